# Optimizing an MI355X kernel written in HIP

```python
import math
import jax, jax.numpy as jnp
from jax import lax
import numpy as np

D_MODEL = 1024
BATCH = 32
SEQ = 2048
DEPTH = 2

HEAD_DIM = 64
A_HEADS = D_MODEL // (2 * HEAD_DIM)
A_WIDTH = A_HEADS * HEAD_DIM
A_BRANCHES = ((128, 1), (512, 4), (2048, 16))
A_BLOCK = 128
B_HEADS = D_MODEL // (4 * HEAD_DIM)
B_QK_WIDTH = 2 * B_HEADS * HEAD_DIM
B_V_WIDTH = B_HEADS * 2 * HEAD_DIM
Q_BLOCK = 128
C_INNER = D_MODEL
C_HEAD_DIM = 64
C_HEADS = C_INNER // C_HEAD_DIM
C_GROUPS = 2
C_STATE = 128
C_CONV = 4
C_CHUNK = 128
D_INNER = D_MODEL
D_HEADS = 4
D_HEAD_DIM = D_INNER // D_HEADS
D_QK_BLOCK = 4
D_CONV = 4
D_CHUNK = 128
FFN_HIDDEN = -(-8 * D_MODEL // (3 * 256)) * 256
RMS_EPS = 1e-6

AB_SIZES = (A_WIDTH, A_WIDTH, A_WIDTH, B_QK_WIDTH, B_QK_WIDTH, B_V_WIDTH)
CD_SIZES = (C_INNER, C_INNER + 2 * C_GROUPS * C_STATE, C_HEADS,
            D_INNER, D_INNER, D_INNER, D_HEADS, D_HEADS)

kernel_name = "hybrid_dilated_diffattn_ssd_mlstm_trunk"


def _split(t, sizes):
    return jnp.split(t, np.cumsum(sizes)[:-1].tolist(), axis=-1)


def rmsnorm(x, w):
    xf = x.astype(jnp.float32)
    y = xf * lax.rsqrt(jnp.mean(xf * xf, axis=-1, keepdims=True) + RMS_EPS)
    return (y * w.astype(jnp.float32)).astype(x.dtype)


def causal_depthwise_conv(x, w, b):
    k, c = w.shape
    y = lax.conv_general_dilated(x, w[:, None, :], window_strides=(1,), padding=[(k - 1, 0)],
                                 dimension_numbers=("NWC", "WIO", "NWC"), feature_group_count=c)
    return y + b


def local_window_attn(q, k, v, n_back):
    lead, n, dh = q.shape[:-2], q.shape[-2], q.shape[-1]
    npad = -(-n // A_BLOCK) * A_BLOCK
    nb = npad // A_BLOCK
    pad = [(0, 0)] * len(lead) + [(0, npad - n), (0, 0)]
    qb, kb, vb = (jnp.pad(t, pad).reshape(lead + (nb, A_BLOCK, dh)) for t in (q, k, v))
    def with_prev(t):
        prev = jnp.concatenate([jnp.zeros_like(t[..., :1, :, :]), t[..., :-1, :, :]], axis=-3)
        return jnp.concatenate([prev, t], axis=-2)
    kk, vv = with_prev(kb), with_prev(vb)
    s = jnp.einsum("...bqd,...bkd->...bqk", qb, kk).astype(jnp.float32) * (HEAD_DIM ** -0.5)
    qpos = jnp.arange(nb)[:, None, None] * A_BLOCK + jnp.arange(A_BLOCK)[None, :, None]
    kpos = (jnp.arange(nb)[:, None, None] - 1) * A_BLOCK + jnp.arange(2 * A_BLOCK)[None, None, :]
    dist = qpos - kpos
    valid = (dist >= 0) & (dist <= n_back) & (kpos >= 0)
    s = jnp.where(valid, s, -jnp.inf)
    m = jnp.max(s, axis=-1, keepdims=True)
    p = jnp.exp(s - m)
    den = jnp.sum(p, axis=-1, keepdims=True)
    o = jnp.einsum("...bqk,...bkd->...bqd", (p / den).astype(v.dtype), vv)
    lse = (m + jnp.log(den))[..., 0]
    o = o.reshape(lead + (npad, dh))[..., :n, :]
    lse = lse.reshape(lead + (npad,))[..., :n]
    return o, lse


def dilated_branch(q, k, v, window, dilation):
    bn, h, t, dh = q.shape
    def strided(a):
        return a.reshape(bn, h, t // dilation, dilation, dh).swapaxes(2, 3)
    o, lse = local_window_attn(strided(q), strided(k), strided(v), window // dilation)
    return o.swapaxes(2, 3).reshape(bn, h, t, dh), lse.swapaxes(2, 3).reshape(bn, h, t)


def dilated_mixture_attention(q, k, v):
    outs, lses = [], []
    for window, dilation in A_BRANCHES:
        o, lse = dilated_branch(q, k, v, window, dilation)
        outs.append(o)
        lses.append(lse)
    wts = jax.nn.softmax(jnp.stack(lses, axis=0), axis=0)
    return jnp.einsum("gbht,gbhtd->bhtd", wts.astype(q.dtype), jnp.stack(outs, axis=0))


def diff_attention(q, k, v, lam):
    bn, h, t = q.shape[:3]
    nb = t // Q_BLOCK
    kidx = jnp.arange(t)
    def block(i):
        qs = lax.dynamic_slice_in_dim(q, i * Q_BLOCK, Q_BLOCK, axis=2)
        s = jnp.einsum("bhqcd,bhkcd->bchqk", qs, k).astype(jnp.float32) * (HEAD_DIM ** -0.5)
        qpos = i * Q_BLOCK + jnp.arange(Q_BLOCK)
        s = jnp.where(kidx[None, :] <= qpos[:, None], s, -jnp.inf)
        p = jax.nn.softmax(s, axis=-1)
        a = p[:, 0] - lam * p[:, 1]
        return jnp.einsum("bhqk,bhkd->bhqd", a.astype(v.dtype), v)
    out = lax.map(block, jnp.arange(nb))
    return out.transpose(1, 2, 0, 3, 4).reshape(bn, h, t, v.shape[-1])


def attn_mix(hn, w_in, w_out, lq1, lk1, lq2, lk2, subln_w, lambda_init):
    bn, t, _ = hn.shape
    qa, ka, va, qd, kd, vd = _split(hn @ w_in, AB_SIZES)
    def heads(a, n):
        return a.reshape(bn, t, n, -1).transpose(0, 2, 1, 3)
    ya = dilated_mixture_attention(heads(qa, A_HEADS), heads(ka, A_HEADS), heads(va, A_HEADS))
    ya = ya.transpose(0, 2, 1, 3).reshape(bn, t, A_WIDTH)
    lam = jnp.exp(jnp.sum(lq1 * lk1)) - jnp.exp(jnp.sum(lq2 * lk2)) + lambda_init
    qd = qd.reshape(bn, t, B_HEADS, 2, HEAD_DIM).transpose(0, 2, 1, 3, 4)
    kd = kd.reshape(bn, t, B_HEADS, 2, HEAD_DIM).transpose(0, 2, 1, 3, 4)
    yb = diff_attention(qd, kd, heads(vd, B_HEADS), lam)
    yb = rmsnorm(yb, subln_w) * (1.0 - lambda_init)
    yb = yb.transpose(0, 2, 1, 3).reshape(bn, t, B_V_WIDTH)
    return jnp.concatenate([ya, yb], axis=-1) @ w_out


def ssd_chunked(x, dt, a_neg, bm, cm):
    bn, t, h, p = x.shape
    g, n = bm.shape[2:]
    e = h // g
    nc = t // C_CHUNK
    x = x.reshape(bn, nc, C_CHUNK, g, e, p)
    dt = dt.reshape(bn, nc, C_CHUNK, g, e)
    bm = bm.reshape(bn, nc, C_CHUNK, g, n)
    cm = cm.reshape(bn, nc, C_CHUNK, g, n)
    xdt = x * dt[..., None]
    acum = jnp.cumsum(jnp.moveaxis(dt.astype(jnp.float32) * a_neg.reshape(g, e), 2, -1), axis=-1)
    causal = jnp.tril(jnp.ones((C_CHUNK, C_CHUNK), dtype=bool))
    decay = jnp.exp(jnp.where(causal, acum[..., :, None] - acum[..., None, :], -jnp.inf))
    cb = jnp.einsum("bclgn,bcsgn->bcgls", cm, bm)
    y_diag = jnp.einsum("bcgls,bcgels,bcsgep->bclgep", cb, decay, xdt)
    decay_end = jnp.exp(acum[..., -1:] - acum)
    states = jnp.einsum("bcsgn,bcges,bcsgep->bcgepn", bm, decay_end, xdt)
    chunk_decay = jnp.exp(acum[..., -1])
    def step(s, inp):
        st, dec = inp
        return dec[..., None, None] * s + st, s
    s0 = jnp.zeros(states.shape[:1] + states.shape[2:], states.dtype)
    _, s_in = lax.scan(step, s0, (jnp.moveaxis(states, 1, 0), jnp.moveaxis(chunk_decay, 1, 0)))
    s_in = jnp.moveaxis(s_in, 0, 1)
    y_off = jnp.einsum("bclgn,bcgepn,bcgel->bclgep", cm, s_in, jnp.exp(acum))
    return (y_diag + y_off).reshape(bn, t, h, p)


def mlstm_chunkwise(q, k, v, ig, logf):
    bn, t, h, dk = q.shape
    dv = v.shape[-1]
    nc = t // D_CHUNK
    q = q.reshape(bn, nc, D_CHUNK, h, dk)
    k = k.reshape(bn, nc, D_CHUNK, h, dk)
    v = v.reshape(bn, nc, D_CHUNK, h, dv)
    ig = jnp.moveaxis(ig.astype(jnp.float32).reshape(bn, nc, D_CHUNK, h), 2, -1)
    bcum = jnp.cumsum(jnp.moveaxis(logf.astype(jnp.float32).reshape(bn, nc, D_CHUNK, h), 2, -1), axis=-1)
    gtot = bcum[..., -1]
    causal = jnp.tril(jnp.ones((D_CHUNK, D_CHUNK), dtype=bool))
    dmat = jnp.where(causal, bcum[..., :, None] - bcum[..., None, :] + ig[..., None, :], -jnp.inf)
    w_end = gtot[..., None] - bcum + ig
    a_loc = jnp.max(w_end, axis=-1)
    e_end = jnp.exp(w_end - a_loc[..., None])
    c_loc = jnp.einsum("bchs,bcshv,bcshk->bchvk", e_end, v, k)
    n_loc = jnp.einsum("bchs,bcshk->bchk", e_end, k)
    def step(carry, inp):
        cs, ns, ms = carry
        cl, nl, al, gc = inp
        m_new = jnp.maximum(gc + ms, al)
        d_old = jnp.exp(gc + ms - m_new)
        d_loc = jnp.exp(al - m_new)
        c_new = d_old[..., None, None] * cs + d_loc[..., None, None] * cl
        n_new = d_old[..., None] * ns + d_loc[..., None] * nl
        return (c_new, n_new, m_new), (cs, ns, ms)
    init = (jnp.zeros((bn, h, dv, dk), c_loc.dtype), jnp.zeros((bn, h, dk), n_loc.dtype),
            jnp.zeros((bn, h), gtot.dtype))
    xs = tuple(jnp.moveaxis(a, 1, 0) for a in (c_loc, n_loc, a_loc, gtot))
    _, (c_in, n_in, m_in) = lax.scan(step, init, xs)
    c_in, n_in, m_in = (jnp.moveaxis(a, 0, 1) for a in (c_in, n_in, m_in))
    inter_log = bcum + m_in[..., None]
    m_out = jnp.maximum(jnp.max(dmat, axis=-1), inter_log)
    wqk = jnp.exp(dmat - m_out[..., None]) * jnp.einsum("bclhk,bcshk->bchls", q, k)
    e_inter = jnp.exp(inter_log - m_out)
    num = (jnp.einsum("bchls,bcshv->bclhv", wqk, v)
           + jnp.einsum("bclhk,bchvk->bclhv", q, c_in) * jnp.swapaxes(e_inter, 2, 3)[..., None])
    den = jnp.sum(wqk, axis=-1) + jnp.einsum("bclhk,bchk->bchl", q, n_in) * e_inter
    denom = jnp.maximum(jnp.abs(den), jnp.exp(-m_out))
    return (num / jnp.swapaxes(denom, 2, 3)[..., None]).reshape(bn, t, h, dv)


def headwise(x, w):
    bn, t, _ = x.shape
    y = jnp.einsum("btnj,nji->btni", x.reshape(bn, t, w.shape[0], D_QK_BLOCK), w)
    return y.reshape(bn, t, D_INNER)


def ssm_mix(hn, w_in, w_out, c_conv_w, c_conv_b, c_dt_bias, c_a_log, c_d_skip, c_norm_w,
            d_conv_w, d_conv_b, d_wq, d_wk, d_i_bias, d_f_bias, d_norm_w):
    bn, t, _ = hn.shape
    z, xbc, dt_raw, u, v, o_pre, i_pre, f_pre = _split(hn @ w_in, CD_SIZES)
    xbc = jax.nn.silu(causal_depthwise_conv(xbc, c_conv_w, c_conv_b))
    xs, bm, cm = _split(xbc, (C_INNER, C_GROUPS * C_STATE, C_GROUPS * C_STATE))
    dt = jax.nn.softplus((dt_raw + c_dt_bias).astype(jnp.float32))
    a_neg = -jnp.exp(c_a_log.astype(jnp.float32))
    xs_h = xs.reshape(bn, t, C_HEADS, C_HEAD_DIM)
    y = ssd_chunked(xs_h, dt, a_neg, bm.reshape(bn, t, C_GROUPS, C_STATE), cm.reshape(bn, t, C_GROUPS, C_STATE))
    y = (y + xs_h * c_d_skip[:, None]).astype(hn.dtype).reshape(bn, t, C_INNER)
    yc = rmsnorm(y * jax.nn.silu(z), c_norm_w)
    uc = jax.nn.silu(causal_depthwise_conv(u, d_conv_w, d_conv_b))
    q = headwise(uc, d_wq).reshape(bn, t, D_HEADS, D_HEAD_DIM)
    k = headwise(uc, d_wk).reshape(bn, t, D_HEADS, D_HEAD_DIM) * (D_HEAD_DIM ** -0.5)
    vh = v.reshape(bn, t, D_HEADS, D_HEAD_DIM)
    logf = jax.nn.log_sigmoid((f_pre + d_f_bias).astype(jnp.float32))
    hd = mlstm_chunkwise(q, k, vh, i_pre + d_i_bias, logf).astype(hn.dtype)
    hd = rmsnorm(hd, d_norm_w.reshape(D_HEADS, D_HEAD_DIM)).reshape(bn, t, D_INNER)
    yd = jax.nn.sigmoid(o_pre) * hd
    return jnp.concatenate([yc, yd], axis=-1) @ w_out


def swiglu(h, w_gate_up, w_down):
    g, u = jnp.split(h @ w_gate_up, 2, axis=-1)
    return (jax.nn.silu(g) * u) @ w_down


def setup_inputs(seed: int = 0) -> dict:
    key = jax.random.key(seed)
    ks = iter(jax.random.split(key, 40))
    def nrm(shape, scale):
        return jax.random.normal(next(ks), shape, jnp.float32) * scale
    ne = (DEPTH + 1) // 2
    no = DEPTH // 2
    ab_cols = sum(AB_SIZES)
    cd_cols = sum(CD_SIZES)
    xbc_w = C_INNER + 2 * C_GROUPS * C_STATE
    x = nrm((BATCH, SEQ, D_MODEL), 1.0)
    mix_norm_w = 1.0 + nrm((DEPTH, D_MODEL), 0.02)
    ffn_norm_w = 1.0 + nrm((DEPTH, D_MODEL), 0.02)
    ab_w_in = nrm((ne, D_MODEL, ab_cols), D_MODEL ** -0.5)
    ab_w_out = nrm((ne, A_WIDTH + B_V_WIDTH, D_MODEL), (A_WIDTH + B_V_WIDTH) ** -0.5)
    diff_lq1 = nrm((ne, HEAD_DIM), 0.1)
    diff_lk1 = nrm((ne, HEAD_DIM), 0.1)
    diff_lq2 = nrm((ne, HEAD_DIM), 0.1)
    diff_lk2 = nrm((ne, HEAD_DIM), 0.1)
    diff_subln_w = 1.0 + nrm((ne, 2 * HEAD_DIM), 0.02)
    cd_w_in = nrm((no, D_MODEL, cd_cols), D_MODEL ** -0.5)
    c_conv_w = nrm((no, C_CONV, xbc_w), C_CONV ** -0.5)
    c_conv_b = nrm((no, xbc_w), 0.02)
    dt0 = jnp.exp(jax.random.uniform(next(ks), (no, C_HEADS), jnp.float32,
                                     minval=math.log(1e-3), maxval=math.log(1e-1)))
    c_dt_bias = dt0 + jnp.log(-jnp.expm1(-dt0))
    c_a_log = jnp.log(jax.random.uniform(next(ks), (no, C_HEADS), jnp.float32, minval=1.0, maxval=16.0))
    c_d_skip = 1.0 + nrm((no, C_HEADS), 0.1)
    c_norm_w = 1.0 + nrm((no, C_INNER), 0.02)
    d_conv_w = nrm((no, D_CONV, D_INNER), D_CONV ** -0.5)
    d_conv_b = nrm((no, D_INNER), 0.02)
    d_wq = nrm((no, D_INNER // D_QK_BLOCK, D_QK_BLOCK, D_QK_BLOCK), D_QK_BLOCK ** -0.5)
    d_wk = nrm((no, D_INNER // D_QK_BLOCK, D_QK_BLOCK, D_QK_BLOCK), D_QK_BLOCK ** -0.5)
    d_i_bias = nrm((no, D_HEADS), 0.1)
    d_f_bias = jnp.linspace(3.0, 6.0, D_HEADS, dtype=jnp.float32)[None, :] + nrm((no, D_HEADS), 0.1)
    d_norm_w = 1.0 + nrm((no, D_INNER), 0.02)
    cd_w_out = nrm((no, C_INNER + D_INNER, D_MODEL), (C_INNER + D_INNER) ** -0.5)
    ffn_w_gate_up = nrm((DEPTH, D_MODEL, 2 * FFN_HIDDEN), D_MODEL ** -0.5)
    ffn_w_down = nrm((DEPTH, FFN_HIDDEN, D_MODEL), FFN_HIDDEN ** -0.5)
    final_norm_w = 1.0 + nrm((D_MODEL,), 0.02)
    return {"x": x, "mix_norm_w": mix_norm_w, "ffn_norm_w": ffn_norm_w,
            "ab_w_in": ab_w_in, "ab_w_out": ab_w_out,
            "diff_lq1": diff_lq1, "diff_lk1": diff_lk1, "diff_lq2": diff_lq2, "diff_lk2": diff_lk2,
            "diff_subln_w": diff_subln_w, "cd_w_in": cd_w_in,
            "c_conv_w": c_conv_w, "c_conv_b": c_conv_b, "c_dt_bias": c_dt_bias, "c_a_log": c_a_log,
            "c_d_skip": c_d_skip, "c_norm_w": c_norm_w,
            "d_conv_w": d_conv_w, "d_conv_b": d_conv_b, "d_wq": d_wq, "d_wk": d_wk,
            "d_i_bias": d_i_bias, "d_f_bias": d_f_bias, "d_norm_w": d_norm_w, "cd_w_out": cd_w_out,
            "ffn_w_gate_up": ffn_w_gate_up, "ffn_w_down": ffn_w_down, "final_norm_w": final_norm_w}


def reference(x, mix_norm_w, ffn_norm_w, ab_w_in, ab_w_out, diff_lq1, diff_lk1, diff_lq2, diff_lk2,
              diff_subln_w, cd_w_in, c_conv_w, c_conv_b, c_dt_bias, c_a_log, c_d_skip, c_norm_w,
              d_conv_w, d_conv_b, d_wq, d_wk, d_i_bias, d_f_bias, d_norm_w, cd_w_out,
              ffn_w_gate_up, ffn_w_down, final_norm_w):
    h = x
    for layer in range(DEPTH):
        j = layer // 2
        hn = rmsnorm(h, mix_norm_w[layer])
        if layer % 2 == 0:
            lambda_init = 0.8 - 0.6 * math.exp(-0.3 * layer)
            h = h + attn_mix(hn, ab_w_in[j], ab_w_out[j], diff_lq1[j], diff_lk1[j], diff_lq2[j],
                             diff_lk2[j], diff_subln_w[j], lambda_init)
        else:
            h = h + ssm_mix(hn, cd_w_in[j], cd_w_out[j], c_conv_w[j], c_conv_b[j], c_dt_bias[j],
                            c_a_log[j], c_d_skip[j], c_norm_w[j], d_conv_w[j], d_conv_b[j],
                            d_wq[j], d_wk[j], d_i_bias[j], d_f_bias[j], d_norm_w[j])
        h = h + swiglu(rmsnorm(h, ffn_norm_w[layer]), ffn_w_gate_up[layer], ffn_w_down[layer])
    return rmsnorm(h, final_norm_w)
```

```cpp
#include <hip/hip_runtime.h>
#include <cstdio>
#include <cstdint>
#ifndef MK_ONE_LAUNCH
#define MK_ONE_LAUNCH 0
#endif
namespace pg8 {
#define PG8_LAS __attribute__((address_space(3)))
typedef unsigned short bf16_t;
typedef short bf16x8 __attribute__((ext_vector_type(8)));
typedef float f32x4 __attribute__((ext_vector_type(4)));
typedef unsigned u32x4 __attribute__((ext_vector_type(4)));
constexpr int BM = 256, BK = 64, HALF = 128, HTB = HALF * BK * 2  , STAGE_BYTES = 8 * HTB, NXCD = 8, WGM = 8;

__host__ __device__ __forceinline__ int lds_byte(int r, int c) { const int st = (r >> 4) * 2 + (c >> 5), rr = r & 15, cc = c & 31, ob = rr * 64 + cc * 2; return st * 1024 + (ob ^ (((ob >> 9) & 1) << 5)); }
__host__ __device__ __forceinline__ void stage_rc(int b, int& R, int& C) { const int st = b / 1024, sb = b % 1024, swz = sb ^ (((sb >> 9) & 1) << 5); R = (st >> 1) * 16 + swz / 64; C = (st & 1) * 32 + (swz % 64) / 2; }
__host__ __device__ __forceinline__ int perm32(int rho) { const int n = rho >> 4, i = rho & 15; return 8 * (i >> 2) + 4 * n + (i & 3); }

struct Unit { int pm, pn; };
struct Gemm { const bf16_t* A; const bf16_t* Bt; int M, N, K; };

struct StaticOrder {
    int nM, nN, nwg, G, c;
    __host__ __device__ void init(int M, int N, int G_, int c_) { nM = M / BM; nN = N / BM; nwg = nM * nN; G = G_; c = c_; }
    __host__ __device__ bool next(int i, Unit& u) const {
        const long L = (long)i * G + c; if (L >= nwg) return false;
        int wgid = (int)L; { const int q = nwg / NXCD, r = nwg % NXCD, xcd = wgid % NXCD, off = wgid / NXCD; wgid = (xcd < r ? xcd * (q + 1) : r * (q + 1) + (xcd - r) * q) + off; }
        const int nig = WGM * nN, gid = wgid / nig, fm = gid * WGM, gsz = (nM - fm) < WGM ? (nM - fm) : WGM;
        u.pm = fm + ((wgid % nig) % gsz); u.pn = (wgid % nig) / gsz; return true;
    }
    __device__ __forceinline__ void a_ready(const Unit&) const {}
    __device__ __forceinline__ void done(const Unit&) const {}
};

__device__ __forceinline__ unsigned cvt_pk_bf16(float lo, float hi) { unsigned r; asm volatile("v_cvt_pk_bf16_f32 %0, %1, %2" : "=v"(r) : "v"(lo), "v"(hi)); return r; }
typedef float f32x2 __attribute__((ext_vector_type(2)));
__device__ __forceinline__ float silu_f(float x) { return x / (1.f + __expf(-x)); }
struct EpiQKV {
    static constexpr bool PERM = true, AFTER_DRAIN = false;
    bf16_t* O; int ldc; int sc_lo, sc_hi; float scale;
    __device__ __forceinline__ void operator()(const f32x4 (&acc)[2][2][4][2], const Unit& u, int wr, int wc, int fr, int fq) const {
        const int row0 = u.pm * BM + wr * 64 + fr, col0 = u.pn * BM + wc * 32 + 8 * fq;
        const float sc = (u.pn >= sc_lo && u.pn < sc_hi) ? scale : 1.f;
#pragma unroll
        for (int ai = 0; ai < 2; ++ai)
#pragma unroll
            for (int m = 0; m < 4; ++m) { bf16_t* rowp = O + (size_t)(row0 + ai * HALF + m * 16) * ldc + col0;
#pragma unroll
                for (int bj = 0; bj < 2; ++bj) { const f32x4 v0 = acc[ai][bj][m][0] * sc, v1 = acc[ai][bj][m][1] * sc;
                    u32x4 w; w.x = cvt_pk_bf16(v0[0], v0[1]); w.y = cvt_pk_bf16(v0[2], v0[3]); w.z = cvt_pk_bf16(v1[0], v1[1]); w.w = cvt_pk_bf16(v1[2], v1[3]);
                    *(u32x4*)(rowp + bj * HALF) = w; } }
    }
};
struct EpiZX {
    static constexpr bool PERM = true, AFTER_DRAIN = false;
    bf16_t *Z, *XBC, *U, *V, *O; float* G;
    __device__ __forceinline__ void operator()(const f32x4 (&acc)[2][2][4][2], const Unit& u, int wr, int wc, int fr, int fq) const {
        const int row0 = u.pm * BM + wr * 64 + fr; const int pn = u.pn;
        if (pn == 22) {
            if (wc == 0) {
#pragma unroll
                for (int ai = 0; ai < 2; ++ai)
#pragma unroll
                    for (int m = 0; m < 4; ++m) { float* gp = G + (size_t)(row0 + ai * HALF + m * 16) * 32 + 8 * fq;
                        *(f32x4*)gp = acc[ai][0][m][0]; *(f32x4*)(gp + 4) = acc[ai][0][m][1]; }
            }
            return;
        }
        bf16_t* base; int ldc, colt;
        if (pn < 4) { base = Z; ldc = 1024; colt = pn * 256; }
        else if (pn < 10) { base = XBC; ldc = 1536; colt = (pn - 4) * 256; }
        else if (pn < 14) { base = U; ldc = 1024; colt = (pn - 10) * 256; }
        else if (pn < 18) { base = V; ldc = 1024; colt = (pn - 14) * 256; }
        else { base = O; ldc = 1024; colt = (pn - 18) * 256; }
        const int col0 = colt + wc * 32 + 8 * fq;
#pragma unroll
        for (int ai = 0; ai < 2; ++ai)
#pragma unroll
            for (int m = 0; m < 4; ++m) { bf16_t* rowp = base + (size_t)(row0 + ai * HALF + m * 16) * ldc + col0;
#pragma unroll
                for (int bj = 0; bj < 2; ++bj) { const f32x4 v0 = acc[ai][bj][m][0], v1 = acc[ai][bj][m][1];
                    u32x4 w; w.x = cvt_pk_bf16(v0[0], v0[1]); w.y = cvt_pk_bf16(v0[2], v0[3]); w.z = cvt_pk_bf16(v1[0], v1[1]); w.w = cvt_pk_bf16(v1[2], v1[3]);
                    *(u32x4*)(rowp + bj * HALF) = w; } }
    }
};
struct EpiSwiglu {
    static constexpr bool PERM = true, AFTER_DRAIN = false;
    bf16_t* O; int ldc;
    __device__ __forceinline__ void operator()(const f32x4 (&acc)[2][2][4][2], const Unit& u, int wr, int wc, int fr, int fq) const {
        const int row0 = u.pm * BM + wr * 64 + fr, col0 = u.pn * HALF + wc * 32 + 8 * fq;
#pragma unroll
        for (int ai = 0; ai < 2; ++ai)
#pragma unroll
            for (int m = 0; m < 4; ++m) {
                const f32x4 g0 = acc[ai][0][m][0], g1 = acc[ai][0][m][1], u0 = acc[ai][1][m][0], u1 = acc[ai][1][m][1];
                float r[8];
#pragma unroll
                for (int j = 0; j < 4; ++j) { r[j] = silu_f(g0[j]) * u0[j]; r[4 + j] = silu_f(g1[j]) * u1[j]; }
                u32x4 w; w.x = cvt_pk_bf16(r[0], r[1]); w.y = cvt_pk_bf16(r[2], r[3]); w.z = cvt_pk_bf16(r[4], r[5]); w.w = cvt_pk_bf16(r[6], r[7]);
                *(u32x4*)(O + (size_t)(row0 + ai * HALF + m * 16) * ldc + col0) = w; }
    }
};
struct EpiResid {
    static constexpr bool PERM = false, AFTER_DRAIN = false;
    const float* src; float* out; int ldc;
    __device__ __forceinline__ void operator()(const f32x4 (&acc)[2][2][4][2], const Unit& u, int wr, int wc, int fr, int fq) const {
        const int row0 = u.pm * BM + wr * 64 + fr, col0 = u.pn * BM + wc * 32 + 4 * fq;
#pragma unroll
        for (int ai = 0; ai < 2; ++ai)
#pragma unroll
            for (int m = 0; m < 4; ++m) { const size_t off = (size_t)(row0 + ai * HALF + m * 16) * ldc + col0;
#pragma unroll
                for (int bj = 0; bj < 2; ++bj)
#pragma unroll
                    for (int n = 0; n < 2; ++n) { const f32x4 s = *(const f32x4*)(src + off + bj * HALF + n * 16); *(f32x4*)(out + off + bj * HALF + n * 16) = s + acc[ai][bj][m][n]; } }
    }
};

template <class Epi, class Sched, bool ALIGN_EPI = false, bool SP2 = false>
__device__ __forceinline__ void gemm_phase(PG8_LAS unsigned char* lds, const Gemm g, const Sched& S, const Epi& E) {
    const int tid = threadIdx.x, wid = __builtin_amdgcn_readfirstlane(tid >> 6), lane = tid & 63, wr = wid >> 2, wc = wid & 3, fr = lane & 15, fq = lane >> 4;
    const int K = g.K, nt = K / BK;
    unsigned voffA[2], voffB[2];
#pragma unroll
    for (int i = 0; i < 2; ++i) { int R, C; stage_rc(tid * 16 + i * 8192, R, C); const int Rb = Epi::PERM ? ((R & ~31) + perm32(R & 31)) : R;
        voffA[i] = (unsigned)(R * K + C) * 2u; voffB[i] = (unsigned)(Rb * K + C) * 2u; }
    const size_t kstep = (size_t)(BK * 2);
    const size_t hstep = (size_t)HALF * K * 2;
    const size_t tstep = 2 * hstep;
    const unsigned ldsw = (unsigned)wid * 1024u;
    const int aoff = lds_byte(wr * 64 + fr, fq * 8), boff = lds_byte(wc * 32 + fr, fq * 8);
#define PG8_SA(b, h) (((b) * 2 + (h)) * HTB)
#define PG8_SB(b, h) ((4 + (b) * 2 + (h)) * HTB)
#define PG8_STAGE(bufoff, gbase, voff) do { _Pragma("unroll") for (int _i = 0; _i < 2; ++_i) \
        __builtin_amdgcn_global_load_lds((const unsigned*)((const char*)(gbase) + (voff)[_i]), (PG8_LAS unsigned*)(lds + (bufoff) + ldsw + _i * 8192), 16, 0, 0); } while (0)
#define PG8_LDA(dst, b, h) do { _Pragma("unroll") for (int m = 0; m < 4; ++m) _Pragma("unroll") for (int k = 0; k < 2; ++k) dst[m][k] = *(const PG8_LAS bf16x8*)(lds + PG8_SA(b, h) + aoff + m * 2048 + k * 1024); } while (0)
#define PG8_LDB(dst, b, h) do { _Pragma("unroll") for (int n = 0; n < 2; ++n) _Pragma("unroll") for (int k = 0; k < 2; ++k) dst[n][k] = *(const PG8_LAS bf16x8*)(lds + PG8_SB(b, h) + boff + n * 2048 + k * 1024); } while (0)
#define PG8_MMA(ai, bj, At, Bt) do { __builtin_amdgcn_s_setprio(1); _Pragma("unroll") for (int m = 0; m < 4; ++m) _Pragma("unroll") for (int n = 0; n < 2; ++n) _Pragma("unroll") for (int k = 0; k < 2; ++k) \
        acc[ai][bj][m][n] = __builtin_amdgcn_mfma_f32_16x16x32_bf16(Bt[n][k], At[m][k], acc[ai][bj][m][n], 0, 0, 0); __builtin_amdgcn_s_setprio(0); } while (0)
#define PG8_WAIT_V(n) asm volatile("s_waitcnt vmcnt(" #n ")" ::: "memory")
#define PG8_WAIT_L(n) asm volatile("s_waitcnt lgkmcnt(" #n ")" ::: "memory")
#define PG8_BAR __builtin_amdgcn_s_barrier()
#define PG8_SCHED __builtin_amdgcn_sched_barrier(0)
    Unit cur, nxt; int ui = 0;
    if (!S.next(0, cur)) return;
    f32x4 acc[2][2][4][2];
#pragma unroll
    for (int a = 0; a < 2; ++a)
#pragma unroll
        for (int b = 0; b < 2; ++b)
#pragma unroll
            for (int m = 0; m < 4; ++m)
#pragma unroll
                for (int n = 0; n < 2; ++n) acc[a][b][m][n] = (f32x4){0.f, 0.f, 0.f, 0.f};
    bf16x8 At[4][2], B0[2][2], B1[2][2];
    const char* cA = (const char*)g.A + (size_t)cur.pm * tstep; const char* cB = (const char*)g.Bt + (size_t)cur.pn * tstep;
    S.a_ready(cur);
    if constexpr (SP2) {
        PG8_STAGE(PG8_SB(0, 0), cB, voffB); PG8_STAGE(PG8_SB(0, 1), cB + hstep, voffB); PG8_STAGE(PG8_SA(0, 0), cA, voffA); PG8_STAGE(PG8_SA(0, 1), cA + hstep, voffA);
        if (wr == 1) PG8_BAR;
        PG8_WAIT_V(2); PG8_BAR;
        PG8_STAGE(PG8_SB(1, 0), cB + kstep, voffB); PG8_STAGE(PG8_SA(1, 0), cA + kstep, voffA); PG8_STAGE(PG8_SB(1, 1), cB + hstep + kstep, voffB);
        PG8_WAIT_V(6); PG8_BAR;
    } else {
        PG8_STAGE(PG8_SB(0, 0), cB, voffB); PG8_STAGE(PG8_SA(0, 0), cA, voffA); PG8_STAGE(PG8_SB(0, 1), cB + hstep, voffB); PG8_STAGE(PG8_SA(0, 1), cA + hstep, voffA);
        if (wr == 1) PG8_BAR;
        PG8_WAIT_V(4); PG8_BAR;
        PG8_STAGE(PG8_SB(1, 0), cB + kstep, voffB); PG8_STAGE(PG8_SA(1, 0), cA + kstep, voffA); PG8_STAGE(PG8_SB(1, 1), cB + hstep + kstep, voffB);
        PG8_WAIT_V(6); PG8_BAR;
    }
    for (;;) {
        const bool has_next = S.next(ui + 1, nxt);
        const char* nA = has_next ? (const char*)g.A + (size_t)nxt.pm * tstep : cA; const char* nB = has_next ? (const char*)g.Bt + (size_t)nxt.pn * tstep : cB;
        for (int t = 0; t < nt; t += 2) {
            const bool last = (t == nt - 2);
            const char* a1 = cA + (size_t)(t + 1) * kstep;
            const char* a2 = last ? nA : cA + (size_t)(t + 2) * kstep; const char* b2 = last ? nB : cB + (size_t)(t + 2) * kstep;
            const char* a3 = a2 + kstep; const char* b3 = b2 + kstep;
            if (last && has_next) S.a_ready(nxt);
            if constexpr (SP2) {
            PG8_LDB(B0, 0, 0); PG8_LDB(B1, 0, 1); PG8_SCHED; PG8_LDA(At, 0, 0); PG8_STAGE(PG8_SA(1, 1), a1 + hstep, voffA);
            PG8_WAIT_V(8); PG8_WAIT_L(0); PG8_BAR; PG8_MMA(0, 0, At, B0); PG8_MMA(0, 1, At, B1); PG8_BAR; PG8_SCHED;
            PG8_LDA(At, 0, 1); PG8_STAGE(PG8_SB(0, 0), b2, voffB); PG8_STAGE(PG8_SB(0, 1), b2 + hstep, voffB); PG8_STAGE(PG8_SA(0, 0), a2, voffA);
            PG8_WAIT_V(8); PG8_WAIT_L(0); PG8_BAR; PG8_MMA(1, 0, At, B0); PG8_MMA(1, 1, At, B1); PG8_BAR; PG8_SCHED;
            PG8_LDB(B0, 1, 0); PG8_LDB(B1, 1, 1); PG8_SCHED; PG8_LDA(At, 1, 0); PG8_STAGE(PG8_SA(0, 1), a2 + hstep, voffA);
            PG8_WAIT_V(8); PG8_WAIT_L(0); PG8_BAR; PG8_MMA(0, 0, At, B0); PG8_MMA(0, 1, At, B1); PG8_BAR; PG8_SCHED;
            PG8_LDA(At, 1, 1); PG8_STAGE(PG8_SB(1, 0), b3, voffB); PG8_STAGE(PG8_SB(1, 1), b3 + hstep, voffB); PG8_STAGE(PG8_SA(1, 0), a3, voffA);
            PG8_WAIT_V(8); PG8_WAIT_L(0); PG8_BAR; PG8_MMA(1, 0, At, B0); PG8_MMA(1, 1, At, B1); PG8_BAR; PG8_SCHED;
            } else {
            PG8_LDB(B0, 0, 0); PG8_SCHED; PG8_LDA(At, 0, 0); PG8_STAGE(PG8_SA(1, 1), a1 + hstep, voffA);
            PG8_WAIT_L(8); PG8_BAR; PG8_WAIT_L(0); PG8_MMA(0, 0, At, B0); PG8_BAR; PG8_SCHED;
            PG8_LDB(B1, 0, 1); PG8_STAGE(PG8_SB(0, 0), b2, voffB);
            PG8_BAR; PG8_WAIT_L(0); PG8_MMA(0, 1, At, B1); PG8_BAR;
            PG8_LDA(At, 0, 1); PG8_STAGE(PG8_SA(0, 0), a2, voffA);
            PG8_BAR; PG8_WAIT_L(0); PG8_MMA(1, 0, At, B0); PG8_BAR; PG8_SCHED;
            PG8_STAGE(PG8_SB(0, 1), b2 + hstep, voffB);
            PG8_WAIT_V(6); PG8_BAR; PG8_MMA(1, 1, At, B1); PG8_BAR;
            PG8_LDB(B0, 1, 0); PG8_SCHED; PG8_LDA(At, 1, 0); PG8_STAGE(PG8_SA(0, 1), a2 + hstep, voffA);
            PG8_WAIT_L(8); PG8_BAR; PG8_WAIT_L(0); PG8_MMA(0, 0, At, B0); PG8_BAR; PG8_SCHED;
            PG8_LDB(B1, 1, 1); PG8_STAGE(PG8_SB(1, 0), b3, voffB);
            PG8_BAR; PG8_WAIT_L(0); PG8_MMA(0, 1, At, B1); PG8_BAR;
            PG8_LDA(At, 1, 1); PG8_STAGE(PG8_SA(1, 0), a3, voffA);
            PG8_BAR; PG8_WAIT_L(0); PG8_MMA(1, 0, At, B0); PG8_BAR; PG8_SCHED;
            PG8_STAGE(PG8_SB(1, 1), b3 + hstep, voffB);
            PG8_WAIT_V(6); PG8_BAR; PG8_MMA(1, 1, At, B1); PG8_BAR;
            }
        }
        if constexpr (ALIGN_EPI) { if (wr == 0) PG8_BAR; }
        if constexpr (!Epi::AFTER_DRAIN) { E(acc, cur, wr, wc, fr, fq); S.done(cur); }
        if (!has_next) break;
#pragma unroll
        for (int a = 0; a < 2; ++a)
#pragma unroll
            for (int b = 0; b < 2; ++b)
#pragma unroll
                for (int m = 0; m < 4; ++m)
#pragma unroll
                    for (int n = 0; n < 2; ++n) acc[a][b][m][n] = (f32x4){0.f, 0.f, 0.f, 0.f};
        cur = nxt; cA = nA; cB = nB; ++ui;
        if constexpr (ALIGN_EPI) { if (wr == 1) PG8_BAR; }
    }
    PG8_WAIT_V(0);
    if constexpr (!ALIGN_EPI) { if (wr == 0) PG8_BAR; }
    PG8_BAR;
    if constexpr (Epi::AFTER_DRAIN) { E.fused(acc, cur, wr, wc, fr, fq, lds, wid, lane); S.done(cur); }
#undef PG8_SA
#undef PG8_SB
#undef PG8_STAGE
#undef PG8_LDA
#undef PG8_LDB
#undef PG8_MMA
#undef PG8_WAIT_V
#undef PG8_WAIT_L
#undef PG8_BAR
#undef PG8_SCHED
}
}
constexpr int NBATCH = 32, T = 2048, D = 1024, M = NBATCH * T, FF = 2816;
constexpr int NQKV = 3072, NGU = 2 * FF, NZX = 5888, NZX_SRC = 5656, KCD = 2048;
constexpr float RMS_EPS = 1e-6f;
constexpr int NWAVES = 8;
constexpr int NPH = 17;
constexpr size_t MiB = 1u << 20;
constexpr size_t WS_CTL = 0, CTL_ZERO_BYTES = 64 * 1024;
constexpr size_t WS_GATES = 1 * MiB;
constexpr size_t WS_W_ABIN = 10 * MiB, WS_W_ABOUT = 16 * MiB, WS_W_GU0 = 18 * MiB, WS_W_DN0 = 29 * MiB, WS_W_CDIN = 35 * MiB, WS_W_CDOUT = 47 * MiB, WS_W_GU1 = 51 * MiB, WS_W_DN1 = 62 * MiB;
constexpr size_t WS_XN = 68 * MiB;
constexpr size_t WS_OB = 196 * MiB;
constexpr size_t WS_R = 324 * MiB;
constexpr size_t WS_QKV = WS_R, WS_ACT = WS_R, WS_Z = WS_OB, WS_XBC = WS_R, WS_U = WS_R + 192 * MiB, WS_V = WS_U + 128 * MiB, WS_O = WS_V + 128 * MiB, WS_YCD = WS_R;
constexpr size_t WS_END = WS_O + 128 * MiB;
static_assert(WS_W_DN1 + (size_t)D * FF * 2 <= WS_XN && WS_W_CDIN + (size_t)NZX * D * 2 <= WS_W_CDOUT && WS_W_DN0 + (size_t)D * FF * 2 <= WS_W_CDIN, "weights map");
static_assert(WS_QKV + (size_t)M * NQKV * 2 <= WS_END && WS_ACT + (size_t)M * FF * 2 <= WS_END && WS_YCD + (size_t)M * KCD * 2 <= WS_V, "activation map");
constexpr int CW_TMO = 0, CW_CODE = 1, CW_BAR = 4096;
constexpr int RING_OFF = 0, RING_BYTES = 131072;
constexpr int LDSCTL_OFF = RING_BYTES, MISC_OFF = LDSCTL_OFF + 320;
constexpr int LDS_BYTES = 147456;
#define GAS __attribute__((address_space(1)))
#define LAS __attribute__((address_space(3)))
typedef unsigned short bf16;
typedef unsigned v4u __attribute__((ext_vector_type(4)));
typedef float f32x4 __attribute__((ext_vector_type(4)));
typedef short bf16x8 __attribute__((ext_vector_type(8)));
typedef GAS unsigned gu32;
typedef GAS unsigned long long gu64;
#define RLX_AGENT __ATOMIC_RELAXED, __HIP_MEMORY_SCOPE_AGENT
#define LDS_WAIT() asm volatile("s_waitcnt lgkmcnt(0)" ::: "memory")
#define VM_WAIT() asm volatile("s_waitcnt vmcnt(0)" ::: "memory")
__device__ __forceinline__ unsigned long long rt() { return __builtin_amdgcn_s_memrealtime(); }
__device__ __forceinline__ unsigned f2bf(float f) { unsigned u = __builtin_bit_cast(unsigned, f); return (u + 0x7fffu + ((u >> 16) & 1u)) >> 16; }
__device__ __forceinline__ unsigned pk2(float lo, float hi) { return f2bf(lo) | (f2bf(hi) << 16); }

#define XB_TMO      128
#define XB_XCNT(j)  (256  + 64 * (j))
#define XB_XSUB(j)  (1280 + 64 * (j))
#define XB_XGEN(j)  (2304 + 64 * (j))
#define XB_TOP      3328
#define XB_TOPGEN   3392
#define XCD_BAR_WORDS 3456
#define XB_SPIN_CAP (1u << 18)

__device__ __forceinline__ unsigned xb_ld(unsigned* p)              { return __hip_atomic_load(p, __ATOMIC_RELAXED, __HIP_MEMORY_SCOPE_AGENT); }
__device__ __forceinline__ unsigned xb_add(unsigned* p, unsigned v) { return __hip_atomic_fetch_add(p, v, __ATOMIC_RELAXED, __HIP_MEMORY_SCOPE_AGENT); }
__device__ __forceinline__ unsigned xb_xcc_id() { return (unsigned)__builtin_amdgcn_s_getreg((3 << 11) | 20) & 0xFu; }
#define XB_SPIN(cond, bar) do { unsigned _sp = 0; while (cond) { __builtin_amdgcn_s_sleep(1); \
    if ((++_sp & 255u) == 0u) { if (xb_ld(&(bar)[XB_TMO])) break; if (_sp > XB_SPIN_CAP) { atomicAdd(&(bar)[XB_TMO], 1u); break; } } } } while (0)

struct XcdBarrier {
    unsigned* bar; unsigned x;
    volatile LAS unsigned* st;
};

__device__ __forceinline__ XcdBarrier xcd_barrier_post(unsigned* bar, volatile LAS unsigned* st) {
    XcdBarrier b; b.bar = bar; b.x = xb_xcc_id(); b.st = st;
    if (threadIdx.x == 0) (void)xb_add(&bar[XB_XCNT(b.x)], 1u);
    return b;
}
__device__ __forceinline__ void xcd_barrier_complete(unsigned* bar, unsigned x, unsigned& nloc, unsigned& nx) {
    const unsigned G = gridDim.x * gridDim.y * gridDim.z;
    unsigned sum, cnt, mine, sp = 0u;
    for (;;) {
        sum = 0u; cnt = 0u; mine = 0u;
#pragma unroll
        for (unsigned j = 0; j < 16; ++j) { const unsigned c = xb_ld(&bar[XB_XCNT(j)]); sum += c; cnt += (c > 0u) ? 1u : 0u; mine = (j == x) ? c : mine; }
        if (sum == G) break;
        __builtin_amdgcn_s_sleep(1);
        if ((++sp & 255u) == 0u) { if (xb_ld(&bar[XB_TMO])) break; if (sp > XB_SPIN_CAP) { atomicAdd(&bar[XB_TMO], 1u); break; } }
    }
    nloc = mine > 0u ? mine : 1u; nx = cnt > 0u ? cnt : 1u;
}

__device__ __forceinline__ void xcd_barrier(const XcdBarrier& b) {
    asm volatile("s_waitcnt vmcnt(0)" ::: "memory");
    __syncthreads();
    if (threadIdx.x == 0) {
        unsigned* bar = b.bar;
        __builtin_amdgcn_s_waitcnt(0);
        unsigned nloc = b.st[0], nx = b.st[1];
        if (nloc == 0u) { xcd_barrier_complete(bar, b.x, nloc, nx); b.st[0] = nloc; b.st[1] = nx; }
        const unsigned old = xb_add(&bar[XB_XSUB(b.x)], 1u);
        const unsigned gen = old / nloc;
        if (old + 1u == (gen + 1u) * nloc) {
            __builtin_amdgcn_fence(__ATOMIC_RELEASE, "agent");
            asm volatile("s_waitcnt vmcnt(0)" ::: "memory");
            const unsigned og = xb_add(&bar[XB_TOP], 1u);
            const unsigned tg = og / nx;
            if (og + 1u == (tg + 1u) * nx) xb_add(&bar[XB_TOPGEN], 1u);
            else XB_SPIN(xb_ld(&bar[XB_TOPGEN]) == tg, bar);
            __builtin_amdgcn_fence(__ATOMIC_ACQUIRE, "agent");
            xb_add(&bar[XB_XGEN(b.x)], 1u);
            asm volatile("s_waitcnt vmcnt(0)" ::: "memory");
        } else {
            XB_SPIN(xb_ld(&bar[XB_XGEN(b.x)]) == gen, bar);
            __builtin_amdgcn_fence(__ATOMIC_ACQUIRE, "agent");
            asm volatile("s_waitcnt vmcnt(0)" ::: "memory");
        }
    }
    __syncthreads();
}
static_assert((CW_BAR + XCD_BAR_WORDS) * 4 <= (int)CTL_ZERO_BYTES, "CTL words inside the memset region");
typedef unsigned long long u64;
__device__ __forceinline__ float wave_sum(float v) {
#pragma unroll
    for (int o = 1; o < 64; o <<= 1) v += __shfl_xor(v, o);
    return v;
}
__device__ __forceinline__ float silu_g(float x) { return x / (1.f + __expf(-x)); }
__device__ __forceinline__ float sigm_g(float x) { return 1.f / (1.f + __expf(-x)); }
__device__ __forceinline__ float bf2f(bf16 v) { return __uint_as_float((unsigned)v << 16); }
__device__ __forceinline__ void ld8f(const bf16* p, float* f) {
    const v4u v = *(const v4u*)p;
    f[0] = __uint_as_float(v.x << 16); f[1] = __uint_as_float(v.x & 0xffff0000u); f[2] = __uint_as_float(v.y << 16); f[3] = __uint_as_float(v.y & 0xffff0000u);
    f[4] = __uint_as_float(v.z << 16); f[5] = __uint_as_float(v.z & 0xffff0000u); f[6] = __uint_as_float(v.w << 16); f[7] = __uint_as_float(v.w & 0xffff0000u);
}
__device__ __forceinline__ void st8f(bf16* p, const float* f) { v4u o; o.x = pk2(f[0], f[1]); o.y = pk2(f[2], f[3]); o.z = pk2(f[4], f[5]); o.w = pk2(f[6], f[7]); *(v4u*)p = o; }

__device__ __forceinline__ int map_gu(int n) { const int p = n >> 8, r = n & 255; return r < 128 ? 128 * p + r : FF + 128 * p + (r - 128); }
__device__ __forceinline__ int map_cdin(int n) {
    if (n < 2560) return n; if (n < 3584) return 2576 + (n - 2560); if (n < 4608) return 3600 + (n - 3584); if (n < 5632) return 4624 + (n - 4608);
    const int j = n - 5632; if (j < 16) return 2560 + j; if (j < 24) return 5648 + (j - 16); return -1;
}
template <int MAP> __device__ __forceinline__ void tr_item(const float* W, int K, int Nsrc, bf16* WT, int nblk, LAS float* scr, int item, int lane) {
    const int kb = item / nblk, nb = item % nblk, k0 = 64 * kb, n0 = 32 * nb;
    const int nd = n0 + (lane & 31); const int sc = (MAP == 0) ? nd : (MAP == 1) ? map_gu(nd) : map_cdin(nd);
#pragma unroll 8
    for (int i = 0; i < 32; ++i) { const int kk = 2 * i + (lane >> 5); scr[kk * 33 + (lane & 31)] = (sc >= 0) ? W[(size_t)(k0 + kk) * Nsrc + sc] : 0.f; }
    LDS_WAIT(); asm volatile("" ::: "memory");
    const int c = lane & 7;
#pragma unroll
    for (int j = 0; j < 4; ++j) { const int n = (lane >> 3) + 8 * j; const LAS float* s = scr + (8 * c) * 33 + n;
        v4u o; o.x = pk2(s[0 * 33], s[1 * 33]); o.y = pk2(s[2 * 33], s[3 * 33]); o.z = pk2(s[4 * 33], s[5 * 33]); o.w = pk2(s[6 * 33], s[7 * 33]);
        *(GAS v4u*)(WT + (size_t)(n0 + n) * K + k0 + 8 * c) = o; }
    LDS_WAIT(); asm volatile("" ::: "memory");
}
__device__ __forceinline__ void rms_row_to_bf16(const float* xrow, const float* w, bf16* orow, int lane) {
    const f32x4* xr = (const f32x4*)xrow + lane; const f32x4* wr = (const f32x4*)w + lane;
    f32x4 v[4]; float s = 0.f;
#pragma unroll
    for (int j = 0; j < 4; ++j) { v[j] = xr[64 * j]; s += (v[j].x * v[j].x + v[j].y * v[j].y) + (v[j].z * v[j].z + v[j].w * v[j].w); }
    const float rstd = 1.f / sqrtf(wave_sum(s) * (1.f / D) + RMS_EPS);
    u64* o8 = (u64*)orow + lane;
#pragma unroll
    for (int j = 0; j < 4; ++j) { const f32x4 g = wr[64 * j]; o8[64 * j] = (u64)pk2(v[j].x * rstd * g.x, v[j].y * rstd * g.y) | ((u64)pk2(v[j].z * rstd * g.z, v[j].w * rstd * g.w) << 32); }
}
__device__ __forceinline__ void rms_row_inplace_f32(float* xrow, const float* w, int lane) {
    f32x4* xr = (f32x4*)xrow + lane; const f32x4* wr = (const f32x4*)w + lane;
    f32x4 v[4]; float s = 0.f;
#pragma unroll
    for (int j = 0; j < 4; ++j) { v[j] = xr[64 * j]; s += (v[j].x * v[j].x + v[j].y * v[j].y) + (v[j].z * v[j].z + v[j].w * v[j].w); }
    const float rstd = 1.f / sqrtf(wave_sum(s) * (1.f / D) + RMS_EPS);
#pragma unroll
    for (int j = 0; j < 4; ++j) { const f32x4 g = wr[64 * j]; xr[64 * j] = v[j] * rstd * g; }
}

__device__ __forceinline__ void attnA_naive_item(const bf16* QKV, bf16* Y, int b, int h, int tb, int lane) {
    const int t = tb * 64 + lane; const size_t row = (size_t)b * T + t;
    float q[64], o[64];
#pragma unroll
    for (int c = 0; c < 8; ++c) ld8f(QKV + row * NQKV + h * 64 + 8 * c, q + 8 * c);
#pragma unroll
    for (int e = 0; e < 64; ++e) { q[e] *= 0.125f; o[e] = 0.f; }
    float m = -1e30f, l = 0.f;
#define A_KEY(tk, cw) do { const bf16* kr = QKV + ((size_t)b * T + (tk)) * NQKV + 512 + h * 64; float s = 0.f; \
    _Pragma("unroll") for (int c = 0; c < 8; ++c) { float kf[8]; ld8f(kr + 8 * c, kf); _Pragma("unroll") for (int e = 0; e < 8; ++e) s += q[8 * c + e] * kf[e]; } \
    const float mn = fmaxf(m, s); const float sc = __expf(m - mn); const float p = (cw) * __expf(s - mn); l = l * sc + p; m = mn; \
    const bf16* vr = kr + 512; \
    _Pragma("unroll") for (int c = 0; c < 8; ++c) { float vf[8]; ld8f(vr + 8 * c, vf); _Pragma("unroll") for (int e = 0; e < 8; ++e) o[8 * c + e] = o[8 * c + e] * sc + p * vf[e]; } } while (0)
    for (int d = 0; d <= 128 && d <= t; ++d) { const float cw = 1.f + ((d & 3) == 0 ? 1.f : 0.f) + ((d & 15) == 0 ? 1.f : 0.f); A_KEY(t - d, cw); }
    for (int d = 132; d <= 512 && d <= t; d += 4) { const float cw = 1.f + ((d & 15) == 0 ? 1.f : 0.f); A_KEY(t - d, cw); }
    for (int d = 528; d <= t; d += 16) { A_KEY(t - d, 1.f); }
#undef A_KEY
    const float il = 1.f / l;
#pragma unroll
    for (int e = 0; e < 64; ++e) o[e] *= il;
#pragma unroll
    for (int c = 0; c < 8; ++c) st8f(Y + row * D + h * 64 + 8 * c, o + 8 * c);
}
__device__ __forceinline__ void attnB_naive_item(const bf16* QKV, bf16* OB, int b, int hv, int tb, int lane, float qscale) {
    const int h = hv >> 2, c2 = (hv >> 1) & 1, vh = hv & 1;
    const bf16* Qp = QKV + 1536 + h * 128 + c2 * 64; const bf16* Kp = QKV + 2048 + h * 128 + c2 * 64; const bf16* Vp = QKV + 2560 + h * 128 + vh * 64;
    const int t = tb * 64 + lane; const size_t row = (size_t)b * T + t;
    float q[64], o[64];
#pragma unroll
    for (int c = 0; c < 8; ++c) ld8f(Qp + row * NQKV + 8 * c, q + 8 * c);
#pragma unroll
    for (int e = 0; e < 64; ++e) { q[e] *= qscale; o[e] = 0.f; }
    float m = -1e30f, l = 0.f;
    const int nk = tb * 64 + 64;
    for (int kk = 0; kk < nk; ++kk) {
        const bf16* kr = Kp + ((size_t)b * T + kk) * NQKV; float s = 0.f;
#pragma unroll
        for (int c = 0; c < 8; ++c) { float kf[8]; ld8f(kr + 8 * c, kf);
#pragma unroll
            for (int e = 0; e < 8; ++e) s += q[8 * c + e] * kf[e]; }
        const bool valid = kk <= t; const float sv = valid ? s : -1e30f;
        const float mn = fmaxf(m, sv); const float sc = __expf(m - mn); const float p = valid ? __expf(sv - mn) : 0.f; l = l * sc + p; m = mn;
        const bf16* vr = Vp + ((size_t)b * T + kk) * NQKV;
#pragma unroll
        for (int c = 0; c < 8; ++c) { float vf[8]; ld8f(vr + 8 * c, vf);
#pragma unroll
            for (int e = 0; e < 8; ++e) o[8 * c + e] = o[8 * c + e] * sc + p * vf[e]; }
    }
    const float il = 1.f / l;
#pragma unroll
    for (int e = 0; e < 64; ++e) o[e] *= il;
#pragma unroll
    for (int c = 0; c < 8; ++c) st8f(OB + row * D + hv * 64 + 8 * c, o + 8 * c);
}
__device__ __forceinline__ void attnB_post_row(const bf16* OB, bf16* Y, const float* subw, float lam, float outscale, size_t row, int lane) {
    const int h = lane >> 4, sub = lane & 15, vh = sub >> 3, d0 = (sub & 7) * 8;
    float a[8], b[8], r[8];
    ld8f(OB + row * D + ((h * 2 + 0) * 2 + vh) * 64 + d0, a); ld8f(OB + row * D + ((h * 2 + 1) * 2 + vh) * 64 + d0, b);
    float ss = 0.f;
#pragma unroll
    for (int e = 0; e < 8; ++e) { r[e] = a[e] - lam * b[e]; ss += r[e] * r[e]; }
    ss += __shfl_xor(ss, 1); ss += __shfl_xor(ss, 2); ss += __shfl_xor(ss, 4); ss += __shfl_xor(ss, 8);
    const float rstd = 1.f / sqrtf(ss * (1.f / 128.f) + RMS_EPS);
    const int dv = vh * 64 + d0;
#pragma unroll
    for (int e = 0; e < 8; ++e) r[e] = r[e] * rstd * subw[dv + e] * outscale;
    st8f(Y + row * D + 512 + h * 128 + dv, r);
}
__device__ __forceinline__ void mamba_naive_unit(LAS unsigned char* L, const bf16* XBC, const float* GT, bf16* YM, const float* cw, const float* cb, const float* dtb, const float* alog, const float* dsk, int b, int g, int tid) {
    LAS float* BC = (LAS float*)L;
    LAS float* DT = (LAS float*)(L + 8192);
    const int hl = tid >> 6, p = tid & 63, head = g * 8 + hl, colx = head * 64 + p;
    const float w0 = cw[colx], w1 = cw[1536 + colx], w2 = cw[2 * 1536 + colx], w3 = cw[3 * 1536 + colx], bb = cb[colx];
    float h0 = 0.f, h1 = 0.f, h2 = 0.f;
    const int colbc = 1024 + ((tid & 255) < 128 ? g * 128 + (tid & 255) : 256 + g * 128 + ((tid & 255) - 128));
    const float v0 = cw[colbc], v1 = cw[1536 + colbc], v2 = cw[2 * 1536 + colbc], v3 = cw[3 * 1536 + colbc], vb = cb[colbc];
    float g0 = 0.f, g1 = 0.f, g2 = 0.f;
    const float dskh = dsk[head];
    float S[128];
#pragma unroll
    for (int n = 0; n < 128; ++n) S[n] = 0.f;
    for (int t0 = 0; t0 < T; t0 += 8) {
        if (tid < 256) {
#pragma unroll
            for (int s = 0; s < 8; ++s) { const float raw = bf2f(XBC[((size_t)b * T + t0 + s) * 1536 + colbc]); const float v = v0 * g0 + v1 * g1 + v2 * g2 + v3 * raw + vb; g0 = g1; g1 = g2; g2 = raw; BC[s * 256 + tid] = silu_g(v); }
        } else if (tid < 320) {
            const int s = (tid - 256) >> 3, hh = (tid - 256) & 7, hd2 = g * 8 + hh;
            const float x = GT[((size_t)b * T + t0 + s) * 32 + hd2] + dtb[hd2]; const float dt = x > 20.f ? x : log1pf(expf(x));
            DT[s * 8 + hh] = dt; DT[64 + s * 8 + hh] = expf(-dt * expf(alog[hd2]));
        }
        __syncthreads();
#pragma unroll 1
        for (int s = 0; s < 8; ++s) {
            const size_t row = (size_t)b * T + t0 + s;
            const float raw = bf2f(XBC[row * 1536 + colx]); const float v = w0 * h0 + w1 * h1 + w2 * h2 + w3 * raw + bb; h0 = h1; h1 = h2; h2 = raw;
            const float xv = silu_g(v), dt = DT[s * 8 + hl], dA = DT[64 + s * 8 + hl], coef = dt * xv;
            float acc = 0.f;
#pragma unroll
            for (int n4 = 0; n4 < 32; ++n4) { const f32x4 Bv = *(const LAS f32x4*)(BC + s * 256 + 4 * n4), Cv = *(const LAS f32x4*)(BC + s * 256 + 128 + 4 * n4);
#pragma unroll
                for (int j = 0; j < 4; ++j) { S[4 * n4 + j] = dA * S[4 * n4 + j] + coef * Bv[j]; acc += Cv[j] * S[4 * n4 + j]; } }
            YM[row * D + colx] = (bf16)f2bf(acc + dskh * xv);
        }
        __syncthreads();
    }
}
__device__ __forceinline__ void mlstm_naive_unit(LAS unsigned char* L, const bf16* U, bf16* V, const float* GT, const float* cw, const float* cb, const float* wq, const float* wk, const float* ib, const float* fb, int b, int h, int vh, int tid) {
    LAS float* UC = (LAS float*)L;
    LAS float* Q8 = (LAS float*)(L + 8192);
    LAS float* K8 = (LAS float*)(L + 8192 + 8704);
    LAS float* IF = (LAS float*)(L + 8192 + 2 * 8704);
    const int vl = tid >> 2, kq = tid & 3, colv = h * 256 + vh * 128 + vl;
    const int ju = tid & 255, colu = h * 256 + ju;
    const float w0 = cw[colu], w1 = cw[1024 + colu], w2 = cw[2048 + colu], w3 = cw[3072 + colu], bu = cb[colu];
    float h0 = 0.f, h1 = 0.f, h2 = 0.f;
    float wqv[4], wkv[4];
    { const int nblk = h * 64 + (ju >> 2), i = ju & 3;
#pragma unroll
      for (int jj = 0; jj < 4; ++jj) { wqv[jj] = wq[(nblk * 4 + jj) * 4 + i]; wkv[jj] = wk[(nblk * 4 + jj) * 4 + i] * 0.0625f; } }
    float C[64], N[64];
#pragma unroll
    for (int j = 0; j < 64; ++j) { C[j] = 0.f; N[j] = 0.f; }
    const float ibh = ib[h], fbh = fb[h];
    for (int t0 = 0; t0 < T; t0 += 8) {
        if (tid < 256) {
#pragma unroll
            for (int s = 0; s < 8; ++s) { const float raw = bf2f(U[((size_t)b * T + t0 + s) * D + colu]); const float v = w0 * h0 + w1 * h1 + w2 * h2 + w3 * raw + bu; h0 = h1; h1 = h2; h2 = raw; UC[s * 256 + tid] = silu_g(v); }
        } else if (tid < 264) {
            const int s = tid - 256; const size_t row = (size_t)b * T + t0 + s;
            IF[2 * s] = expf(GT[row * 32 + 16 + h] + ibh); IF[2 * s + 1] = sigm_g(GT[row * 32 + 20 + h] + fbh);
        }
        __syncthreads();
        if (tid < 256) {
#pragma unroll
            for (int s = 0; s < 8; ++s) { const f32x4 u4 = *(const LAS f32x4*)(UC + s * 256 + (tid & ~3));
                const float qv = u4[0] * wqv[0] + u4[1] * wqv[1] + u4[2] * wqv[2] + u4[3] * wqv[3], kv = u4[0] * wkv[0] + u4[1] * wkv[1] + u4[2] * wkv[2] + u4[3] * wkv[3];
                Q8[s * 272 + (tid >> 6) * 68 + (tid & 63)] = qv; K8[s * 272 + (tid >> 6) * 68 + (tid & 63)] = kv; }
        }
        __syncthreads();
#pragma unroll 1
        for (int s = 0; s < 8; ++s) {
            const size_t row = (size_t)b * T + t0 + s;
            const float vt = bf2f(V[row * D + colv]), ig = IF[2 * s], f = IF[2 * s + 1], iv = ig * vt;
            float num = 0.f, den = 0.f;
#pragma unroll
            for (int j4 = 0; j4 < 16; ++j4) { const f32x4 kv = *(const LAS f32x4*)(K8 + s * 272 + kq * 68 + 4 * j4), qv = *(const LAS f32x4*)(Q8 + s * 272 + kq * 68 + 4 * j4);
#pragma unroll
                for (int j = 0; j < 4; ++j) { C[4 * j4 + j] = f * C[4 * j4 + j] + iv * kv[j]; N[4 * j4 + j] = f * N[4 * j4 + j] + ig * kv[j]; num += C[4 * j4 + j] * qv[j]; den += N[4 * j4 + j] * qv[j]; } }
            num += __shfl_xor(num, 1); num += __shfl_xor(num, 2); den += __shfl_xor(den, 1); den += __shfl_xor(den, 2);
            const float hv = num / fmaxf(fabsf(den), 1.f);
            if (kq == 0) V[row * D + colv] = (bf16)f2bf(hv);
        }
        __syncthreads();
    }
}
__device__ __forceinline__ void gate_row(const bf16* YM, const bf16* Z, const bf16* HD, const bf16* OP, bf16* YCD, const float* cnw, const float* dnw, size_t row, int lane) {
    float y[16], z[16];
    ld8f(YM + row * D + lane * 16, y); ld8f(YM + row * D + lane * 16 + 8, y + 8); ld8f(Z + row * D + lane * 16, z); ld8f(Z + row * D + lane * 16 + 8, z + 8);
    float ss = 0.f;
#pragma unroll
    for (int e = 0; e < 16; ++e) { y[e] = y[e] * silu_g(z[e]); ss += y[e] * y[e]; }
    ss = wave_sum(ss); float rstd = 1.f / sqrtf(ss * (1.f / 1024.f) + RMS_EPS);
#pragma unroll
    for (int e = 0; e < 16; ++e) y[e] = y[e] * rstd * cnw[lane * 16 + e];
    st8f(YCD + row * KCD + lane * 16, y); st8f(YCD + row * KCD + lane * 16 + 8, y + 8);
    ld8f(HD + row * D + lane * 16, y); ld8f(HD + row * D + lane * 16 + 8, y + 8); ld8f(OP + row * D + lane * 16, z); ld8f(OP + row * D + lane * 16 + 8, z + 8);
    ss = 0.f;
#pragma unroll
    for (int e = 0; e < 16; ++e) ss += y[e] * y[e];
    ss += __shfl_xor(ss, 1); ss += __shfl_xor(ss, 2); ss += __shfl_xor(ss, 4); ss += __shfl_xor(ss, 8);
    rstd = 1.f / sqrtf(ss * (1.f / 256.f) + RMS_EPS);
#pragma unroll
    for (int e = 0; e < 16; ++e) y[e] = sigm_g(z[e]) * y[e] * rstd * dnw[lane * 16 + e];
    st8f(YCD + row * KCD + 1024 + lane * 16, y); st8f(YCD + row * KCD + 1024 + lane * 16 + 8, y + 8);
}

struct Args { const float* in[28]; float* out; unsigned char* ws; int ph_lo, ph_hi; };
__global__ void __launch_bounds__(NWAVES * 64, 2) fwd_kernel(Args args) {
    extern __shared__ __attribute__((aligned(16))) unsigned char lds[];
    LAS unsigned char* L = (LAS unsigned char*)lds;
    volatile LAS unsigned* MISC = (volatile LAS unsigned*)(L + MISC_OFF);
    const int tid = threadIdx.x, lane = tid & 63, wave = __builtin_amdgcn_readfirstlane(tid >> 6);
    const int G = gridDim.x, bx = blockIdx.x; const int vcu = (G % 8 == 0) ? (bx % 8) * (G / 8) + bx / 8 : bx;
    const int gw = vcu * NWAVES + wave, NGW = G * NWAVES;
    unsigned char* ws = args.ws;
    gu32* ctl = (gu32*)(ws + WS_CTL);
    for (int u = tid; u < (LDS_BYTES - LDSCTL_OFF) / 4; u += NWAVES * 64) ((LAS unsigned*)(L + LDSCTL_OFF))[u] = 0u;
    __syncthreads();
    XcdBarrier bar; bar.bar = (unsigned*)(ctl + CW_BAR); bar.x = 0; bar.st = nullptr;
    if (MK_ONE_LAUNCH) bar = xcd_barrier_post((unsigned*)(ctl + CW_BAR), MISC + 8);
    const int lo = args.ph_lo, hi = args.ph_hi;
#define IN(k) (lo <= (k) && (k) < hi)
#define SEAM(k) do { if (MK_ONE_LAUNCH && IN(k) && IN((k) + 1)) xcd_barrier(bar); } while (0)
    const float* x = args.in[0]; float* out = args.out;
    bf16* W_ABIN = (bf16*)(ws + WS_W_ABIN); bf16* W_ABOUT = (bf16*)(ws + WS_W_ABOUT); bf16* W_GU0 = (bf16*)(ws + WS_W_GU0); bf16* W_DN0 = (bf16*)(ws + WS_W_DN0);
    bf16* W_CDIN = (bf16*)(ws + WS_W_CDIN); bf16* W_CDOUT = (bf16*)(ws + WS_W_CDOUT); bf16* W_GU1 = (bf16*)(ws + WS_W_GU1); bf16* W_DN1 = (bf16*)(ws + WS_W_DN1);
    bf16* XN = (bf16*)(ws + WS_XN); bf16* OB = (bf16*)(ws + WS_OB); bf16* QKV = (bf16*)(ws + WS_QKV); bf16* ACT = (bf16*)(ws + WS_ACT);
    bf16* ZB = (bf16*)(ws + WS_Z); bf16* XBC = (bf16*)(ws + WS_XBC); bf16* UB = (bf16*)(ws + WS_U); bf16* VB = (bf16*)(ws + WS_V); bf16* OPB = (bf16*)(ws + WS_O); bf16* YCD = (bf16*)(ws + WS_YCD);
    float* GT = (float*)(ws + WS_GATES);

    if (IN(0)) {
        LAS float* scr = (LAS float*)(L + RING_OFF + wave * 16384);
        constexpr int I0 = 16 * 96, I1 = 16 * 32, I2 = 16 * 176, I3 = 44 * 32, I4 = 16 * 184, I5 = 32 * 32;
        constexpr int NITEMS = I0 + I1 + 2 * I2 + 2 * I3 + I4 + I5;
        for (int it = gw; it < NITEMS; it += NGW) {
            int r = it;
            if (r < I0) { tr_item<0>(args.in[3], D, NQKV, W_ABIN, NQKV / 32, scr, r, lane); continue; } r -= I0;
            if (r < I1) { tr_item<0>(args.in[4], D, D, W_ABOUT, D / 32, scr, r, lane); continue; } r -= I1;
            if (r < I2) { tr_item<1>(args.in[25], D, NGU, W_GU0, NGU / 32, scr, r, lane); continue; } r -= I2;
            if (r < I3) { tr_item<0>(args.in[26], FF, D, W_DN0, D / 32, scr, r, lane); continue; } r -= I3;
            if (r < I4) { tr_item<2>(args.in[10], D, NZX_SRC, W_CDIN, NZX / 32, scr, r, lane); continue; } r -= I4;
            if (r < I5) { tr_item<0>(args.in[24], KCD, D, W_CDOUT, D / 32, scr, r, lane); continue; } r -= I5;
            if (r < I2) { tr_item<1>(args.in[25] + (size_t)D * NGU, D, NGU, W_GU1, NGU / 32, scr, r, lane); continue; } r -= I2;
            tr_item<0>(args.in[26] + (size_t)FF * D, FF, D, W_DN1, D / 32, scr, r, lane);
        }
        for (int m = gw; m < M; m += NGW) rms_row_to_bf16(x + (size_t)m * D, args.in[1], XN + (size_t)m * D, lane);
    }
    SEAM(0);
    if (IN(1)) {
        pg8::Gemm g{XN, W_ABIN, M, NQKV, D}; pg8::StaticOrder S; S.init(M, NQKV, G, bx);
        pg8::EpiQKV E{QKV, NQKV, 0, 0, 1.f};
        pg8::gemm_phase<pg8::EpiQKV, pg8::StaticOrder, true, true>(L + RING_OFF, g, S, E);
    }
    SEAM(1);
    if (IN(2)) {
        bf16* Y = XN;
        for (int it = gw; it < NBATCH * 16 * 32; it += NGW) { const int bh = it >> 5, tbs = it & 31, r = it / NGW, tb = (r & 1) ? 31 - tbs : tbs;
            attnB_naive_item(QKV, OB, bh >> 4, bh & 15, tb, lane, 0.125f); }
        for (int it = gw; it < NBATCH * 8 * 32; it += NGW) { const int bh = it >> 5, tbs = it & 31, r = it / NGW, tb = (r & 1) ? 31 - tbs : tbs;
            attnA_naive_item(QKV, Y, bh >> 3, bh & 7, tb, lane); }
    }
    SEAM(2);
    if (IN(3)) {
        bf16* Y = XN;
        const float s1 = wave_sum(args.in[5][lane] * args.in[6][lane]), s2 = wave_sum(args.in[7][lane] * args.in[8][lane]);
        const float lam = expf(s1) - expf(s2) + 0.2f;
        for (int m = gw; m < M; m += NGW) attnB_post_row(OB, Y, args.in[9], lam, 0.8f, (size_t)m, lane);
    }
    SEAM(3);
    if (IN(4)) {
        pg8::Gemm g{XN, W_ABOUT, M, D, D}; pg8::StaticOrder S; S.init(M, D, G, bx);
        pg8::EpiResid E{x, out, D};
        pg8::gemm_phase<pg8::EpiResid, pg8::StaticOrder, true, true>(L + RING_OFF, g, S, E);
    }
    SEAM(4);
    if (IN(5)) { for (int m = gw; m < M; m += NGW) rms_row_to_bf16(out + (size_t)m * D, args.in[2], XN + (size_t)m * D, lane); }
    SEAM(5);
    if (IN(6)) {
        pg8::Gemm g{XN, W_GU0, M, NGU, D}; pg8::StaticOrder S; S.init(M, NGU, G, bx);
        pg8::EpiSwiglu E{ACT, FF};
        pg8::gemm_phase<pg8::EpiSwiglu, pg8::StaticOrder, true, true>(L + RING_OFF, g, S, E);
    }
    SEAM(6);
    if (IN(7)) {
        pg8::Gemm g{ACT, W_DN0, M, D, FF}; pg8::StaticOrder S; S.init(M, D, G, bx);
        pg8::EpiResid E{out, out, D};
        pg8::gemm_phase<pg8::EpiResid, pg8::StaticOrder, true, true>(L + RING_OFF, g, S, E);
    }
    SEAM(7);
    if (IN(8)) { for (int m = gw; m < M; m += NGW) rms_row_to_bf16(out + (size_t)m * D, args.in[1] + D, XN + (size_t)m * D, lane); }
    SEAM(8);
    if (IN(9)) {
        pg8::Gemm g{XN, W_CDIN, M, NZX, D}; pg8::StaticOrder S; S.init(M, NZX, G, bx);
        pg8::EpiZX E{ZB, XBC, UB, VB, OPB, GT};
        pg8::gemm_phase<pg8::EpiZX, pg8::StaticOrder, true, true>(L + RING_OFF, g, S, E);
    }
    SEAM(9);
    if (IN(10)) {
        bf16* YM = XN;
        for (int it = bx; it < 256 + 64; it += G) {
            if (it < 256) mlstm_naive_unit(L, UB, VB, GT, args.in[17], args.in[18], args.in[19], args.in[20], args.in[21], args.in[22], it >> 3, (it >> 1) & 3, it & 1, tid);
            else mamba_naive_unit(L, XBC, GT, YM, args.in[11], args.in[12], args.in[13], args.in[14], args.in[15], (it - 256) >> 1, (it - 256) & 1, tid);
        }
    }
    SEAM(10);
    if (IN(11)) { for (int m = gw; m < M; m += NGW) gate_row(XN, ZB, VB, OPB, YCD, args.in[16], args.in[23], (size_t)m, lane); }
    SEAM(11);
    if (IN(12)) {
        pg8::Gemm g{YCD, W_CDOUT, M, D, KCD}; pg8::StaticOrder S; S.init(M, D, G, bx);
        pg8::EpiResid E{out, out, D};
        pg8::gemm_phase<pg8::EpiResid, pg8::StaticOrder, true, true>(L + RING_OFF, g, S, E);
    }
    SEAM(12);
    if (IN(13)) { for (int m = gw; m < M; m += NGW) rms_row_to_bf16(out + (size_t)m * D, args.in[2] + D, XN + (size_t)m * D, lane); }
    SEAM(13);
    if (IN(14)) {
        pg8::Gemm g{XN, W_GU1, M, NGU, D}; pg8::StaticOrder S; S.init(M, NGU, G, bx);
        pg8::EpiSwiglu E{ACT, FF};
        pg8::gemm_phase<pg8::EpiSwiglu, pg8::StaticOrder, true, true>(L + RING_OFF, g, S, E);
    }
    SEAM(14);
    if (IN(15)) {
        pg8::Gemm g{ACT, W_DN1, M, D, FF}; pg8::StaticOrder S; S.init(M, D, G, bx);
        pg8::EpiResid E{out, out, D};
        pg8::gemm_phase<pg8::EpiResid, pg8::StaticOrder, true, true>(L + RING_OFF, g, S, E);
    }
    SEAM(15);
    if (IN(16)) { for (int m = gw; m < M; m += NGW) rms_row_inplace_f32(out + (size_t)m * D, args.in[27], lane); }
#undef IN
#undef SEAM
}

extern "C" void kernel_launch(void* const* d_in, const int* in_sizes, int n_in, void* d_out, int out_size, void* d_ws, size_t ws_size, hipStream_t stream) {
    static int grid = 0;
    if (grid == 0) {
        if (n_in != 28 || in_sizes[0] != M * D || out_size != M * D || ws_size < WS_END) { fprintf(stderr, "kernel_launch: unexpected shapes / workspace (%d inputs, ws %zu < %zu); nothing launched\n", n_in, ws_size, (size_t)WS_END); grid = -1; return; }
        int dev = 0, cus = 0;
        if (hipGetDevice(&dev) != hipSuccess || hipDeviceGetAttribute(&cus, hipDeviceAttributeMultiprocessorCount, dev) != hipSuccess) { grid = -1; return; }
        if (hipFuncSetAttribute((const void*)fwd_kernel, hipFuncAttributeMaxDynamicSharedMemorySize, LDS_BYTES) != hipSuccess) { grid = -1; return; }
        int per_cu = 0;
        if (hipOccupancyMaxActiveBlocksPerMultiprocessor(&per_cu, (const void*)fwd_kernel, NWAVES * 64, LDS_BYTES) != hipSuccess || per_cu < 1) fprintf(stderr, "kernel_launch: occupancy query reports %d\n", per_cu);
        (void)hipGetLastError();
        grid = cus;
    }
    if (grid < 0) return;
    if (hipMemsetAsync((char*)d_ws + WS_CTL, 0, CTL_ZERO_BYTES, stream) != hipSuccess) return;
    Args a{};
    for (int i = 0; i < 28; ++i) a.in[i] = (const float*)d_in[i];
    a.out = (float*)d_out; a.ws = (unsigned char*)d_ws;
#if MK_ONE_LAUNCH
    a.ph_lo = 0; a.ph_hi = NPH;
    hipLaunchKernelGGL(fwd_kernel, dim3(grid), dim3(NWAVES * 64), LDS_BYTES, stream, a);
#else
    for (int p = 0; p < NPH; ++p) { a.ph_lo = p; a.ph_hi = p + 1; hipLaunchKernelGGL(fwd_kernel, dim3(grid), dim3(NWAVES * 64), LDS_BYTES, stream, a); }
#endif
}
```

```cpp
#include <hip/hip_runtime.h>
#include <cstdio>
#include <cstdint>
#ifndef MK_ONE_LAUNCH
#define MK_ONE_LAUNCH 1
#endif
#define PROBE_G 0
#define PROBE_T 0
#define PROBE_LO 0
#define PROBE_HI 0
namespace pg8 {
#define PG8_LAS __attribute__((address_space(3)))
typedef unsigned short bf16_t;
typedef short bf16x8 __attribute__((ext_vector_type(8)));
typedef float f32x4 __attribute__((ext_vector_type(4)));
typedef unsigned u32x4 __attribute__((ext_vector_type(4)));
constexpr int BM = 256, BK = 64, HALF = 128, HTB = HALF * BK * 2  , STAGE_BYTES = 8 * HTB, NXCD = 8, WGM = 4;

__host__ __device__ __forceinline__ int lds_byte(int r, int c) { const int st = (r >> 4) * 2 + (c >> 5), rr = r & 15, cc = c & 31, ob = rr * 64 + cc * 2; return st * 1024 + (ob ^ (((ob >> 9) & 1) << 5)); }
__host__ __device__ __forceinline__ void stage_rc(int b, int& R, int& C) { const int st = b / 1024, sb = b % 1024, swz = sb ^ (((sb >> 9) & 1) << 5); R = (st >> 1) * 16 + swz / 64; C = (st & 1) * 32 + (swz % 64) / 2; }
__host__ __device__ __forceinline__ int perm32(int rho) { const int n = rho >> 4, i = rho & 15; return 8 * (i >> 2) + 4 * n + (i & 3); }

struct Unit { int pm, pn; };
struct Gemm { const bf16_t* A; const bf16_t* Bt; int M, N, K; const float* ps; const float* wq; };

struct StaticOrder {
    int nM, nN, nwg, G, c, wgm;
    __host__ __device__ void init(int M, int N, int G_, int c_, int wgm_ = WGM) { nM = M / BM; nN = N / BM; nwg = nM * nN; G = G_; c = c_; wgm = wgm_; }
    __host__ __device__ bool next(int i, Unit& u) const {
        const long L = (long)i * G + c; if (L >= nwg) return false;
        int wgid = (int)L; { const int q = nwg / NXCD, r = nwg % NXCD, xcd = wgid % NXCD, off = wgid / NXCD; wgid = (xcd < r ? xcd * (q + 1) : r * (q + 1) + (xcd - r) * q) + off; }
        const int nig = wgm * nN, gid = wgid / nig, fm = gid * wgm, gsz = (nM - fm) < wgm ? (nM - fm) : wgm;
        u.pm = fm + ((wgid % nig) % gsz); u.pn = (wgid % nig) / gsz; return true;
    }
    __device__ __forceinline__ void a_ready(const Unit&) const {}
    __device__ __forceinline__ void done(const Unit&) const {}
};

__device__ __forceinline__ unsigned cvt_pk_bf16(float lo, float hi) { unsigned r; asm volatile("v_cvt_pk_bf16_f32 %0, %1, %2" : "=v"(r) : "v"(lo), "v"(hi)); return r; }
typedef float f32x2 __attribute__((ext_vector_type(2)));
typedef int i32x4 __attribute__((ext_vector_type(4)));
typedef int i32x8 __attribute__((ext_vector_type(8)));
__device__ __forceinline__ i32x8 cat8(bf16x8 a, bf16x8 b) { const i32x4 x = __builtin_bit_cast(i32x4, a), y = __builtin_bit_cast(i32x4, b); return __builtin_shufflevector(x, y, 0, 1, 2, 3, 4, 5, 6, 7); }
__device__ __forceinline__ float clamp8(float v) { return __builtin_fminf(__builtin_fmaxf(v, -448.f), 448.f); }
__device__ __forceinline__ unsigned pk4_fp8(float a, float b, float c, float d) { int w = 0; w = __builtin_amdgcn_cvt_pk_fp8_f32(clamp8(a), clamp8(b), w, false); w = __builtin_amdgcn_cvt_pk_fp8_f32(clamp8(c), clamp8(d), w, true); return (unsigned)w; }
constexpr float ACT8_SC = 8.f, W8_SC = 64.f;
__device__ __forceinline__ float silu_f(float x) { return x * __builtin_amdgcn_rcpf(1.f + __expf(-x)); }
__device__ __forceinline__ float row_rstd(const PG8_LAS f32x4* rst, int rl) { const f32x4 p = rst[rl]; return 1.f / sqrtf(((p[0] + p[1]) + (p[2] + p[3])) * (1.f / 1024.f) + 1e-6f); }
struct EpiQKV {
    static constexpr bool PERM = true, AFTER_DRAIN = false, RSTD = false, FP8 = false, I8 = false;
    bf16_t* O; int ldc; int sa_lo, sa_hi, sc_lo, sc_hi; float scale;
    __device__ __forceinline__ void operator()(const f32x4 (&acc)[2][2][4][2], const Unit& u, int wr, int wc, int fr, int fq) const {
        const int row0 = u.pm * BM + wr * 64 + fr, col0 = u.pn * BM + wc * 32 + 8 * fq;
        const float sc = ((u.pn >= sc_lo && u.pn < sc_hi) || (u.pn >= sa_lo && u.pn < sa_hi)) ? scale : 1.f;
#pragma unroll
        for (int ai = 0; ai < 2; ++ai)
#pragma unroll
            for (int m = 0; m < 4; ++m) { bf16_t* rowp = O + (size_t)(row0 + ai * HALF + m * 16) * ldc + col0;
#pragma unroll
                for (int bj = 0; bj < 2; ++bj) { const f32x4 v0 = acc[ai][bj][m][0] * sc, v1 = acc[ai][bj][m][1] * sc;
                    u32x4 w; w.x = cvt_pk_bf16(v0[0], v0[1]); w.y = cvt_pk_bf16(v0[2], v0[3]); w.z = cvt_pk_bf16(v1[0], v1[1]); w.w = cvt_pk_bf16(v1[2], v1[3]);
                    *(u32x4*)(rowp + bj * HALF) = w; } }
    }
};
template <int MODE> struct EpiZX {
    static constexpr bool PERM = true, AFTER_DRAIN = false, RSTD = true, FP8 = false, I8 = (MODE == 2);
    bf16_t *Z, *XBC, *U, *V, *O; float* G;
    static __device__ __forceinline__ f32x4 accf(const f32x4& a) { if constexpr (MODE == 2) return __builtin_convertvector(__builtin_bit_cast(i32x4, a), f32x4); else return a; }
    __device__ __forceinline__ void operator()(const f32x4 (&acc)[2][2][4][2], const Unit& u, int wr, int wc, int fr, int fq, const PG8_LAS f32x4* rst, const PG8_LAS f32x4* wqt) const {
        const int row0 = u.pm * BM + wr * 64 + fr; const int pn = u.pn;
        f32x4 wq[2][2];
#pragma unroll
        for (int bj = 0; bj < 2; ++bj)
#pragma unroll
            for (int n = 0; n < 2; ++n) { if constexpr (MODE == 2) wq[bj][n] = wqt[32 * bj + 8 * wc + 2 * fq + n]; else wq[bj][n] = (f32x4){1.f, 1.f, 1.f, 1.f}; }

        if (pn == 22) {
            if (wc == 0) {
#pragma unroll
                for (int ai = 0; ai < 2; ++ai)
#pragma unroll
                    for (int m = 0; m < 4; ++m) { float* gp = G + (size_t)(row0 + ai * HALF + m * 16) * 32 + 8 * fq; const int rl = ai * HALF + wr * 64 + m * 16 + fr; const float rs = (MODE == 2) ? rst[rl][0] : row_rstd(rst, rl);
                        *(f32x4*)gp = accf(acc[ai][0][m][0]) * (wq[0][0] * rs); *(f32x4*)(gp + 4) = accf(acc[ai][0][m][1]) * (wq[0][1] * rs); }
            }
            return;
        }
        bf16_t* base; int ldc, colt;
        if (pn < 4) { base = Z; ldc = 1024; colt = pn * 256; }
        else if (pn < 10) { base = XBC; ldc = 1536; colt = (pn - 4) * 256; }
        else if (pn < 14) { base = U; ldc = 1024; colt = (pn - 10) * 256; }
        else if (pn < 18) { base = V; ldc = 1024; colt = (pn - 14) * 256; }
        else { base = O; ldc = 1024; colt = (pn - 18) * 256; }
        const int col0 = colt + wc * 32 + 8 * fq;
#pragma unroll
        for (int ai = 0; ai < 2; ++ai)
#pragma unroll
            for (int m = 0; m < 4; ++m) { bf16_t* rowp = base + (size_t)(row0 + ai * HALF + m * 16) * ldc + col0; const int rl = ai * HALF + wr * 64 + m * 16 + fr; const float rs = (MODE == 2) ? rst[rl][0] : row_rstd(rst, rl);
#pragma unroll
                for (int bj = 0; bj < 2; ++bj) { const f32x4 v0 = accf(acc[ai][bj][m][0]) * (wq[bj][0] * rs), v1 = accf(acc[ai][bj][m][1]) * (wq[bj][1] * rs);
                    u32x4 w; w.x = cvt_pk_bf16(v0[0], v0[1]); w.y = cvt_pk_bf16(v0[2], v0[3]); w.z = cvt_pk_bf16(v1[0], v1[1]); w.w = cvt_pk_bf16(v1[2], v1[3]);
                    *(u32x4*)(rowp + bj * HALF) = w; } }
    }
};
template <bool O8, int MODE> struct EpiSwiglu {
    static constexpr bool PERM = true, AFTER_DRAIN = false, RSTD = true, FP8 = false, I8 = (MODE == 2);
    unsigned char* O; int ldc; float wdq;
    __device__ __forceinline__ void operator()(const f32x4 (&acc)[2][2][4][2], const Unit& u, int wr, int wc, int fr, int fq, const PG8_LAS f32x4* rst, const PG8_LAS f32x4* wqt) const {
        const int row0 = u.pm * BM + wr * 64 + fr, col0 = u.pn * HALF + wc * 32 + 8 * fq;
        f32x4 wg0, wg1, wu0, wu1;
        if constexpr (MODE == 2) { const int q = 8 * wc + 2 * fq; wg0 = wqt[q]; wg1 = wqt[q + 1]; wu0 = wqt[32 + q]; wu1 = wqt[32 + q + 1]; }
#pragma unroll
        for (int ai = 0; ai < 2; ++ai)
#pragma unroll
            for (int m = 0; m < 4; ++m) {
                const int rl = ai * HALF + wr * 64 + m * 16 + fr;
                f32x4 g0, g1, u0, u1;
                if constexpr (MODE == 2) { const float rs = rst[rl][0];
                    g0 = __builtin_convertvector(__builtin_bit_cast(i32x4, acc[ai][0][m][0]), f32x4) * (wg0 * rs); g1 = __builtin_convertvector(__builtin_bit_cast(i32x4, acc[ai][0][m][1]), f32x4) * (wg1 * rs);
                    u0 = __builtin_convertvector(__builtin_bit_cast(i32x4, acc[ai][1][m][0]), f32x4) * (wu0 * rs); u1 = __builtin_convertvector(__builtin_bit_cast(i32x4, acc[ai][1][m][1]), f32x4) * (wu1 * rs); }
                else { const float rs = row_rstd(rst, rl); g0 = acc[ai][0][m][0] * rs; g1 = acc[ai][0][m][1] * rs; u0 = acc[ai][1][m][0] * rs; u1 = acc[ai][1][m][1] * rs; }
                float r[8];
#pragma unroll
                for (int j = 0; j < 4; ++j) { r[j] = silu_f(g0[j]) * u0[j]; r[4 + j] = silu_f(g1[j]) * u1[j]; }
                if constexpr (O8) { typedef unsigned u32x2 __attribute__((ext_vector_type(2)));
                    u32x2 w; w.x = pk4_fp8(r[0] * ACT8_SC, r[1] * ACT8_SC, r[2] * ACT8_SC, r[3] * ACT8_SC); w.y = pk4_fp8(r[4] * ACT8_SC, r[5] * ACT8_SC, r[6] * ACT8_SC, r[7] * ACT8_SC);
                    *(u32x2*)(O + (size_t)(row0 + ai * HALF + m * 16) * ldc + col0) = w; }
                else { u32x4 w; w.x = cvt_pk_bf16(r[0], r[1]); w.y = cvt_pk_bf16(r[2], r[3]); w.z = cvt_pk_bf16(r[4], r[5]); w.w = cvt_pk_bf16(r[6], r[7]);
                    *(u32x4*)((bf16_t*)O + (size_t)(row0 + ai * HALF + m * 16) * ldc + col0) = w; } }
    }
};
template <bool SRC_F32, bool PART, bool F8> struct EpiResidBf {
    static constexpr bool PERM = true, AFTER_DRAIN = false, RSTD = false, FP8 = F8, I8 = false;
    const float* srcf; bf16_t* H; int ldc; float* ps; PG8_LAS float* red;
    __device__ __forceinline__ void operator()(const f32x4 (&acc)[2][2][4][2], const Unit& u, int wr, int wc, int fr, int fq) const {
        const int row0 = u.pm * BM + wr * 64 + fr, col0 = u.pn * BM + wc * 32 + 8 * fq;
#pragma unroll
        for (int ai = 0; ai < 2; ++ai)
#pragma unroll
            for (int m = 0; m < 4; ++m) { const size_t off = (size_t)(row0 + ai * HALF + m * 16) * ldc + col0; float ss = 0.f;
#pragma unroll
                for (int bj = 0; bj < 2; ++bj) { f32x4 s0, s1;
                    if (SRC_F32) { s0 = *(const f32x4*)(srcf + off + bj * HALF); s1 = *(const f32x4*)(srcf + off + bj * HALF + 4); }
                    else { const u32x4 hv = *(const u32x4*)(H + off + bj * HALF);
                        s0 = (f32x4){__uint_as_float(hv.x << 16), __uint_as_float(hv.x & 0xffff0000u), __uint_as_float(hv.y << 16), __uint_as_float(hv.y & 0xffff0000u)};
                        s1 = (f32x4){__uint_as_float(hv.z << 16), __uint_as_float(hv.z & 0xffff0000u), __uint_as_float(hv.w << 16), __uint_as_float(hv.w & 0xffff0000u)}; }
                    constexpr float dsc = F8 ? 1.f / (ACT8_SC * W8_SC) : 1.f;
                    const f32x4 v0 = s0 + acc[ai][bj][m][0] * dsc, v1 = s1 + acc[ai][bj][m][1] * dsc;
                    if (PART) ss += ((v0[0] * v0[0] + v0[1] * v0[1]) + (v0[2] * v0[2] + v0[3] * v0[3])) + ((v1[0] * v1[0] + v1[1] * v1[1]) + (v1[2] * v1[2] + v1[3] * v1[3]));
                    u32x4 w; w.x = cvt_pk_bf16(v0[0], v0[1]); w.y = cvt_pk_bf16(v0[2], v0[3]); w.z = cvt_pk_bf16(v1[0], v1[1]); w.w = cvt_pk_bf16(v1[2], v1[3]);
                    *(u32x4*)(H + off + bj * HALF) = w; }
                if constexpr (PART) { ss += __shfl_xor(ss, 16); ss += __shfl_xor(ss, 32); if (fq == 0) red[(ai * HALF + wr * 64 + m * 16 + fr) * 4 + wc] = ss; } }
        if constexpr (PART) {
            asm volatile("s_waitcnt lgkmcnt(0)" ::: "memory"); __builtin_amdgcn_s_barrier(); asm volatile("" ::: "memory");
            const int t = threadIdx.x;
            if (t < 256) { const f32x4 r = *(const PG8_LAS f32x4*)(red + t * 4); ps[((size_t)u.pm * BM + t) * 4 + u.pn] = (r[0] + r[1]) + (r[2] + r[3]); }
        }
    }
};

template <class Epi, class Sched, bool ALIGN_EPI = false, bool SP2 = false>
__device__ __forceinline__ void gemm_phase(PG8_LAS unsigned char* lds, const Gemm g, const Sched& S, const Epi& E) {
    const int tid = threadIdx.x, wid = __builtin_amdgcn_readfirstlane(tid >> 6), lane = tid & 63, wr = wid >> 2, wc = wid & 3, fr = lane & 15, fq = lane >> 4;
    const int K = g.K, nt = K / BK;
    unsigned voffA[2], voffB[2];
#pragma unroll
    for (int i = 0; i < 2; ++i) { int R, C; stage_rc(tid * 16 + i * 8192, R, C); const int Rb = Epi::PERM ? ((R & ~31) + perm32(R & 31)) : R;
        voffA[i] = (unsigned)(R * K + C) * 2u; voffB[i] = (unsigned)(Rb * K + C) * 2u; }
    int one8 = 0x7f7f7f7f; asm volatile("" : "+v"(one8));
    const size_t kstep = (size_t)(BK * 2);
    const size_t hstep = (size_t)HALF * K * 2;
    const size_t tstep = 2 * hstep;
    const unsigned ldsw = (unsigned)wid * 1024u;
    const int aoff = lds_byte(wr * 64 + fr, fq * 8), boff = lds_byte(wc * 32 + fr, fq * 8);
#define PG8_SA(b, h) (((b) * 2 + (h)) * HTB)
#define PG8_SB(b, h) ((4 + (b) * 2 + (h)) * HTB)
#define PG8_STAGE(bufoff, gbase, voff) do { _Pragma("unroll") for (int _i = 0; _i < 2; ++_i) \
        __builtin_amdgcn_global_load_lds((const unsigned*)((const char*)(gbase) + (voff)[_i]), (PG8_LAS unsigned*)(lds + (bufoff) + ldsw + _i * 8192), 16, 0, 0); } while (0)
#define PG8_LDA(dst, b, h) do { _Pragma("unroll") for (int m = 0; m < 4; ++m) _Pragma("unroll") for (int k = 0; k < 2; ++k) dst[m][k] = *(const PG8_LAS bf16x8*)(lds + PG8_SA(b, h) + aoff + m * 2048 + k * 1024); } while (0)
#define PG8_LDB(dst, b, h) do { _Pragma("unroll") for (int n = 0; n < 2; ++n) _Pragma("unroll") for (int k = 0; k < 2; ++k) dst[n][k] = *(const PG8_LAS bf16x8*)(lds + PG8_SB(b, h) + boff + n * 2048 + k * 1024); } while (0)
#define PG8_MMA(ai, bj, At, Bt) do { __builtin_amdgcn_s_setprio(1); \
        if constexpr (Epi::FP8) { _Pragma("unroll") for (int m = 0; m < 4; ++m) _Pragma("unroll") for (int n = 0; n < 2; ++n) \
            { const i32x8 b8 = cat8(Bt[n][0], Bt[n][1]), a8 = cat8(At[m][0], At[m][1]);     \
              asm volatile("v_mfma_scale_f32_16x16x128_f8f6f4 %0, %1, %2, %0, %3, %3 op_sel_hi:[0,0,0]" : "+v"(acc[ai][bj][m][n]) : "v"(b8), "v"(a8), "v"(one8)); } } \
        else if constexpr (Epi::I8) { _Pragma("unroll") for (int m = 0; m < 4; ++m) _Pragma("unroll") for (int n = 0; n < 2; ++n) _Pragma("unroll") for (int k = 0; k < 2; ++k)     \
            acc[ai][bj][m][n] = __builtin_bit_cast(f32x4, __builtin_amdgcn_mfma_i32_16x16x64_i8(__builtin_bit_cast(i32x4, Bt[n][k]), __builtin_bit_cast(i32x4, At[m][k]), __builtin_bit_cast(i32x4, acc[ai][bj][m][n]), 0, 0, 0)); } \
        else { _Pragma("unroll") for (int m = 0; m < 4; ++m) _Pragma("unroll") for (int n = 0; n < 2; ++n) _Pragma("unroll") for (int k = 0; k < 2; ++k) \
            acc[ai][bj][m][n] = __builtin_amdgcn_mfma_f32_16x16x32_bf16(Bt[n][k], At[m][k], acc[ai][bj][m][n], 0, 0, 0); } \
        __builtin_amdgcn_s_setprio(0); } while (0)
#define PG8_WAIT_V(n) asm volatile("s_waitcnt vmcnt(" #n ")" ::: "memory")
#define PG8_WAIT_L(n) asm volatile("s_waitcnt lgkmcnt(" #n ")" ::: "memory")
#define PG8_BAR __builtin_amdgcn_s_barrier()
#define PG8_SCHED __builtin_amdgcn_sched_barrier(0)
    Unit cur, nxt; int ui = 0;
    if (!S.next(0, cur)) return;
    f32x4 acc[2][2][4][2];
#pragma unroll
    for (int a = 0; a < 2; ++a)
#pragma unroll
        for (int b = 0; b < 2; ++b)
#pragma unroll
            for (int m = 0; m < 4; ++m)
#pragma unroll
                for (int n = 0; n < 2; ++n) acc[a][b][m][n] = (f32x4){0.f, 0.f, 0.f, 0.f};
    bf16x8 At[4][2], B0[2][2], B1[2][2];
    const char* cA = (const char*)g.A + (size_t)cur.pm * tstep; const char* cB = (const char*)g.Bt + (size_t)cur.pn * tstep;
    S.a_ready(cur);
    if constexpr (SP2) {
        PG8_STAGE(PG8_SB(0, 0), cB, voffB); PG8_STAGE(PG8_SB(0, 1), cB + hstep, voffB); PG8_STAGE(PG8_SA(0, 0), cA, voffA); PG8_STAGE(PG8_SA(0, 1), cA + hstep, voffA);
        if (wr == 1) PG8_BAR;
        PG8_WAIT_V(2); PG8_BAR;
        PG8_STAGE(PG8_SB(1, 0), cB + kstep, voffB); PG8_STAGE(PG8_SA(1, 0), cA + kstep, voffA); PG8_STAGE(PG8_SB(1, 1), cB + hstep + kstep, voffB);
        PG8_WAIT_V(6); PG8_BAR;
    } else {
        PG8_STAGE(PG8_SB(0, 0), cB, voffB); PG8_STAGE(PG8_SA(0, 0), cA, voffA); PG8_STAGE(PG8_SB(0, 1), cB + hstep, voffB); PG8_STAGE(PG8_SA(0, 1), cA + hstep, voffA);
        if (wr == 1) PG8_BAR;
        PG8_WAIT_V(4); PG8_BAR;
        PG8_STAGE(PG8_SB(1, 0), cB + kstep, voffB); PG8_STAGE(PG8_SA(1, 0), cA + kstep, voffA); PG8_STAGE(PG8_SB(1, 1), cB + hstep + kstep, voffB);
        PG8_WAIT_V(6); PG8_BAR;
    }
    for (;;) {
        const bool has_next = S.next(ui + 1, nxt);
        const char* nA = has_next ? (const char*)g.A + (size_t)nxt.pm * tstep : cA; const char* nB = has_next ? (const char*)g.Bt + (size_t)nxt.pn * tstep : cB;
        if constexpr (Epi::RSTD) { if (wid < 4)
            __builtin_amdgcn_global_load_lds((const unsigned*)(g.ps + ((size_t)cur.pm * BM + wid * 64 + lane) * 4), (PG8_LAS unsigned*)(lds + STAGE_BYTES + (ui & 1) * 4096 + wid * 1024), 16, 0, 0); }
        if constexpr (Epi::I8) { if (wid == 4)
            __builtin_amdgcn_global_load_lds((const unsigned*)(g.wq + (size_t)cur.pn * BM + lane * 4), (PG8_LAS unsigned*)(lds + STAGE_BYTES + 12288 + (ui & 1) * 1024), 16, 0, 0); }
        for (int t = 0; t < nt; t += 2) {
            const bool last = (t == nt - 2);
            const char* a1 = cA + (size_t)(t + 1) * kstep;
            const char* a2 = last ? nA : cA + (size_t)(t + 2) * kstep; const char* b2 = last ? nB : cB + (size_t)(t + 2) * kstep;
            const char* a3 = a2 + kstep; const char* b3 = b2 + kstep;
            if (last && has_next) S.a_ready(nxt);
            if constexpr (SP2) {
            PG8_LDB(B0, 0, 0); PG8_LDB(B1, 0, 1); PG8_SCHED; PG8_LDA(At, 0, 0); PG8_STAGE(PG8_SA(1, 1), a1 + hstep, voffA);
            PG8_WAIT_V(8); PG8_WAIT_L(0); PG8_BAR; PG8_MMA(0, 0, At, B0); PG8_MMA(0, 1, At, B1); PG8_BAR; PG8_SCHED;
            PG8_LDA(At, 0, 1); PG8_STAGE(PG8_SB(0, 0), b2, voffB); PG8_STAGE(PG8_SB(0, 1), b2 + hstep, voffB); PG8_STAGE(PG8_SA(0, 0), a2, voffA);
            PG8_WAIT_V(8); PG8_WAIT_L(0); PG8_BAR; PG8_MMA(1, 0, At, B0); PG8_MMA(1, 1, At, B1); PG8_BAR; PG8_SCHED;
            PG8_LDB(B0, 1, 0); PG8_LDB(B1, 1, 1); PG8_SCHED; PG8_LDA(At, 1, 0); PG8_STAGE(PG8_SA(0, 1), a2 + hstep, voffA);
            PG8_WAIT_V(8); PG8_WAIT_L(0); PG8_BAR; PG8_MMA(0, 0, At, B0); PG8_MMA(0, 1, At, B1); PG8_BAR; PG8_SCHED;
            PG8_LDA(At, 1, 1); PG8_STAGE(PG8_SB(1, 0), b3, voffB); PG8_STAGE(PG8_SB(1, 1), b3 + hstep, voffB); PG8_STAGE(PG8_SA(1, 0), a3, voffA);
            PG8_WAIT_V(8); PG8_WAIT_L(0); PG8_BAR; PG8_MMA(1, 0, At, B0); PG8_MMA(1, 1, At, B1); PG8_BAR; PG8_SCHED;
            } else {
            PG8_LDB(B0, 0, 0); PG8_SCHED; PG8_LDA(At, 0, 0); PG8_STAGE(PG8_SA(1, 1), a1 + hstep, voffA);
            PG8_WAIT_L(8); PG8_BAR; PG8_WAIT_L(0); PG8_MMA(0, 0, At, B0); PG8_BAR; PG8_SCHED;
            PG8_LDB(B1, 0, 1); PG8_STAGE(PG8_SB(0, 0), b2, voffB);
            PG8_BAR; PG8_WAIT_L(0); PG8_MMA(0, 1, At, B1); PG8_BAR;
            PG8_LDA(At, 0, 1); PG8_STAGE(PG8_SA(0, 0), a2, voffA);
            PG8_BAR; PG8_WAIT_L(0); PG8_MMA(1, 0, At, B0); PG8_BAR; PG8_SCHED;
            PG8_STAGE(PG8_SB(0, 1), b2 + hstep, voffB);
            PG8_WAIT_V(6); PG8_BAR; PG8_MMA(1, 1, At, B1); PG8_BAR;
            PG8_LDB(B0, 1, 0); PG8_SCHED; PG8_LDA(At, 1, 0); PG8_STAGE(PG8_SA(0, 1), a2 + hstep, voffA);
            PG8_WAIT_L(8); PG8_BAR; PG8_WAIT_L(0); PG8_MMA(0, 0, At, B0); PG8_BAR; PG8_SCHED;
            PG8_LDB(B1, 1, 1); PG8_STAGE(PG8_SB(1, 0), b3, voffB);
            PG8_BAR; PG8_WAIT_L(0); PG8_MMA(0, 1, At, B1); PG8_BAR;
            PG8_LDA(At, 1, 1); PG8_STAGE(PG8_SA(1, 0), a3, voffA);
            PG8_BAR; PG8_WAIT_L(0); PG8_MMA(1, 0, At, B0); PG8_BAR; PG8_SCHED;
            PG8_STAGE(PG8_SB(1, 1), b3 + hstep, voffB);
            PG8_WAIT_V(6); PG8_BAR; PG8_MMA(1, 1, At, B1); PG8_BAR;
            }
        }
        if constexpr (ALIGN_EPI) { if (wr == 0) PG8_BAR; }
        if constexpr (!Epi::AFTER_DRAIN) { if constexpr (Epi::RSTD) E(acc, cur, wr, wc, fr, fq, (const PG8_LAS f32x4*)(lds + STAGE_BYTES + (ui & 1) * 4096), (const PG8_LAS f32x4*)(lds + STAGE_BYTES + 12288 + (ui & 1) * 1024)); else E(acc, cur, wr, wc, fr, fq); S.done(cur); }
        if (!has_next) break;
#pragma unroll
        for (int a = 0; a < 2; ++a)
#pragma unroll
            for (int b = 0; b < 2; ++b)
#pragma unroll
                for (int m = 0; m < 4; ++m)
#pragma unroll
                    for (int n = 0; n < 2; ++n) acc[a][b][m][n] = (f32x4){0.f, 0.f, 0.f, 0.f};
        cur = nxt; cA = nA; cB = nB; ++ui;
        if constexpr (ALIGN_EPI) { if (wr == 1) PG8_BAR; }
    }
    PG8_WAIT_V(0);
    if constexpr (!ALIGN_EPI) { if (wr == 0) PG8_BAR; }
    PG8_BAR;
    if constexpr (Epi::AFTER_DRAIN) { E.fused(acc, cur, wr, wc, fr, fq, lds, wid, lane); S.done(cur); }
#undef PG8_SA
#undef PG8_SB
#undef PG8_STAGE
#undef PG8_LDA
#undef PG8_LDB
#undef PG8_MMA
#undef PG8_WAIT_V
#undef PG8_WAIT_L
#undef PG8_BAR
#undef PG8_SCHED
}
}
#include <hip/hip_bf16.h>
#include <cmath>
namespace attn_body {
using bf16=__hip_bfloat16;
using bf16x8=__attribute__((ext_vector_type(8)))short;
using s16x4=__attribute__((ext_vector_type(4)))short;
using f32x16=__attribute__((ext_vector_type(16)))float;
using u32x4=__attribute__((ext_vector_type(4)))unsigned;
constexpr int BATCH=32,NHEAD=16,SEQ=2048,D=64,DM=3072,DMO=1024;
constexpr int NW=8,QBLK=32,QB=QBLK*NW,KVBLK=64,NQB=SEQ/QB;
constexpr int ATTN_PITCH=DM, ATTN_UNIT_ROWS=QB;
__device__ __forceinline__ int crow(int r,int hi){return (r&3)+8*(r>>2)+4*hi;}
#define SBAR() __builtin_amdgcn_sched_barrier(0)
__device__ __forceinline__ void cmask(f32x16&p0,f32x16&p1,int jb,int qrel,int hi){
  const float NEG=-INFINITY; int kb=64*jb+4*hi;
  #pragma unroll
  for(int r=0;r<16;++r){int kv=kb+(r&3)+8*(r>>2); if(kv>qrel)p0[r]=NEG; if(kv+32>qrel)p1[r]=NEG;}
}

constexpr int NSLOT=3, SLOTB=8192;
constexpr int LDS_K=0, LDS_V=NSLOT*SLOTB, LDS_WS=2*NSLOT*SLOTB, LDS_OST=LDS_WS+NW*64*4, LDS_BYTES=LDS_OST+NW*4096;
constexpr float C2=0.125f*1.4426950408889634f;
__device__ __forceinline__ void glds16(const void*gsrc,unsigned lds_dst){unsigned keep;
  asm volatile("s_mov_b32 %0, m0\n\ts_mov_b32 m0, %2\n\ts_nop 0\n\tglobal_load_lds_dwordx4 %1, off\n\ts_mov_b32 m0, %0":"=&s"(keep):"v"(gsrc),"s"(lds_dst):"memory");}
__device__ __forceinline__ float max3f(float a,float b,float c){float r;asm("v_max3_f32 %0, %1, %2, %3":"=v"(r):"v"(a),"v"(b),"v"(c));return r;}
__device__ __forceinline__ float max2f(float a,float b){float r;asm("v_max_f32_e32 %0, %1, %2":"=v"(r):"v"(a),"v"(b));return r;}
__device__ __forceinline__ float fadd_s(float a,float b){float r;asm("v_add_f32_e32 %0, %1, %2":"=v"(r):"v"(a),"v"(b));return r;}
__device__ __forceinline__ float fsub_s(float a,float b){float r;asm("v_sub_f32_e32 %0, %1, %2":"=v"(r):"v"(a),"v"(b));return r;}
typedef float f32x2_t __attribute__((ext_vector_type(2))); typedef __bf16 bf16x2_t __attribute__((ext_vector_type(2)));
__device__ __forceinline__ unsigned cvtpk_s(float lo,float hi){f32x2_t v={lo,hi};bf16x2_t b=__builtin_convertvector(v,bf16x2_t);return __builtin_bit_cast(unsigned,b);}
#define WAIT_BAR(N) asm volatile("s_waitcnt vmcnt(" #N ") lgkmcnt(0)\n\ts_barrier":::"memory")

__device__ __forceinline__ void qkt(f32x16&p0,f32x16&p1,const char*Kslot,const bf16x8*qr,const f32x16&negm,int r32,int hi){
  const char*kb=Kslot+hi*1024+r32*16;
  #pragma unroll
  for(int d0=0;d0<4;++d0){
    const bf16x8 b0=*reinterpret_cast<const bf16x8*>(kb+d0*2048);
    const bf16x8 b1=*reinterpret_cast<const bf16x8*>(kb+d0*2048+512);
    if(d0==0){p0=__builtin_amdgcn_mfma_f32_32x32x16_bf16(b0,qr[0],negm,0,0,0);p1=__builtin_amdgcn_mfma_f32_32x32x16_bf16(b1,qr[0],negm,0,0,0);}
    else{p0=__builtin_amdgcn_mfma_f32_32x32x16_bf16(b0,qr[d0],p0,0,0,0);p1=__builtin_amdgcn_mfma_f32_32x32x16_bf16(b1,qr[d0],p1,0,0,0);}}
}
typedef __attribute__((address_space(3))) const char* lds_cptr;
typedef short v4i16_t __attribute__((ext_vector_type(4)));
__device__ __forceinline__ void kload8(bf16x8*kf,lds_cptr kp){
  kf[0]=*(const __attribute__((address_space(3))) bf16x8*)(kp);      kf[1]=*(const __attribute__((address_space(3))) bf16x8*)(kp+512);
  kf[2]=*(const __attribute__((address_space(3))) bf16x8*)(kp+2048); kf[3]=*(const __attribute__((address_space(3))) bf16x8*)(kp+2560);
  kf[4]=*(const __attribute__((address_space(3))) bf16x8*)(kp+4096); kf[5]=*(const __attribute__((address_space(3))) bf16x8*)(kp+4608);
  kf[6]=*(const __attribute__((address_space(3))) bf16x8*)(kp+6144); kf[7]=*(const __attribute__((address_space(3))) bf16x8*)(kp+6656);
}
__device__ __forceinline__ void kload2(bf16x8*kf,lds_cptr kp,int j){ kf[2*j]=*(const __attribute__((address_space(3))) bf16x8*)(kp+j*2048); kf[2*j+1]=*(const __attribute__((address_space(3))) bf16x8*)(kp+j*2048+512); }
__device__ __forceinline__ s16x4 vtr(lds_cptr p){ return __builtin_bit_cast(s16x4,__builtin_amdgcn_ds_read_tr16_b64_v4i16((__attribute__((address_space(3))) v4i16_t*)p)); }
__device__ __forceinline__ float rowmax(const f32x16&p0,const f32x16&p1){
  float a=max3f(p0[0],p0[1],p1[0]),b=max3f(p0[2],p0[3],p1[1]);a=max3f(a,p1[2],p1[3]);
  #pragma unroll
  for(int r=4;r<16;r+=4){a=max3f(a,p0[r],p0[r+1]);b=max3f(b,p0[r+2],p0[r+3]);a=max3f(a,p1[r],p1[r+1]);b=max3f(b,p1[r+2],p1[r+3]);}
  const float m=max2f(a,b);
  auto rr=__builtin_amdgcn_permlane32_swap(__float_as_uint(m),__float_as_uint(m),false,false);
  return max2f(__uint_as_float(rr[0]),__uint_as_float(rr[1]));
}
__device__ __forceinline__ void pv(f32x16*o,int vb,bf16x8 pa0,bf16x8 pa1,bf16x8 pa2,bf16x8 pa3){
  #pragma unroll
  for(int d0=0;d0<2;++d0){s16x4 lo[4],hi[4];
    #pragma unroll
    for(int ks=0;ks<4;++ks){
      asm volatile("ds_read_b64_tr_b16 %0,%1 offset:%c2":"=&v"(lo[ks]):"v"(vb),"i"(d0*4096+ks*1024):"memory");
      asm volatile("ds_read_b64_tr_b16 %0,%1 offset:%c2":"=&v"(hi[ks]):"v"(vb),"i"(d0*4096+ks*1024+512):"memory");}
    asm volatile("s_waitcnt lgkmcnt(0)":::"memory");SBAR();
    #define PK(k) (bf16x8){lo[k][0],lo[k][1],lo[k][2],lo[k][3],hi[k][0],hi[k][1],hi[k][2],hi[k][3]}
    o[d0]=__builtin_amdgcn_mfma_f32_32x32x16_bf16(pa0,PK(0),o[d0],0,0,0);
    o[d0]=__builtin_amdgcn_mfma_f32_32x32x16_bf16(pa1,PK(1),o[d0],0,0,0);
    o[d0]=__builtin_amdgcn_mfma_f32_32x32x16_bf16(pa2,PK(2),o[d0],0,0,0);
    o[d0]=__builtin_amdgcn_mfma_f32_32x32x16_bf16(pa3,PK(3),o[d0],0,0,0);
    #undef PK
  }
}

#ifndef ATTN_STORE16
#define ATTN_STORE16(p,v) (*(u32x4*)(p)=(v))
#endif
template<int THRL> __device__ __forceinline__ void attn_unit(int b,int h,int qb,const bf16*Q,const bf16*__restrict__ K,const bf16*__restrict__ V,bf16*O,char*shm){
  const int tid=threadIdx.x,lane=tid&63,r32=lane&31,hi=lane>>5; const int wid=__builtin_amdgcn_readfirstlane(tid>>6);
  const long rowbase=(long)b*SEQ; const int q0=qb*QB;
  const bf16*Qw=Q+(rowbase+q0+wid*QBLK)*DM+1536+(h>>1)*64;
  const bf16*Kh=K+rowbase*DM+2048+(h>>1)*64,*Vh=V+rowbase*DM+2560+(h>>2)*128+(h&1)*64;
  const unsigned lds0=(unsigned)(uintptr_t)shm;
  float*wsf=(float*)(shm+LDS_WS)+wid*64;
  const bf16*ksrc=Kh+(long)lane*DM+wid*8;
  const bf16*vsrc=Vh+(long)(16*(wid&3)+(lane>>2))*DM+(wid>>2)*32+(lane&3)*8;
  const unsigned kdst=lds0+LDS_K+wid*1024, vdst=lds0+LDS_V+wid*1024;
  #define DMA_K(t,slot) glds16(ksrc+(long)(t)*KVBLK*DM,(unsigned)__builtin_amdgcn_readfirstlane(kdst+(slot)))
  #define DMA_V(t,slot) glds16(vsrc+(long)(t)*KVBLK*DM,(unsigned)__builtin_amdgcn_readfirstlane(vdst+(slot)))
  const int vb0=(int)(lds0+LDS_V)+((lane>>4)&1)*32+(lane&3)*8+(4*hi+((lane&15)>>2))*64;
  const char*Kbase=shm+LDS_K; bf16x8 kf[8];
  const lds_cptr shm3=(lds_cptr)shm; const lds_cptr kp0=shm3+LDS_K+hi*1024+r32*16; const lds_cptr vp0=shm3+LDS_V+((lane>>4)&1)*32+(lane&3)*8+(4*hi+((lane&15)>>2))*64;
  const int NT=(q0+QB)/KVBLK;
  DMA_K(0,0);DMA_V(0,0);DMA_K(1,SLOTB);
  bf16x8 qr[4];
  #pragma unroll
  for(int d0=0;d0<4;++d0)qr[d0]=*reinterpret_cast<const bf16x8*>(&Qw[(long)r32*DM+d0*16+hi*8]);
  float mhat=0.f,l_reg=0.f;f32x16 o[2];o[0]=f32x16{};o[1]=f32x16{};f32x16 negm=f32x16{};asm volatile("":"+v"(negm));
  const int qrel=wid*QBLK+r32;
  #define CMASK(P0,P1,t) do{int jb_=(t)-(NT-4); if(jb_>=0)cmask(P0,P1,jb_,qrel,hi);}while(0)
  bool resc=false;
  #define START(P0,P1) do{ const float rm=rowmax(P0,P1); resc=false; \
    { const float dl=rm; mhat=fadd_s(mhat,dl); \
      _Pragma("unroll") for(int r=0;r<16;++r){P0[r]=fsub_s(P0[r],dl);P1[r]=fsub_s(P1[r],dl);} \
      _Pragma("unroll") for(int r=0;r<16;++r)negm[r]=-mhat; asm volatile("":"+v"(negm)); } \
    _Pragma("unroll") for(int r=0;r<16;++r)P0[r]=__builtin_amdgcn_exp2f(P0[r]); }while(0)
  #define RESC() do{ if(resc){ asm volatile("s_waitcnt lgkmcnt(0)":::"memory"); \
      _Pragma("unroll") for(int d_=0;d_<2;++d_) _Pragma("unroll") for(int r=0;r<16;++r)o[d_][r]*=wsf[crow(r,hi)]; } }while(0)
  f32x16 pA0,pA1,pB0,pB1;
  int sl_prev=0,sl_cur=0,sl_next=SLOTB;
  #define ROT() do{sl_prev=sl_cur;sl_cur=sl_next;sl_next=(sl_next==(NSLOT-1)*SLOTB)?0:sl_next+SLOTB;}while(0)
  DMA_K(2,2*SLOTB);
  WAIT_BAR(3);
  qkt(pA0,pA1,Kbase,qr,negm,r32,hi);asm volatile("s_nop 15\n\ts_nop 7":"+v"(pA0),"+v"(pA1));CMASK(pA0,pA1,0);
  START(pA0,pA1);
  _Pragma("unroll") for(int r=0;r<16;++r)pA1[r]=__builtin_amdgcn_exp2f(pA1[r]);
  WAIT_BAR(0);
  DMA_K(3,0);DMA_V(1,SLOTB);
  ROT();
  kload8(kf,kp0+sl_cur);
  WAIT_BAR(2);
  s16x4 vlo[8],vhi[8]; u32x4 pw0,pw1,pw2,pw3;
  #define PKW(P,B) cvtpk_s(P[B],P[B+1])
  #define PAF(k) __builtin_bit_cast(bf16x8,pw##k)
  #define VFR(i) (bf16x8){vlo[i][0],vlo[i][1],vlo[i][2],vlo[i][3],vhi[i][0],vhi[i][1],vhi[i][2],vhi[i][3]}
  #define PIN(x) asm volatile("":"+v"(x))
  #define MX3(a,b,c) __builtin_fmaxf(__builtin_fmaxf((a),(b)),(c))
  #define GAPA(MF,A0,A1,A2,A3,W0,W1,PW) do{ MF; sacc+=A0; sacc+=A1; sacc+=A2; sacc+=A3; PIN(sacc); W0; W1; PIN(PW); SBAR(); }while(0)
  #define EX(v) __builtin_amdgcn_exp2f(v)
  #define GAPB(MF,X,B) do{ MF; X[B]=EX(X[B]); X[B+1]=EX(X[B+1]); X[B+2]=EX(X[B+2]); X[B+3]=EX(X[B+3]); PIN(X); SBAR(); }while(0)
  #define VRD(i) do{ vlo[i]=vtr(vp_+(((i)>>2)*4096+((i)&3)*1024)); vhi[i]=vtr(vp_+(((i)>>2)*4096+((i)&3)*1024+512)); }while(0)
  #define KRD(G,j) do{ if(G){ kload2(kf,kp0+sl_next,j); SBAR(); } }while(0)
  #define STEP(C0,C1,P0,P1,t,GK,GV,GL) do{ SBAR(); \
    const lds_cptr vp_=vp0+sl_prev; \
    VRD(0); SBAR(); float sacc=(P0[0]+P0[1]); \
    GAPA(C0=__builtin_amdgcn_mfma_f32_32x32x16_bf16(kf[0],qr[0],negm,0,0,0), P0[2],P0[3],P0[4],P0[5],     pw0[0]=PKW(P0,0), pw0[1]=PKW(P0,2), pw0); \
    VRD(4); SBAR(); GAPA(C1=__builtin_amdgcn_mfma_f32_32x32x16_bf16(kf[1],qr[0],negm,0,0,0), P0[6],P0[7],P0[8],P0[9],     pw0[2]=PKW(P0,4), pw0[3]=PKW(P0,6), pw0); \
    VRD(1); SBAR(); GAPA(C0=__builtin_amdgcn_mfma_f32_32x32x16_bf16(kf[2],qr[1],C0,0,0,0),   P0[10],P0[11],P0[12],P0[13], pw1[0]=PKW(P0,8), pw1[1]=PKW(P0,10), pw1); \
    VRD(5); SBAR(); GAPA(C1=__builtin_amdgcn_mfma_f32_32x32x16_bf16(kf[3],qr[1],C1,0,0,0),   P0[14],P0[15],P1[0],P1[1],   pw1[2]=PKW(P0,12),pw1[3]=PKW(P0,14), pw1); \
    VRD(2); SBAR(); GAPA(C0=__builtin_amdgcn_mfma_f32_32x32x16_bf16(kf[4],qr[2],C0,0,0,0),   P1[2],P1[3],P1[4],P1[5],     pw2[0]=PKW(P1,0), pw2[1]=PKW(P1,2), pw2); \
    VRD(6); SBAR(); GAPA(C1=__builtin_amdgcn_mfma_f32_32x32x16_bf16(kf[5],qr[2],C1,0,0,0),   P1[6],P1[7],P1[8],P1[9],     pw2[2]=PKW(P1,4), pw2[3]=PKW(P1,6), pw2); \
    VRD(3); SBAR(); GAPA(C0=__builtin_amdgcn_mfma_f32_32x32x16_bf16(kf[6],qr[3],C0,0,0,0),   P1[10],P1[11],P1[12],P1[13], pw3[0]=PKW(P1,8), pw3[1]=PKW(P1,10), pw3); \
    VRD(7); SBAR(); GAPA(C1=__builtin_amdgcn_mfma_f32_32x32x16_bf16(kf[7],qr[3],C1,0,0,0),   P1[14],P1[15],0.f,0.f,       pw3[2]=PKW(P1,12),pw3[3]=PKW(P1,14), pw3); \
    l_reg+=sacc; \
    if(GK){DMA_K((t)+3,sl_cur);} if(GV){DMA_V((t)+1,sl_next);} \
    CMASK(C0,C1,t); \
    { float a=MX3(C0[0],C0[1],C1[0]),b=MX3(C0[2],C0[3],C1[1]); a=MX3(a,C1[2],C1[3]); \
      _Pragma("unroll") for(int r=4;r<16;r+=4){a=MX3(a,C0[r],C0[r+1]);b=MX3(b,C0[r+2],C0[r+3]);a=MX3(a,C1[r],C1[r+1]);b=MX3(b,C1[r+2],C1[r+3]);} \
      float rm=__builtin_fmaxf(a,b); { auto rr=__builtin_amdgcn_permlane32_swap(__float_as_uint(rm),__float_as_uint(rm),false,false); rm=__builtin_fmaxf(__uint_as_float(rr[0]),__uint_as_float(rr[1])); } \
      resc=false; \
      if(__builtin_expect(__any(rm>(float)THRL),0)){ const float dl=__builtin_fmaxf(rm,0.f); mhat+=dl; \
        _Pragma("unroll") for(int r=0;r<16;++r){C0[r]-=dl;C1[r]-=dl;} \
        _Pragma("unroll") for(int r=0;r<16;++r)negm[r]=-mhat; asm volatile("":"+v"(negm)); \
        const float f=__builtin_amdgcn_exp2f(-dl); l_reg*=f; if(hi==0)wsf[r32]=f; resc=true; } } \
    SBAR(); \
    GAPB(o[0]=__builtin_amdgcn_mfma_f32_32x32x16_bf16(PAF(0),VFR(0),o[0],0,0,0), C0,0); \
    GAPB(o[1]=__builtin_amdgcn_mfma_f32_32x32x16_bf16(PAF(0),VFR(4),o[1],0,0,0), C0,4); \
    KRD(GL,0); GAPB(o[0]=__builtin_amdgcn_mfma_f32_32x32x16_bf16(PAF(1),VFR(1),o[0],0,0,0), C0,8); \
    KRD(GL,1); GAPB(o[1]=__builtin_amdgcn_mfma_f32_32x32x16_bf16(PAF(1),VFR(5),o[1],0,0,0), C0,12); \
    KRD(GL,2); GAPB(o[0]=__builtin_amdgcn_mfma_f32_32x32x16_bf16(PAF(2),VFR(2),o[0],0,0,0), C1,0); \
    KRD(GL,3); GAPB(o[1]=__builtin_amdgcn_mfma_f32_32x32x16_bf16(PAF(2),VFR(6),o[1],0,0,0), C1,4); \
    GAPB(o[0]=__builtin_amdgcn_mfma_f32_32x32x16_bf16(PAF(3),VFR(3),o[0],0,0,0), C1,8); \
    GAPB(o[1]=__builtin_amdgcn_mfma_f32_32x32x16_bf16(PAF(3),VFR(7),o[1],0,0,0), C1,12); \
    }while(0)
  int t=1;
  #undef CMASK
  #define CMASK(P0,P1,t) do{}while(0)
  for(;t+5<NT;t+=2){
    STEP(pB0,pB1,pA0,pA1,t,true,true,true);     WAIT_BAR(2); RESC(); ROT();
    STEP(pA0,pA1,pB0,pB1,t+1,true,true,true);   WAIT_BAR(2); RESC(); ROT();
  }
  #undef CMASK
  #define CMASK(P0,P1,t) do{int jb_=(t)-(NT-4); if(jb_>=0)cmask(P0,P1,jb_,qrel,hi);}while(0)
  #define ENDW(tt) do{ if((tt)+3<NT){WAIT_BAR(2);} else if((tt)+2<NT){WAIT_BAR(1);} else {WAIT_BAR(0);} }while(0)
  for(;t+1<NT;t+=2){
    STEP(pB0,pB1,pA0,pA1,t,(t+3<NT),(t+1<NT),(t+1<NT));       ENDW(t);   RESC(); ROT();
    STEP(pA0,pA1,pB0,pB1,t+1,(t+4<NT),(t+2<NT),(t+2<NT));     ENDW(t+1); RESC(); ROT();
  }
  STEP(pB0,pB1,pA0,pA1,NT-1,false,false,false); RESC();
  { float sacc=pB0[0]+pB0[1]; _Pragma("unroll") for(int r=2;r<16;++r)sacc+=pB0[r]; _Pragma("unroll") for(int r=0;r<16;++r)sacc+=pB1[r]; l_reg+=sacc;
    pw0=(u32x4){PKW(pB0,0),PKW(pB0,2),PKW(pB0,4),PKW(pB0,6)};pw1=(u32x4){PKW(pB0,8),PKW(pB0,10),PKW(pB0,12),PKW(pB0,14)};pw2=(u32x4){PKW(pB1,0),PKW(pB1,2),PKW(pB1,4),PKW(pB1,6)};pw3=(u32x4){PKW(pB1,8),PKW(pB1,10),PKW(pB1,12),PKW(pB1,14)};
    SBAR(); pv(o,vb0+sl_cur,PAF(0),PAF(1),PAF(2),PAF(3)); }
  #undef PKW
  #undef PAF
  #undef VFR
  #undef PIN
  #undef MX3
  #undef GAPA
  #undef GAPB
  #undef EX
  #undef VRD
  #undef KRD
  #undef STEP
  #undef ENDW
  {auto rr=__builtin_amdgcn_permlane32_swap(__float_as_uint(l_reg),__float_as_uint(l_reg),false,false);l_reg=__uint_as_float(rr[0])+__uint_as_float(rr[1]);}
  if(hi==0)wsf[32+r32]=l_reg;asm volatile("s_waitcnt lgkmcnt(0)":::"memory");
  float rli[16];
  #pragma unroll
  for(int r=0;r<16;++r)rli[r]=__builtin_amdgcn_rcpf(wsf[32+crow(r,hi)]);
  bf16*Ow=O+(rowbase+q0+wid*QBLK)*DMO+h*D;
  { bf16*stg=(bf16*)(shm+LDS_OST)+wid*2048;
    #pragma unroll
    for(int r=0;r<16;++r){const int orow=crow(r,hi);
      #pragma unroll
      for(int d0=0;d0<2;++d0)stg[orow*64+d0*32+r32]=__float2bfloat16(o[d0][r]*rli[r]);}
    asm volatile("s_waitcnt lgkmcnt(0)":::"memory");
    #pragma unroll
    for(int i=0;i<4;++i){const int row=i*8+(lane>>3),ch=lane&7; const u32x4 v=*(const u32x4*)(stg+row*64+ch*8); ATTN_STORE16(Ow+(long)row*DMO+ch*8,v);} }
  asm volatile("s_waitcnt lgkmcnt(0)\n\ts_barrier":::"memory");
  #undef DMA_K
  #undef DMA_V
  #undef CMASK
  #undef START
  #undef RESC
  #undef ROT
}
constexpr int ATTN_LDS_BYTES=LDS_BYTES;
struct AttnTensors { const bf16* Q; const bf16* K; const bf16* V; bf16* O; };
struct AttnUnit { int bh; int qb; };
struct StaticOrder {
  int vcu;
  __device__ __forceinline__ explicit StaticOrder(int grid,int block):vcu((block%8)*(grid/8)+block/8){}
  __device__ __forceinline__ bool next(int i,AttnUnit&u)const{ if(i>=16)return false; const int j=i&7; u.bh=vcu*2+(i>>3); u.qb=(j&1)?7-(j>>1):(j>>1); return true; }
  __device__ __forceinline__ void a_ready(const AttnUnit&)const{}
  __device__ __forceinline__ void done(const AttnUnit&)const{}
};
template<class Sched,int THRL=8> __device__ __forceinline__ void attn_phase(char*lds,const AttnTensors&T,const Sched&S){
  AttnUnit u;
  for(int i=0;S.next(i,u);++i){ S.a_ready(u); attn_unit<THRL>(u.bh/NHEAD,u.bh%NHEAD,u.qb,T.Q,T.K,T.V,T.O,lds); S.done(u); }
}
#undef SBAR
#undef WAIT_BAR
}
namespace mixa {
using bf16x8 = __attribute__((ext_vector_type(8))) short;
using s16x4 = __attribute__((ext_vector_type(4))) short;
using f32x16 = __attribute__((ext_vector_type(16))) float;
using f32x4 = __attribute__((ext_vector_type(4))) float;
using u32x4 = __attribute__((ext_vector_type(4))) unsigned;
typedef short v4i16_t __attribute__((ext_vector_type(4)));
#define MA_LAS __attribute__((address_space(3)))
typedef unsigned short bf16;
constexpr int PQ = 3072, TT = 2048, PY = 1024;
constexpr int XO = 0, XM = 65536, XL = XM + 1024, WV = XL + 1024, WSZ = 4096 + 256;
constexpr int LDS_NEED = WV + 8 * WSZ;
__device__ __forceinline__ int crow(int r, int hi) { return (r & 3) + 8 * (r >> 2) + 4 * hi; }
__device__ __forceinline__ unsigned cvtpk(float lo, float hi) { typedef float f2 __attribute__((ext_vector_type(2))); typedef __bf16 b2 __attribute__((ext_vector_type(2))); f2 v = {lo, hi}; b2 b = __builtin_convertvector(v, b2); return __builtin_bit_cast(unsigned, b); }
template <int BR> __device__ __forceinline__ int qloc(int w, int i) {
    if (BR == 0) return 32 * w + i;
    if (BR == 1) return (w & 3) + 4 * (32 * (w >> 2) + i);
    return (2 * w + (i >> 4)) + 16 * (i & 15);
}
struct State { f32x16 o[2]; float m, l; };
template <int BR> __device__ __forceinline__ void xchg_write(const State& S, MA_LAS unsigned char* L, int w, int r32, int hi) {
    MA_LAS float* xo = (MA_LAS float*)(L + XO);
#pragma unroll
    for (int r = 0; r < 16; ++r) { const int ql = qloc<BR>(w, crow(r, hi)); xo[ql * 64 + r32] = S.o[0][r]; xo[ql * 64 + 32 + r32] = S.o[1][r]; }
    const float lt = S.l + __shfl_xor(S.l, 32);
    if (hi == 0) { const int ql = qloc<BR>(w, r32); ((MA_LAS float*)(L + XM))[ql] = S.m; ((MA_LAS float*)(L + XL))[ql] = lt; }
}
template <int BR> __device__ __forceinline__ void xchg_read(State& S, MA_LAS unsigned char* L, int w, int r32, int hi) {
    const MA_LAS float* xo = (const MA_LAS float*)(L + XO);
#pragma unroll
    for (int r = 0; r < 16; ++r) { const int ql = qloc<BR>(w, crow(r, hi)); S.o[0][r] = xo[ql * 64 + r32]; S.o[1][r] = xo[ql * 64 + 32 + r32]; }
    const int ql = qloc<BR>(w, r32);
    S.m = ((const MA_LAS float*)(L + XM))[ql]; const float lt = ((const MA_LAS float*)(L + XL))[ql]; S.l = (hi == 0) ? lt : 0.f;
}
template <int BR> __device__ __forceinline__ void branch(State& S, const bf16* Qb, int t0, MA_LAS unsigned char* L, int w, int lane) {
    constexpr int STRIDE = (BR == 0) ? 1 : (BR == 1) ? 4 : 16;
    const int r32 = lane & 31, hi = lane >> 5;
    const bf16* Kb = Qb + 512; const bf16* Vb = Qb + 1024;
    MA_LAS unsigned char* img = L + WV + w * WSZ; MA_LAS float* SC = (MA_LAS float*)(img + 4096);
    const int qi = (BR == 0) ? t0 + 32 * w + r32 : (BR == 1) ? (t0 >> 2) + 32 * (w >> 2) + r32 : (t0 >> 4) + (r32 & 15);
    const int qc = (BR == 2) ? (r32 >> 4) : 0;
    bf16x8 qf[4];
    { const bf16* qp = Qb + (size_t)(t0 + qloc<BR>(w, r32)) * PQ + 8 * hi;
#pragma unroll
      for (int d0 = 0; d0 < 4; ++d0) qf[d0] = *(const bf16x8*)(qp + 16 * d0); }
    const int nt2 = ((t0 >> 4) + 16 + 31) >> 5;
    const int ntile = (BR == 2) ? 2 * nt2 : 5;
    const int kbase = (BR == 0) ? t0 + 32 * w - 128 : (BR == 1) ? (t0 >> 2) + 32 * (w >> 2) - 128 : 0;
    const int res01 = (BR == 1) ? (w & 3) : 0;
    int n = 0;
    if (BR != 2) { while (n < ntile && kbase + 32 * n + 31 < 0) ++n; }
#define MA_TILE(nn, cls_, k0_, res_) const int cls_ = (BR == 2) ? ((nn) >= nt2 ? 1 : 0) : 0; const int k0_ = (BR == 2) ? 32 * ((nn) - cls_ * nt2) : kbase + 32 * (nn); const int res_ = (BR == 2) ? 2 * w + cls_ : res01
#define MA_LOADS(kf_, vr_, k0_, res_) do { \
        int kj_ = k0_ + r32; kj_ = kj_ < 0 ? 0 : kj_; const bf16* kp_ = Kb + (size_t)(res_ + STRIDE * kj_) * PQ + 8 * hi; \
        _Pragma("unroll") for (int d0 = 0; d0 < 4; ++d0) kf_[d0] = *(const bf16x8*)(kp_ + 16 * d0); \
        int vj_ = k0_ + (lane >> 1); vj_ = vj_ < 0 ? 0 : vj_; const bf16* vp_ = Vb + (size_t)(res_ + STRIDE * vj_) * PQ + 32 * (lane & 1); \
        _Pragma("unroll") for (int c = 0; c < 4; ++c) vr_[c] = *(const u32x4*)(vp_ + 8 * c); } while (0)
    bf16x8 kfn[4]; u32x4 vrn[4];
    if (n < ntile) { MA_TILE(n, c0, k00, r00); MA_LOADS(kfn, vrn, k00, r00); }
    const int trb = ((lane >> 4) & 1) * 32 + (lane & 3) * 8 + (4 * hi + ((lane & 15) >> 2)) * 64;
    for (; n < ntile; ++n) {
        MA_TILE(n, cls, k0, res); (void)res;
        bf16x8 kf[4]; u32x4 vr[4];
#pragma unroll
        for (int c = 0; c < 4; ++c) { kf[c] = kfn[c]; vr[c] = vrn[c]; }
        asm volatile("" ::: "memory");
#pragma unroll
        for (int c = 0; c < 4; ++c) *(MA_LAS u32x4*)(img + (lane & 1) * 2048 + (lane >> 1) * 64 + c * 16) = vr[c];
        if (n + 1 < ntile) { MA_TILE(n + 1, c1, k01, r01); (void)c1; MA_LOADS(kfn, vrn, k01, r01); }
        f32x16 s = {};
#pragma unroll
        for (int d0 = 0; d0 < 4; ++d0) s = __builtin_amdgcn_mfma_f32_32x32x16_bf16(kf[d0], qf[d0], s, 0, 0, 0);
        const int dbase = k0 + 4 * hi - qi; const int lo = (-qi > -128) ? -qi : -128; const bool tok = (BR != 2) || (qc == cls);
        float tm = -INFINITY;
#pragma unroll
        for (int r = 0; r < 16; ++r) { const int d = dbase + (r & 3) + 8 * (r >> 2); s[r] = (tok && d <= 0 && d >= lo) ? s[r] : -INFINITY; tm = fmaxf(tm, s[r]); }
        tm = fmaxf(tm, __shfl_xor(tm, 32));
        const float mn = fmaxf(S.m, tm), sc = __builtin_amdgcn_exp2f(S.m - mn);
        float ps = 0.f;
#pragma unroll
        for (int r = 0; r < 16; ++r) { s[r] = __builtin_amdgcn_exp2f(s[r] - mn); ps += s[r]; }
        S.l = S.l * sc + ps; S.m = mn;
        if (__any(sc != 1.f)) {
            if (hi == 0) SC[r32] = sc;
            asm volatile("s_waitcnt lgkmcnt(0)" ::: "memory");
#pragma unroll
            for (int j = 0; j < 4; ++j) { const f32x4 f = *(const MA_LAS f32x4*)(SC + 8 * j + 4 * hi);
#pragma unroll
                for (int e = 0; e < 4; ++e) { S.o[0][4 * j + e] *= f[e]; S.o[1][4 * j + e] *= f[e]; } }
        }
        u32x4 p0, p1;
        p0[0] = cvtpk(s[0], s[1]); p0[1] = cvtpk(s[2], s[3]); p0[2] = cvtpk(s[4], s[5]); p0[3] = cvtpk(s[6], s[7]);
        p1[0] = cvtpk(s[8], s[9]); p1[1] = cvtpk(s[10], s[11]); p1[2] = cvtpk(s[12], s[13]); p1[3] = cvtpk(s[14], s[15]);
        const bf16x8 pa0 = __builtin_bit_cast(bf16x8, p0), pa1 = __builtin_bit_cast(bf16x8, p1);
        asm volatile("s_waitcnt lgkmcnt(0)" ::: "memory");
#pragma unroll
        for (int dh = 0; dh < 2; ++dh) {
#pragma unroll
            for (int ks = 0; ks < 2; ++ks) {
                const s16x4 vlo = __builtin_bit_cast(s16x4, __builtin_amdgcn_ds_read_tr16_b64_v4i16((MA_LAS v4i16_t*)(img + dh * 2048 + ks * 1024 + trb)));
                const s16x4 vhi = __builtin_bit_cast(s16x4, __builtin_amdgcn_ds_read_tr16_b64_v4i16((MA_LAS v4i16_t*)(img + dh * 2048 + ks * 1024 + 512 + trb)));
                const bf16x8 vf = (bf16x8){vlo[0], vlo[1], vlo[2], vlo[3], vhi[0], vhi[1], vhi[2], vhi[3]};
                S.o[dh] = __builtin_amdgcn_mfma_f32_32x32x16_bf16(ks == 0 ? pa0 : pa1, vf, S.o[dh], 0, 0, 0);
            }
        }
        asm volatile("s_waitcnt lgkmcnt(0)" ::: "memory");
    }
#undef MA_TILE
#undef MA_LOADS
}
__device__ __forceinline__ void unit(const bf16* QKV, bf16* Y, int b, int h, int t0, MA_LAS unsigned char* L, int tid) {
    const int lane = tid & 63, r32 = lane & 31, hi = lane >> 5; const int w = __builtin_amdgcn_readfirstlane(tid >> 6);
    const bf16* Qb = QKV + (size_t)b * TT * PQ + h * 64;
    State S; S.o[0] = f32x16{}; S.o[1] = f32x16{}; S.m = -1e30f; S.l = 0.f;
    branch<0>(S, Qb, t0, L, w, lane);
    xchg_write<0>(S, L, w, r32, hi); __syncthreads(); xchg_read<1>(S, L, w, r32, hi); __syncthreads();
    branch<1>(S, Qb, t0, L, w, lane);
    xchg_write<1>(S, L, w, r32, hi); __syncthreads(); xchg_read<2>(S, L, w, r32, hi); __syncthreads();
    branch<2>(S, Qb, t0, L, w, lane);
    { MA_LAS unsigned char* img = L + WV + w * WSZ; MA_LAS float* SC = (MA_LAS float*)(img + 4096);
      const float lt = S.l + __shfl_xor(S.l, 32);
      if (hi == 0) SC[r32] = 1.f / lt;
      asm volatile("s_waitcnt lgkmcnt(0)" ::: "memory");
      MA_LAS float* xo = (MA_LAS float*)(L + XO);
#pragma unroll
      for (int r = 0; r < 16; ++r) { const float f = SC[crow(r, hi)]; const int ql = qloc<2>(w, crow(r, hi)); xo[ql * 64 + r32] = S.o[0][r] * f; xo[ql * 64 + 32 + r32] = S.o[1][r] * f; } }
    __syncthreads();
    { const int row = tid >> 1, hf = tid & 1; const MA_LAS float* xr = (const MA_LAS float*)(L + XO) + row * 64 + 32 * hf;
      bf16* yp = Y + ((size_t)b * TT + t0 + row) * PY + h * 64 + 32 * hf;
#pragma unroll
      for (int c = 0; c < 4; ++c) { const f32x4 a = *(const MA_LAS f32x4*)(xr + 8 * c), bq = *(const MA_LAS f32x4*)(xr + 8 * c + 4);
          u32x4 o; o[0] = cvtpk(a[0], a[1]); o[1] = cvtpk(a[2], a[3]); o[2] = cvtpk(bq[0], bq[1]); o[3] = cvtpk(bq[2], bq[3]); *(u32x4*)(yp + 8 * c) = o; } }
    __syncthreads();
}
#undef MA_LAS
}
constexpr int NBATCH = 32, T = 2048, D = 1024, M = NBATCH * T, FF = 2816;
constexpr int NQKV = 3072, NGU = 2 * FF, NZX = 5888, NZX_SRC = 5656, KCD = 2048;
constexpr float RMS_EPS = 1e-6f;
constexpr int NWAVES = 8;
constexpr int NPH = 18;
constexpr size_t MiB = 1u << 20;
constexpr size_t WS_CTL = 0, CTL_ZERO_BYTES = 192 * 1024;
constexpr size_t WS_WDQ = 192 * 1024;
constexpr size_t DO_GATES = 0;
constexpr size_t DO_CS = 16 * MiB;
constexpr size_t WS_W_ABIN = 1 * MiB, WS_W_ABOUT = 7 * MiB, WS_W_GU0 = 9 * MiB, WS_W_DN0 = 20 * MiB, WS_W_CDIN = 26 * MiB, WS_W_CDOUT = 38 * MiB, WS_W_GU1 = 42 * MiB, WS_W_DN1 = 53 * MiB;
constexpr size_t WS_XN = 59 * MiB;
constexpr size_t WS_OB = 187 * MiB;
constexpr size_t WS_R = 315 * MiB;
constexpr size_t WS_QKV = WS_R, WS_ACT = WS_R, WS_U = WS_OB, WS_Z = WS_R, WS_XBC = WS_R + 128 * MiB, WS_V = WS_XBC + 192 * MiB, WS_O = WS_V + 128 * MiB, WS_YCD = WS_XN;
constexpr size_t WS_HB = WS_O + 128 * MiB;
constexpr size_t WS_RSS = WS_HB + 128 * MiB;
constexpr size_t WS_END = WS_RSS + 4 * MiB;
static_assert(WS_W_DN1 + (size_t)D * FF * 2 <= WS_XN && WS_W_CDIN + (size_t)NZX * D * 2 <= WS_W_CDOUT && WS_W_DN0 + (size_t)D * FF * 2 <= WS_W_CDIN, "weights map");
static_assert(WS_QKV + (size_t)M * NQKV * 2 <= WS_HB && WS_ACT + (size_t)M * FF * 2 <= WS_HB && WS_YCD + (size_t)M * KCD * 2 <= WS_R && WS_U + (size_t)M * D * 2 <= WS_R && WS_END <= 1024 * MiB, "activation map");
constexpr int CW_TMO = 0, CW_CODE = 1, CW_WMAX = 64, CW_BAR = 4096, CW_CMAX = 16384  ;
constexpr int RING_OFF = 0, RING_BYTES = 131072;
constexpr int LDSCTL_OFF = 147456 - 512, MISC_OFF = LDSCTL_OFF + 320;
constexpr int LDS_BYTES = 147456;
#define GAS __attribute__((address_space(1)))
#define LAS __attribute__((address_space(3)))
typedef unsigned short bf16;
typedef unsigned v4u __attribute__((ext_vector_type(4)));
typedef float f32x4 __attribute__((ext_vector_type(4)));
typedef short bf16x8 __attribute__((ext_vector_type(8)));
typedef GAS unsigned gu32;
typedef GAS unsigned long long gu64;
#define RLX_AGENT __ATOMIC_RELAXED, __HIP_MEMORY_SCOPE_AGENT
#define LDS_WAIT() asm volatile("s_waitcnt lgkmcnt(0)" ::: "memory")
#define VM_WAIT() asm volatile("s_waitcnt vmcnt(0)" ::: "memory")
__device__ __forceinline__ unsigned long long rt() { return __builtin_amdgcn_s_memrealtime(); }
__device__ __forceinline__ unsigned f2bf(float f) { unsigned u = __builtin_bit_cast(unsigned, f); return (u + 0x7fffu + ((u >> 16) & 1u)) >> 16; }
__device__ __forceinline__ unsigned pk2(float lo, float hi) { return f2bf(lo) | (f2bf(hi) << 16); }

#define XB_TMO      128
#define XB_XCNT(j)  (256  + 64 * (j))
#define XB_XSUB(j)  (1280 + 64 * (j))
#define XB_XGEN(j)  (2304 + 64 * (j))
#define XB_TOP      3328
#define XB_TOPGEN   3392
#define XCD_BAR_WORDS 3456
#define XB_SPIN_CAP (1u << 18)

__device__ __forceinline__ unsigned xb_ld(unsigned* p)              { return __hip_atomic_load(p, __ATOMIC_RELAXED, __HIP_MEMORY_SCOPE_AGENT); }
__device__ __forceinline__ unsigned xb_add(unsigned* p, unsigned v) { return __hip_atomic_fetch_add(p, v, __ATOMIC_RELAXED, __HIP_MEMORY_SCOPE_AGENT); }
__device__ __forceinline__ unsigned xb_xcc_id() { return (unsigned)__builtin_amdgcn_s_getreg((3 << 11) | 20) & 0xFu; }
#define XB_SPIN(cond, bar) do { unsigned _sp = 0; while (cond) { __builtin_amdgcn_s_sleep(1); \
    if ((++_sp & 255u) == 0u) { if (xb_ld(&(bar)[XB_TMO])) break; if (_sp > XB_SPIN_CAP) { atomicAdd(&(bar)[XB_TMO], 1u); break; } } } } while (0)

struct XcdBarrier {
    unsigned* bar; unsigned x;
    volatile LAS unsigned* st;
};

__device__ __forceinline__ XcdBarrier xcd_barrier_post(unsigned* bar, volatile LAS unsigned* st) {
    XcdBarrier b; b.bar = bar; b.x = xb_xcc_id(); b.st = st;
    if (threadIdx.x == 0) (void)xb_add(&bar[XB_XCNT(b.x)], 1u);
    return b;
}
__device__ __forceinline__ void xcd_barrier_complete(unsigned* bar, unsigned x, unsigned& nloc, unsigned& nx) {
    const unsigned G = gridDim.x * gridDim.y * gridDim.z;
    unsigned sum, cnt, mine, sp = 0u;
    for (;;) {
        sum = 0u; cnt = 0u; mine = 0u;
#pragma unroll
        for (unsigned j = 0; j < 16; ++j) { const unsigned c = xb_ld(&bar[XB_XCNT(j)]); sum += c; cnt += (c > 0u) ? 1u : 0u; mine = (j == x) ? c : mine; }
        if (sum == G) break;
        __builtin_amdgcn_s_sleep(1);
        if ((++sp & 255u) == 0u) { if (xb_ld(&bar[XB_TMO])) break; if (sp > XB_SPIN_CAP) { atomicAdd(&bar[XB_TMO], 1u); break; } }
    }
    nloc = mine > 0u ? mine : 1u; nx = cnt > 0u ? cnt : 1u;
}

__device__ __forceinline__ void xcd_barrier(const XcdBarrier& b) {
    asm volatile("s_waitcnt vmcnt(0)" ::: "memory");
    __syncthreads();
    if (threadIdx.x == 0) {
        unsigned* bar = b.bar;
        __builtin_amdgcn_s_waitcnt(0);
        unsigned nloc = b.st[0], nx = b.st[1];
        if (nloc == 0u) { xcd_barrier_complete(bar, b.x, nloc, nx); b.st[0] = nloc; b.st[1] = nx; }
        const unsigned old = xb_add(&bar[XB_XSUB(b.x)], 1u);
        const unsigned gen = old / nloc;
        if (old + 1u == (gen + 1u) * nloc) {
            __builtin_amdgcn_fence(__ATOMIC_RELEASE, "agent");
            asm volatile("s_waitcnt vmcnt(0)" ::: "memory");
            const unsigned og = xb_add(&bar[XB_TOP], 1u);
            const unsigned tg = og / nx;
            if (og + 1u == (tg + 1u) * nx) xb_add(&bar[XB_TOPGEN], 1u);
            else XB_SPIN(xb_ld(&bar[XB_TOPGEN]) == tg, bar);
            __builtin_amdgcn_fence(__ATOMIC_ACQUIRE, "agent");
            xb_add(&bar[XB_XGEN(b.x)], 1u);
            asm volatile("s_waitcnt vmcnt(0)" ::: "memory");
        } else {
            XB_SPIN(xb_ld(&bar[XB_XGEN(b.x)]) == gen, bar);
            __builtin_amdgcn_fence(__ATOMIC_ACQUIRE, "agent");
            asm volatile("s_waitcnt vmcnt(0)" ::: "memory");
        }
    }
    __syncthreads();
}
static_assert((CW_BAR + 2 * XCD_BAR_WORDS) * 4 <= (int)CTL_ZERO_BYTES, "CTL words inside the memset region");
typedef unsigned long long u64;
__device__ __forceinline__ float wave_sum(float v) {
#pragma unroll
    for (int o = 1; o < 64; o <<= 1) v += __shfl_xor(v, o);
    return v;
}
__device__ __forceinline__ float silu_g(float x) { return x * __builtin_amdgcn_rcpf(1.f + __expf(-x)); }
__device__ __forceinline__ float sigm_g(float x) { return __builtin_amdgcn_rcpf(1.f + __expf(-x)); }
__device__ __forceinline__ float bf2f(bf16 v) { return __uint_as_float((unsigned)v << 16); }
__device__ __forceinline__ void ld8f(const bf16* p, float* f) {
    const v4u v = *(const v4u*)p;
    f[0] = __uint_as_float(v.x << 16); f[1] = __uint_as_float(v.x & 0xffff0000u); f[2] = __uint_as_float(v.y << 16); f[3] = __uint_as_float(v.y & 0xffff0000u);
    f[4] = __uint_as_float(v.z << 16); f[5] = __uint_as_float(v.z & 0xffff0000u); f[6] = __uint_as_float(v.w << 16); f[7] = __uint_as_float(v.w & 0xffff0000u);
}
__device__ __forceinline__ void st8f(bf16* p, const float* f) { v4u o; o.x = pk2(f[0], f[1]); o.y = pk2(f[2], f[3]); o.z = pk2(f[4], f[5]); o.w = pk2(f[6], f[7]); *(v4u*)p = o; }

__device__ __forceinline__ int map_gu(int n) { const int p = n >> 8, r = n & 255; return r < 128 ? 128 * p + r : FF + 128 * p + (r - 128); }
__device__ __forceinline__ int map_cdin(int n) {
    if (n < 2560) return n; if (n < 3584) return 2576 + (n - 2560); if (n < 4608) return 3600 + (n - 3584); if (n < 5632) return 4624 + (n - 4608);
    const int j = n - 5632; if (j < 16) return 2560 + j; if (j < 24) return 5648 + (j - 16); return -1;
}
template <int MAP> __device__ __forceinline__ void tr_item(const float* W, int K, int Nsrc, bf16* WT, int nblk, LAS float* scr, int item, int lane, const float* nw = nullptr) {
    const int kb = item / nblk, nb = item % nblk, k0 = 64 * kb, n0 = 32 * nb;
    const int nd = n0 + (lane & 31); const int sc = (MAP == 0) ? nd : (MAP == 1) ? map_gu(nd) : map_cdin(nd);
#pragma unroll 8
    for (int i = 0; i < 32; ++i) { const int kk = 2 * i + (lane >> 5); scr[kk * 33 + (lane & 31)] = (sc >= 0) ? W[(size_t)(k0 + kk) * Nsrc + sc] * (nw ? nw[k0 + kk] : 1.f) : 0.f; }
    LDS_WAIT(); asm volatile("" ::: "memory");
    const int c = lane & 7;
#pragma unroll
    for (int j = 0; j < 4; ++j) { const int n = (lane >> 3) + 8 * j; const LAS float* s = scr + (8 * c) * 33 + n;
        v4u o; o.x = pk2(s[0 * 33], s[1 * 33]); o.y = pk2(s[2 * 33], s[3 * 33]); o.z = pk2(s[4 * 33], s[5 * 33]); o.w = pk2(s[6 * 33], s[7 * 33]);
        *(GAS v4u*)(WT + (size_t)(n0 + n) * K + k0 + 8 * c) = o; }
    LDS_WAIT(); asm volatile("" ::: "memory");
}
__device__ __forceinline__ void tr_item8(const float* W, int K, int Nsrc, unsigned char* WT, int nblk, LAS float* scr, int item, int lane, float sc) {
    const int kb = item / nblk, nb = item % nblk, k0 = 64 * kb, n0 = 32 * nb; const int nd = n0 + (lane & 31);
#pragma unroll 8
    for (int i = 0; i < 32; ++i) { const int kk = 2 * i + (lane >> 5); scr[kk * 33 + (lane & 31)] = W[(size_t)(k0 + kk) * Nsrc + nd] * sc; }
    LDS_WAIT(); asm volatile("" ::: "memory");
    const int c = lane & 7;
#pragma unroll
    for (int j = 0; j < 4; ++j) { const int n = (lane >> 3) + 8 * j; const LAS float* s = scr + (8 * c) * 33 + n;
        const u64 o = (u64)pg8::pk4_fp8(s[0 * 33], s[1 * 33], s[2 * 33], s[3 * 33]) | ((u64)pg8::pk4_fp8(s[4 * 33], s[5 * 33], s[6 * 33], s[7 * 33]) << 32);
        *(GAS u64*)(WT + (size_t)(n0 + n) * K + k0 + 8 * c) = o; }
    LDS_WAIT(); asm volatile("" ::: "memory");
}
__device__ __forceinline__ unsigned pk4_i8(float a, float b, float c, float d) {
    const int x = __float2int_rn(a), y = __float2int_rn(b), z = __float2int_rn(c), w = __float2int_rn(d);
    return (unsigned)(x & 255) | ((unsigned)(y & 255) << 8) | ((unsigned)(z & 255) << 16) | ((unsigned)w << 24);
}
template <int MAP> __device__ __forceinline__ void tr_item_i8(const float* W, int K, int Nsrc, unsigned char* WT, int nblk, LAS float* scr, int item, int lane, const unsigned* cmax, float* wdq) {
    const int kb = item / nblk, nb = item % nblk, k0 = 64 * kb, n0 = 32 * nb; const int nd = n0 + (lane & 31); const int scn = (MAP == 0) ? nd : (MAP == 1) ? map_gu(nd) : map_cdin(nd);
    const float cm = fmaxf(__uint_as_float(cmax[scn >= 0 ? scn : 0]), 1e-30f), sc = 127.f / cm;
    if (kb == 0 && lane < 32) wdq[nd] = (scn >= 0) ? cm * (1.f / 127.f) : 0.f;
#pragma unroll 8
    for (int i = 0; i < 32; ++i) { const int kk = 2 * i + (lane >> 5); scr[kk * 33 + (lane & 31)] = (scn >= 0) ? W[(size_t)(k0 + kk) * Nsrc + scn] * sc : 0.f; }
    LDS_WAIT(); asm volatile("" ::: "memory");
    const int c = lane & 7;
#pragma unroll
    for (int j = 0; j < 4; ++j) { const int n = (lane >> 3) + 8 * j; const LAS float* s = scr + (8 * c) * 33 + n;
        const u64 o = (u64)pk4_i8(s[0 * 33], s[1 * 33], s[2 * 33], s[3 * 33]) | ((u64)pk4_i8(s[4 * 33], s[5 * 33], s[6 * 33], s[7 * 33]) << 32);
        *(GAS u64*)(WT + (size_t)(n0 + n) * K + k0 + 8 * c) = o; }
    LDS_WAIT(); asm volatile("" ::: "memory");
}
__device__ __forceinline__ void rms_row_i8(const bf16* hrow, const float* w, unsigned char* orow, float* dq, int lane) {
    float h[16]; ld8f(hrow + lane * 16, h); ld8f(hrow + lane * 16 + 8, h + 8);
    float s = 0.f;
#pragma unroll
    for (int e = 0; e < 16; ++e) s += h[e] * h[e];
    const float rstd = 1.f / sqrtf(wave_sum(s) * (1.f / D) + RMS_EPS);
    float am = 0.f;
#pragma unroll
    for (int j = 0; j < 4; ++j) { const f32x4 g = *(const f32x4*)(w + lane * 16 + 4 * j); h[4 * j] *= rstd * g.x; h[4 * j + 1] *= rstd * g.y; h[4 * j + 2] *= rstd * g.z; h[4 * j + 3] *= rstd * g.w;
        am = fmaxf(fmaxf(am, fmaxf(fabsf(h[4 * j]), fabsf(h[4 * j + 1]))), fmaxf(fabsf(h[4 * j + 2]), fabsf(h[4 * j + 3]))); }
#pragma unroll
    for (int o = 1; o < 64; o <<= 1) am = fmaxf(am, __shfl_xor(am, o));
    am = fmaxf(am, 1e-20f); const float sc = 127.f / am;
    v4u q; q.x = pk4_i8(h[0] * sc, h[1] * sc, h[2] * sc, h[3] * sc); q.y = pk4_i8(h[4] * sc, h[5] * sc, h[6] * sc, h[7] * sc); q.z = pk4_i8(h[8] * sc, h[9] * sc, h[10] * sc, h[11] * sc); q.w = pk4_i8(h[12] * sc, h[13] * sc, h[14] * sc, h[15] * sc);
    *(v4u*)(orow + lane * 16) = q;
    if (lane == 0) dq[0] = am * (1.f / 127.f);
}
__device__ __forceinline__ void rms_row_to_bf16(const float* xrow, const float* w, bf16* orow, int lane) {
    const f32x4* xr = (const f32x4*)xrow + lane; const f32x4* wr = (const f32x4*)w + lane;
    f32x4 v[4]; float s = 0.f;
#pragma unroll
    for (int j = 0; j < 4; ++j) { v[j] = xr[64 * j]; s += (v[j].x * v[j].x + v[j].y * v[j].y) + (v[j].z * v[j].z + v[j].w * v[j].w); }
    const float rstd = 1.f / sqrtf(wave_sum(s) * (1.f / D) + RMS_EPS);
    u64* o8 = (u64*)orow + lane;
#pragma unroll
    for (int j = 0; j < 4; ++j) { const f32x4 g = wr[64 * j]; o8[64 * j] = (u64)pk2(v[j].x * rstd * g.x, v[j].y * rstd * g.y) | ((u64)pk2(v[j].z * rstd * g.z, v[j].w * rstd * g.w) << 32); }
}
__device__ __forceinline__ void rms_row_bf16(const bf16* hrow, const float* w, bf16* orow, int lane) {
    float h[16]; ld8f(hrow + lane * 16, h); ld8f(hrow + lane * 16 + 8, h + 8);
    float s = 0.f;
#pragma unroll
    for (int e = 0; e < 16; ++e) s += h[e] * h[e];
    const float rstd = 1.f / sqrtf(wave_sum(s) * (1.f / D) + RMS_EPS);
#pragma unroll
    for (int j = 0; j < 4; ++j) { const f32x4 g = *(const f32x4*)(w + lane * 16 + 4 * j); h[4 * j] *= rstd * g.x; h[4 * j + 1] *= rstd * g.y; h[4 * j + 2] *= rstd * g.z; h[4 * j + 3] *= rstd * g.w; }
    st8f(orow + lane * 16, h); st8f(orow + lane * 16 + 8, h + 8);
}
__device__ __forceinline__ void final_row(const bf16* hrow, const float* w, float* orow, int lane) {
    float h[16]; ld8f(hrow + lane * 16, h); ld8f(hrow + lane * 16 + 8, h + 8);
    float s = 0.f;
#pragma unroll
    for (int e = 0; e < 16; ++e) s += h[e] * h[e];
    const float rstd = 1.f / sqrtf(wave_sum(s) * (1.f / D) + RMS_EPS);
#pragma unroll
    for (int j = 0; j < 4; ++j) { const f32x4 g = *(const f32x4*)(w + lane * 16 + 4 * j); *(f32x4*)(orow + lane * 16 + 4 * j) = (f32x4){h[4 * j] * rstd * g.x, h[4 * j + 1] * rstd * g.y, h[4 * j + 2] * rstd * g.z, h[4 * j + 3] * rstd * g.w}; }
}
__device__ __forceinline__ void rms_row_inplace_f32(float* xrow, const float* w, int lane) {
    f32x4* xr = (f32x4*)xrow + lane; const f32x4* wr = (const f32x4*)w + lane;
    f32x4 v[4]; float s = 0.f;
#pragma unroll
    for (int j = 0; j < 4; ++j) { v[j] = xr[64 * j]; s += (v[j].x * v[j].x + v[j].y * v[j].y) + (v[j].z * v[j].z + v[j].w * v[j].w); }
    const float rstd = 1.f / sqrtf(wave_sum(s) * (1.f / D) + RMS_EPS);
#pragma unroll
    for (int j = 0; j < 4; ++j) { const f32x4 g = wr[64 * j]; xr[64 * j] = v[j] * rstd * g; }
}

__device__ __forceinline__ void attnA_naive_item(const bf16* QKV, bf16* Y, int b, int h, int tb, int lane) {
    const int t = tb * 64 + lane; const size_t row = (size_t)b * T + t;
    float q[64], o[64];
#pragma unroll
    for (int c = 0; c < 8; ++c) ld8f(QKV + row * NQKV + h * 64 + 8 * c, q + 8 * c);
#pragma unroll
    for (int e = 0; e < 64; ++e) { q[e] *= 0.125f; o[e] = 0.f; }
    float m = -1e30f, l = 0.f;
#define A_KEY(tk, cw) do { const bf16* kr = QKV + ((size_t)b * T + (tk)) * NQKV + 512 + h * 64; float s = 0.f; \
    _Pragma("unroll") for (int c = 0; c < 8; ++c) { float kf[8]; ld8f(kr + 8 * c, kf); _Pragma("unroll") for (int e = 0; e < 8; ++e) s += q[8 * c + e] * kf[e]; } \
    const float mn = fmaxf(m, s); const float sc = __expf(m - mn); const float p = (cw) * __expf(s - mn); l = l * sc + p; m = mn; \
    const bf16* vr = kr + 512; \
    _Pragma("unroll") for (int c = 0; c < 8; ++c) { float vf[8]; ld8f(vr + 8 * c, vf); _Pragma("unroll") for (int e = 0; e < 8; ++e) o[8 * c + e] = o[8 * c + e] * sc + p * vf[e]; } } while (0)
    for (int d = 0; d <= 128 && d <= t; ++d) { const float cw = 1.f + ((d & 3) == 0 ? 1.f : 0.f) + ((d & 15) == 0 ? 1.f : 0.f); A_KEY(t - d, cw); }
    for (int d = 132; d <= 512 && d <= t; d += 4) { const float cw = 1.f + ((d & 15) == 0 ? 1.f : 0.f); A_KEY(t - d, cw); }
    for (int d = 528; d <= t; d += 16) { A_KEY(t - d, 1.f); }
#undef A_KEY
    const float il = 1.f / l;
#pragma unroll
    for (int e = 0; e < 64; ++e) o[e] *= il;
#pragma unroll
    for (int c = 0; c < 8; ++c) st8f(Y + row * D + h * 64 + 8 * c, o + 8 * c);
}
__device__ __forceinline__ void attnB_naive_item(const bf16* QKV, bf16* OB, int b, int hv, int tb, int lane, float qscale) {
    const int h = hv >> 2, c2 = (hv >> 1) & 1, vh = hv & 1;
    const bf16* Qp = QKV + 1536 + h * 128 + c2 * 64; const bf16* Kp = QKV + 2048 + h * 128 + c2 * 64; const bf16* Vp = QKV + 2560 + h * 128 + vh * 64;
    const int t = tb * 64 + lane; const size_t row = (size_t)b * T + t;
    float q[64], o[64];
#pragma unroll
    for (int c = 0; c < 8; ++c) ld8f(Qp + row * NQKV + 8 * c, q + 8 * c);
#pragma unroll
    for (int e = 0; e < 64; ++e) { q[e] *= qscale; o[e] = 0.f; }
    float m = -1e30f, l = 0.f;
    const int nk = tb * 64 + 64;
    for (int kk = 0; kk < nk; ++kk) {
        const bf16* kr = Kp + ((size_t)b * T + kk) * NQKV; float s = 0.f;
#pragma unroll
        for (int c = 0; c < 8; ++c) { float kf[8]; ld8f(kr + 8 * c, kf);
#pragma unroll
            for (int e = 0; e < 8; ++e) s += q[8 * c + e] * kf[e]; }
        const bool valid = kk <= t; const float sv = valid ? s : -1e30f;
        const float mn = fmaxf(m, sv); const float sc = __expf(m - mn); const float p = valid ? __expf(sv - mn) : 0.f; l = l * sc + p; m = mn;
        const bf16* vr = Vp + ((size_t)b * T + kk) * NQKV;
#pragma unroll
        for (int c = 0; c < 8; ++c) { float vf[8]; ld8f(vr + 8 * c, vf);
#pragma unroll
            for (int e = 0; e < 8; ++e) o[8 * c + e] = o[8 * c + e] * sc + p * vf[e]; }
    }
    const float il = 1.f / l;
#pragma unroll
    for (int e = 0; e < 64; ++e) o[e] *= il;
#pragma unroll
    for (int c = 0; c < 8; ++c) st8f(OB + row * D + hv * 64 + 8 * c, o + 8 * c);
}
__device__ __forceinline__ void attnB_post_row(const bf16* OB, bf16* Y, const float* subw, float lam, float outscale, size_t row, int lane) {
    const int h = lane >> 4, sub = lane & 15, vh = sub >> 3, d0 = (sub & 7) * 8;
    float a[8], b[8], r[8];
    ld8f(OB + row * D + ((h * 2 + 0) * 2 + vh) * 64 + d0, a); ld8f(OB + row * D + ((h * 2 + 1) * 2 + vh) * 64 + d0, b);
    float ss = 0.f;
#pragma unroll
    for (int e = 0; e < 8; ++e) { r[e] = a[e] - lam * b[e]; ss += r[e] * r[e]; }
    ss += __shfl_xor(ss, 1); ss += __shfl_xor(ss, 2); ss += __shfl_xor(ss, 4); ss += __shfl_xor(ss, 8);
    const float rstd = 1.f / sqrtf(ss * (1.f / 128.f) + RMS_EPS);
    const int dv = vh * 64 + d0;
#pragma unroll
    for (int e = 0; e < 8; ++e) r[e] = r[e] * rstd * subw[dv + e] * outscale;
    st8f(Y + row * D + 512 + h * 128 + dv, r);
}
template <int MODE> __device__ __forceinline__ void conv_unit(bf16* X, int pitch, int c0, const float* cw, int cwp, const float* cb, int b, int tid, const float* wq, const float* wk, bf16* KB) {
    const int oct = tid & 15, seg = tid >> 4, ch = c0 + 8 * oct;
    float w0[8], w1[8], w2[8], w3[8], bs[8], h0[8], h1[8], h2[8];
#pragma unroll
    for (int e = 0; e < 8; ++e) { w0[e] = cw[ch + e]; w1[e] = cw[cwp + ch + e]; w2[e] = cw[2 * cwp + ch + e]; w3[e] = cw[3 * cwp + ch + e]; bs[e] = cb[ch + e]; }
    bf16* base = X + ((size_t)b * T + seg * 64) * pitch + ch;
    if (seg == 0) {
#pragma unroll
        for (int e = 0; e < 8; ++e) { h0[e] = 0.f; h1[e] = 0.f; h2[e] = 0.f; }
    } else { ld8f(base - 3 * (size_t)pitch, h0); ld8f(base - 2 * (size_t)pitch, h1); ld8f(base - (size_t)pitch, h2); }
    float wqv[2][4][4], wkv[2][4][4];
    if (MODE == 1) {
#pragma unroll
        for (int a = 0; a < 2; ++a)
#pragma unroll
            for (int j = 0; j < 4; ++j)
#pragma unroll
                for (int i = 0; i < 4; ++i) { const int nb = (ch >> 2) + a; wqv[a][j][i] = wq[(nb * 4 + j) * 4 + i]; wkv[a][j][i] = wk[(nb * 4 + j) * 4 + i] * 0.0625f; }
    }
    __syncthreads();
#pragma unroll 4
    for (int s = 0; s < 64; ++s) {
        float raw[8], o[8];
        ld8f(base + (size_t)s * pitch, raw);
#pragma unroll
        for (int e = 0; e < 8; ++e) { const float v = w0[e] * h0[e] + w1[e] * h1[e] + w2[e] * h2[e] + w3[e] * raw[e] + bs[e]; o[e] = silu_g(v); h0[e] = h1[e]; h1[e] = h2[e]; h2[e] = raw[e]; }
        if (MODE == 0) st8f(base + (size_t)s * pitch, o);
        else {
            float q[8], k[8];
#pragma unroll
            for (int a = 0; a < 2; ++a)
#pragma unroll
                for (int i = 0; i < 4; ++i) { float qa = 0.f, ka = 0.f;
#pragma unroll
                    for (int j = 0; j < 4; ++j) { qa += o[4 * a + j] * wqv[a][j][i]; ka += o[4 * a + j] * wkv[a][j][i]; }
                    q[4 * a + i] = qa; k[4 * a + i] = ka; }
            st8f(base + (size_t)s * pitch, q); st8f(KB + ((size_t)b * T + seg * 64 + s) * D + ch, k);
        }
    }
    __syncthreads();
}
namespace mam {
using bf16x8 = __attribute__((ext_vector_type(8))) short;
using s16x4 = __attribute__((ext_vector_type(4))) short;
using f32x16 = __attribute__((ext_vector_type(16))) float;
using f32x4 = __attribute__((ext_vector_type(4))) float;
using u32x4 = __attribute__((ext_vector_type(4))) unsigned;
using u32x2 = __attribute__((ext_vector_type(2))) unsigned;
typedef short v4i16_t __attribute__((ext_vector_type(4)));
#define MM_LAS __attribute__((address_space(3)))
typedef unsigned short bf16;
constexpr int PXBC = 1536, TT = 2048;
constexpr int PB = 272, PX = 144, PS = 272;
constexpr int LB = 0, LC = LB + 128 * PB, LX = LC + 128 * PB, LS = LX + 2 * 128 * PX, LV = LS + 2 * 64 * PS, VSZ = 5 * 512;
constexpr int LDS_NEED = LV + 2 * VSZ;
__device__ __forceinline__ int crow(int r, int hi) { return (r & 3) + 8 * (r >> 2) + 4 * hi; }
__device__ __forceinline__ unsigned cvtpk(float lo, float hi) { typedef float f2 __attribute__((ext_vector_type(2))); typedef __bf16 b2 __attribute__((ext_vector_type(2))); f2 v = {lo, hi}; b2 b = __builtin_convertvector(v, b2); return __builtin_bit_cast(unsigned, b); }
__device__ __forceinline__ bf16x8 trfrag(const MM_LAS unsigned char* p, int rowpitch8) {
    const s16x4 lo = __builtin_bit_cast(s16x4, __builtin_amdgcn_ds_read_tr16_b64_v4i16((MM_LAS v4i16_t*)p));
    const s16x4 hi = __builtin_bit_cast(s16x4, __builtin_amdgcn_ds_read_tr16_b64_v4i16((MM_LAS v4i16_t*)(p + rowpitch8)));
    return (bf16x8){lo[0], lo[1], lo[2], lo[3], hi[0], hi[1], hi[2], hi[3]};
}
__device__ __forceinline__ void unit(bf16* XBC, const float* GT, const float* dtb, const float* alog, const float* dsk, int b, int g, int hp, MM_LAS unsigned char* L, int tid) {
    const int lane = tid & 63, r32 = lane & 31, hi = lane >> 5; const int w = __builtin_amdgcn_readfirstlane(tid >> 6);
    const int hh = w >> 2, it = hh ? 3 - (w & 3) : (w & 3), head = g * 8 + 2 * hp + hh;
    const float a_neg = -expf(alog[head]), dskh = dsk[head];
    const int q4 = (lane & 15) >> 2, p4 = lane & 3, blk = (lane >> 4) & 1;
    MM_LAS float* V = (MM_LAS float*)(L + LV + hh * VSZ);
    f32x16 st[2]; st[0] = f32x16{}; st[1] = f32x16{};
    for (int i = tid; i < 2 * 64 * PS / 4; i += 512) ((MM_LAS unsigned*)(L + LS))[i] = 0u;
    const unsigned sgo = (unsigned)(tid >> 4) * (PXBC * 2) + (unsigned)(tid & 15) * 16;
    const unsigned slo = (unsigned)(tid >> 4) * PB + (unsigned)(tid & 15) * 16;
    const unsigned sxo = (unsigned)((tid & 15) >> 3) * 128 * PX + (unsigned)(tid >> 4) * PX + (unsigned)(tid & 7) * 16;
    u32x4 tb[4], tc[4], tx[4];
    { const unsigned char* g0 = (const unsigned char*)(XBC + (size_t)b * TT * PXBC);
#pragma unroll
      for (int q = 0; q < 4; ++q) { tb[q] = *(const u32x4*)(g0 + (size_t)q * (32 * PXBC * 2) + (1024 + g * 128) * 2 + sgo); tc[q] = *(const u32x4*)(g0 + (size_t)q * (32 * PXBC * 2) + (1280 + g * 128) * 2 + sgo);
          tx[q] = *(const u32x4*)(g0 + (size_t)q * (32 * PXBC * 2) + ((g * 8 + 2 * hp) * 64) * 2 + sgo); } }
    for (int c = 0; c < 16; ++c) {
        const size_t row0 = (size_t)b * TT + c * 128;
        __syncthreads();
#pragma unroll
        for (int q = 0; q < 4; ++q) { *(MM_LAS u32x4*)(L + LB + q * (32 * PB) + slo) = tb[q]; *(MM_LAS u32x4*)(L + LC + q * (32 * PB) + slo) = tc[q]; *(MM_LAS u32x4*)(L + LX + q * (32 * PX) + sxo) = tx[q]; }
        if ((w & 3) == 0) {
            const float x0 = GT[(row0 + 2 * lane) * 32 + head] + dtb[head], x1 = GT[(row0 + 2 * lane + 1) * 32 + head] + dtb[head];
            const float dt0 = x0 > 20.f ? x0 : log1pf(expf(x0)), dt1 = x1 > 20.f ? x1 : log1pf(expf(x1));
            const float v0 = dt0 * a_neg, v1 = dt1 * a_neg, ps = v0 + v1; float inc = ps;
#pragma unroll
            for (int o = 1; o < 64; o <<= 1) { const float t = __shfl_up(inc, o); if (lane >= o) inc += t; }
            const float ac0 = inc - ps + v0, ac1 = inc, aend = __shfl(inc, 63);
            V[2 * lane] = dt0; V[2 * lane + 1] = dt1; V[128 + 2 * lane] = ac0 * 1.4426950408889634f; V[128 + 2 * lane + 1] = ac1 * 1.4426950408889634f;
            V[256 + 2 * lane] = dt0 * expf(aend - ac0); V[256 + 2 * lane + 1] = dt1 * expf(aend - ac1); V[384 + 2 * lane] = expf(ac0); V[384 + 2 * lane + 1] = expf(ac1);
            if (lane == 0) V[512] = expf(aend);
        }
        __syncthreads();
        if (c < 15) { const unsigned char* g0 = (const unsigned char*)(XBC + (row0 + 128) * PXBC);
#pragma unroll
            for (int q = 0; q < 4; ++q) { tb[q] = *(const u32x4*)(g0 + (size_t)q * (32 * PXBC * 2) + (1024 + g * 128) * 2 + sgo); tc[q] = *(const u32x4*)(g0 + (size_t)q * (32 * PXBC * 2) + (1280 + g * 128) * 2 + sgo);
                tx[q] = *(const u32x4*)(g0 + (size_t)q * (32 * PXBC * 2) + ((g * 8 + 2 * hp) * 64) * 2 + sgo); } }
        const MM_LAS unsigned char* cfp = L + LC + (32 * it + r32) * PB + 8 * hi * 2;
#define MM_CF(kn) (*(const MM_LAS bf16x8*)(cfp + 32 * (kn)))
        f32x16 yd[2]; yd[0] = f32x16{}; yd[1] = f32x16{};
#pragma unroll
        for (int pt = 0; pt < 2; ++pt)
#pragma unroll
            for (int kn = 0; kn < 8; ++kn) { const bf16x8 sf = *(const MM_LAS bf16x8*)(L + LS + hh * 64 * PS + (32 * pt + r32) * PS + (16 * kn + 8 * hi) * 2);
                yd[pt] = __builtin_amdgcn_mfma_f32_32x32x16_bf16(MM_CF(kn), sf, yd[pt], 0, 0, 0); }
#pragma unroll
        for (int jj = 0; jj < 4; ++jj) { const f32x4 ea = *(const MM_LAS f32x4*)(V + 384 + 32 * it + 8 * jj + 4 * hi);
#pragma unroll
            for (int e = 0; e < 4; ++e) { yd[0][4 * jj + e] *= ea[e]; yd[1][4 * jj + e] *= ea[e]; } }
        const float a2l = V[128 + 32 * it + r32];
        const MM_LAS unsigned char* xbase = L + LX + hh * 128 * PX + (4 * hi + q4) * PX + blk * 32 + 8 * p4;
        for (int j = 0; j <= it; ++j) {
            f32x16 X = {};
            unsigned cfo = (unsigned)((32 * it + r32) * PB + 16 * hi); asm volatile("" : "+v"(cfo));
#pragma unroll
            for (int kn = 0; kn < 8; ++kn) { const bf16x8 bfr = *(const MM_LAS bf16x8*)(L + LB + (32 * j + r32) * PB + (16 * kn + 8 * hi) * 2);
                X = __builtin_amdgcn_mfma_f32_32x32x16_bf16(bfr, *(const MM_LAS bf16x8*)(L + LC + cfo + 32 * kn), X, 0, 0, 0); }
#pragma unroll
            for (int jj = 0; jj < 4; ++jj) { const f32x4 a2s = *(const MM_LAS f32x4*)(V + 128 + 32 * j + 8 * jj + 4 * hi), dts = *(const MM_LAS f32x4*)(V + 32 * j + 8 * jj + 4 * hi);
#pragma unroll
                for (int e = 0; e < 4; ++e) { const int r = 4 * jj + e; const bool ok = (j < it) || (8 * jj + 4 * hi + e <= r32);
                    X[r] = ok ? X[r] * __builtin_amdgcn_exp2f(a2l - a2s[e]) * dts[e] : 0.f; } }
            u32x4 p0, p1;
            p0[0] = cvtpk(X[0], X[1]); p0[1] = cvtpk(X[2], X[3]); p0[2] = cvtpk(X[4], X[5]); p0[3] = cvtpk(X[6], X[7]);
            p1[0] = cvtpk(X[8], X[9]); p1[1] = cvtpk(X[10], X[11]); p1[2] = cvtpk(X[12], X[13]); p1[3] = cvtpk(X[14], X[15]);
            const bf16x8 pa0 = __builtin_bit_cast(bf16x8, p0), pa1 = __builtin_bit_cast(bf16x8, p1);
#pragma unroll
            for (int pt = 0; pt < 2; ++pt)
#pragma unroll
                for (int ks = 0; ks < 2; ++ks) { const bf16x8 xf = trfrag(xbase + (32 * j + 16 * ks) * PX + pt * 64, 8 * PX);
                    yd[pt] = __builtin_amdgcn_mfma_f32_32x32x16_bf16(ks == 0 ? pa0 : pa1, xf, yd[pt], 0, 0, 0); }
        }
        { const float eend = V[512];
#pragma unroll
          for (int r = 0; r < 16; ++r) { st[0][r] *= eend; st[1][r] *= eend; } }
        const MM_LAS unsigned char* bbase = L + LB + (4 * hi + q4) * PB + (32 * it + 16 * blk) * 2 + 8 * p4;
#pragma unroll
        for (int ks = 0; ks < 8; ++ks) {
            const bf16x8 bt = trfrag(bbase + 16 * ks * PB, 8 * PB);
            const f32x4 c0 = *(const MM_LAS f32x4*)(V + 256 + 16 * ks + 4 * hi), c1 = *(const MM_LAS f32x4*)(V + 256 + 16 * ks + 8 + 4 * hi);
            float f[8];
#pragma unroll
            for (int e = 0; e < 4; ++e) { f[e] = __uint_as_float((unsigned)(unsigned short)bt[e] << 16) * c0[e]; f[4 + e] = __uint_as_float((unsigned)(unsigned short)bt[4 + e] << 16) * c1[e]; }
            u32x4 pk; pk[0] = cvtpk(f[0], f[1]); pk[1] = cvtpk(f[2], f[3]); pk[2] = cvtpk(f[4], f[5]); pk[3] = cvtpk(f[6], f[7]);
            const bf16x8 af = __builtin_bit_cast(bf16x8, pk);
#pragma unroll
            for (int pt = 0; pt < 2; ++pt) { const bf16x8 xf = trfrag(xbase + 16 * ks * PX + pt * 64, 8 * PX); st[pt] = __builtin_amdgcn_mfma_f32_32x32x16_bf16(af, xf, st[pt], 0, 0, 0); }
        }
#pragma unroll
        for (int r = 0; r < 16; ++r) { const int l = 32 * it + crow(r, hi);
#pragma unroll
            for (int pt = 0; pt < 2; ++pt) { const float xv = __uint_as_float((unsigned)*(const MM_LAS unsigned short*)(L + LX + hh * 128 * PX + l * PX + (32 * pt + r32) * 2) << 16);
                const float y = yd[pt][r] + dskh * xv;
                XBC[(row0 + l) * PXBC + head * 64 + 32 * pt + r32] = (bf16)(cvtpk(y, 0.f) & 0xffffu); } }
        __syncthreads();
#pragma unroll
        for (int pt = 0; pt < 2; ++pt) {
#pragma unroll
            for (int jj = 0; jj < 4; ++jj) { u32x2 o; o[0] = cvtpk(st[pt][4 * jj], st[pt][4 * jj + 1]); o[1] = cvtpk(st[pt][4 * jj + 2], st[pt][4 * jj + 3]);
                *(MM_LAS u32x2*)(L + LS + hh * 64 * PS + (32 * pt + r32) * PS + (32 * it + 8 * jj + 4 * hi) * 2) = o; }
        }
    }
    __syncthreads();
}
#undef MM_CF
#undef MM_LAS
}
namespace mls {
using bf16x8 = __attribute__((ext_vector_type(8))) short;
using s16x4 = __attribute__((ext_vector_type(4))) short;
using f32x16 = __attribute__((ext_vector_type(16))) float;
using f32x4 = __attribute__((ext_vector_type(4))) float;
using u32x4 = __attribute__((ext_vector_type(4))) unsigned;
using u32x2 = __attribute__((ext_vector_type(2))) unsigned;
typedef short v4i16_t __attribute__((ext_vector_type(4)));
#define ML_LAS __attribute__((address_space(3)))
typedef unsigned short bf16;
constexpr int PD = 1024, TT = 2048;
constexpr int PK = 528, PV = 272;
constexpr int LK = 0, LVV = LK + 128 * PK, LG = LVV + 128 * PV, GSZ = 5 * 512, LN = LG + 2 * GSZ, LW = LN + 1024, LDS_NEED = LW + 8 * 256;
constexpr float LOG2E = 1.4426950408889634f;
__device__ __forceinline__ int crow(int r, int hi) { return (r & 3) + 8 * (r >> 2) + 4 * hi; }
__device__ __forceinline__ unsigned cvtpk(float lo, float hi) { typedef float f2 __attribute__((ext_vector_type(2))); typedef __bf16 b2 __attribute__((ext_vector_type(2))); f2 v = {lo, hi}; b2 b = __builtin_convertvector(v, b2); return __builtin_bit_cast(unsigned, b); }
__device__ __forceinline__ float bfx(short v) { return __uint_as_float((unsigned)(unsigned short)v << 16); }
__device__ __forceinline__ bf16x8 trfrag(const ML_LAS unsigned char* p, int rowpitch8) {
    const s16x4 lo = __builtin_bit_cast(s16x4, __builtin_amdgcn_ds_read_tr16_b64_v4i16((ML_LAS v4i16_t*)p));
    const s16x4 hi = __builtin_bit_cast(s16x4, __builtin_amdgcn_ds_read_tr16_b64_v4i16((ML_LAS v4i16_t*)(p + rowpitch8)));
    return (bf16x8){lo[0], lo[1], lo[2], lo[3], hi[0], hi[1], hi[2], hi[3]};
}
__device__ __forceinline__ void gate_vectors(ML_LAS float* gv, const float* GT, size_t row0, int h, float ibh, float fbh, float m_in, int lane) {
    const float* gb = GT + row0 * 32 + h; const unsigned go = (unsigned)lane * 64u;
    const float xi0 = gb[go + 16] + ibh, xi1 = gb[go + 48] + ibh;
    const float xf0 = gb[go + 20] + fbh, xf1 = gb[go + 52] + fbh;
    const float lf0 = xf0 > 0.f ? -log1pf(expf(-xf0)) : xf0 - log1pf(expf(xf0)), lf1 = xf1 > 0.f ? -log1pf(expf(-xf1)) : xf1 - log1pf(expf(xf1));
    const float ps = lf0 + lf1; float inc = ps;
#pragma unroll
    for (int o = 1; o < 64; o <<= 1) { const float t = __shfl_up(inc, o); if (lane >= o) inc += t; }
    const float bc0 = inc - ps + lf0, bc1 = inc, g0 = xi0 - bc0, g1 = xi1 - bc1;
    float pmx = fmaxf(g0, g1);
#pragma unroll
    for (int o = 1; o < 64; o <<= 1) { const float t = __shfl_up(pmx, o); if (lane >= o) pmx = fmaxf(pmx, t); }
    float pex = __shfl_up(pmx, 1); if (lane == 0) pex = -INFINITY;
    const float gtot0 = __shfl(inc, 63), pm127 = __shfl(pmx, 63), mm0 = fmaxf(m_in, pm127);
    gv[2 * lane] = g0 * LOG2E; gv[2 * lane + 1] = g1 * LOG2E; gv[128 + 2 * lane] = fmaxf(pex, g0); gv[128 + 2 * lane + 1] = pmx; gv[256 + 2 * lane] = bc0; gv[256 + 2 * lane + 1] = bc1;
    gv[384 + 2 * lane] = expf(g0 - mm0); gv[384 + 2 * lane + 1] = expf(g1 - mm0);
    if (lane == 0) { gv[512] = gtot0; gv[513] = pm127; }
}
__device__ __forceinline__ void unit(const bf16* Qg, const bf16* Kg, bf16* Vg, bf16* CS, const float* GT, const float* ib, const float* fb, int b, int h, int vh, ML_LAS unsigned char* L, int tid) {
    const int lane = tid & 63, r32 = lane & 31, hi = lane >> 5; const int w = __builtin_amdgcn_readfirstlane(tid >> 6);
    const int q4 = (lane & 15) >> 2, p4 = lane & 3, blk = (lane >> 4) & 1;
    ML_LAS float* NV = (ML_LAS float*)(L + LN); ML_LAS float* WS = (ML_LAS float*)(L + LW + w * 256);
    float m_in = 0.f;
    if (tid < 256) NV[tid] = 0.f;
    if (w < 4) {
        const int lt = w, l = 32 * lt + r32;
        const float ibh = ib[h], fbh = fb[h];
        if (w == 0) gate_vectors((ML_LAS float*)(L + LG), GT, (size_t)b * TT, h, ibh, fbh, 0.f, lane);
        for (int c = 0; c < 16; ++c) {
            const size_t row0 = (size_t)b * TT + c * 128;
            ML_LAS float* G2 = (ML_LAS float*)(L + LG + (c & 1) * GSZ); ML_LAS float* PM = G2 + 128; ML_LAS float* BC = G2 + 256; ML_LAS float* SCL = G2 + 512;
            __syncthreads();
            const bf16* qp = Qg + (row0 + l) * PD + h * 256 + 8 * hi;
            f32x16 num[4]; num[0] = f32x16{}; num[1] = f32x16{}; num[2] = f32x16{}; num[3] = f32x16{};
            float qn = 0.f;
            if (c > 0) {
                const bf16* cp = CS + (size_t)r32 * 256 + 8 * hi;
#pragma unroll 4
                for (int kk = 0; kk < 16; ++kk) {
                    const bf16x8 q8 = *(const bf16x8*)(qp + 16 * kk);
                    const f32x4 n0 = *(const ML_LAS f32x4*)(NV + 16 * kk + 8 * hi), n1 = *(const ML_LAS f32x4*)(NV + 16 * kk + 8 * hi + 4);
#pragma unroll
                    for (int e = 0; e < 4; ++e) { qn += bfx(q8[e]) * n0[e]; qn += bfx(q8[4 + e]) * n1[e]; }
#pragma unroll
                    for (int vt = 0; vt < 4; ++vt) { const bf16x8 cs = *(const bf16x8*)(cp + (size_t)vt * 32 * 256 + 16 * kk); num[vt] = __builtin_amdgcn_mfma_f32_32x32x16_bf16(q8, cs, num[vt], 0, 0, 0); }
                }
                qn += __shfl_xor(qn, 32);
            }
            asm volatile("" ::: "memory");
            bf16x8 qf[16];
#pragma unroll
            for (int kk = 0; kk < 16; ++kk) qf[kk] = *(const bf16x8*)(qp + 16 * kk);
            __syncthreads();
            const float gtot = SCL[0], mm = fmaxf(m_in, SCL[1]);
            const float ml = fmaxf(PM[l], m_in), ei = expf(m_in - ml), ml2 = ml * LOG2E;
            if (hi == 0) WS[r32] = ei;
            asm volatile("s_waitcnt lgkmcnt(0)" ::: "memory");
#pragma unroll
            for (int jj = 0; jj < 4; ++jj) { const f32x4 f = *(const ML_LAS f32x4*)(WS + 8 * jj + 4 * hi);
#pragma unroll
                for (int e = 0; e < 4; ++e) { num[0][4 * jj + e] *= f[e]; num[1][4 * jj + e] *= f[e]; num[2][4 * jj + e] *= f[e]; num[3][4 * jj + e] *= f[e]; } }
            float dsum = 0.f;
            const ML_LAS unsigned char* vbase = L + LVV + (4 * hi + q4) * PV + blk * 32 + 8 * p4;
            for (int j = 0; j <= lt; ++j) {
                f32x16 S = {};
#pragma unroll
                for (int kk = 0; kk < 16; ++kk) { const bf16x8 kf = *(const ML_LAS bf16x8*)(L + LK + (32 * j + r32) * PK + (16 * kk + 8 * hi) * 2);
                    S = __builtin_amdgcn_mfma_f32_32x32x16_bf16(kf, qf[kk], S, 0, 0, 0);
                    if ((kk & 3) == 3) asm volatile("" ::: "memory"); }
#pragma unroll
                for (int jj = 0; jj < 4; ++jj) { const f32x4 g2 = *(const ML_LAS f32x4*)(G2 + 32 * j + 8 * jj + 4 * hi);
#pragma unroll
                    for (int e = 0; e < 4; ++e) { const int r = 4 * jj + e; const bool ok = (j < lt) || (8 * jj + 4 * hi + e <= r32);
                        S[r] = ok ? S[r] * __builtin_amdgcn_exp2f(g2[e] - ml2) : 0.f; dsum += S[r]; } }
                u32x4 p0, p1;
                p0[0] = cvtpk(S[0], S[1]); p0[1] = cvtpk(S[2], S[3]); p0[2] = cvtpk(S[4], S[5]); p0[3] = cvtpk(S[6], S[7]);
                p1[0] = cvtpk(S[8], S[9]); p1[1] = cvtpk(S[10], S[11]); p1[2] = cvtpk(S[12], S[13]); p1[3] = cvtpk(S[14], S[15]);
                const bf16x8 pa0 = __builtin_bit_cast(bf16x8, p0), pa1 = __builtin_bit_cast(bf16x8, p1);
#pragma unroll
                for (int vt = 0; vt < 4; ++vt)
#pragma unroll
                    for (int ks = 0; ks < 2; ++ks) { const bf16x8 vf = trfrag(vbase + (32 * j + 16 * ks) * PV + vt * 64, 8 * PV);
                        num[vt] = __builtin_amdgcn_mfma_f32_32x32x16_bf16(ks == 0 ? pa0 : pa1, vf, num[vt], 0, 0, 0); }
            }
            { const float dtot = dsum + __shfl_xor(dsum, 32); const float den = dtot + ei * qn; const float mo = BC[l] + ml;
              const float dn = fmaxf(fabsf(den), expf(-mo));
              if (hi == 0) WS[32 + r32] = 1.f / dn; }
            asm volatile("s_waitcnt lgkmcnt(0)" ::: "memory");
#pragma unroll
            for (int jj = 0; jj < 4; ++jj) { const f32x4 f = *(const ML_LAS f32x4*)(WS + 32 + 8 * jj + 4 * hi);
#pragma unroll
                for (int e = 0; e < 4; ++e) { const int r = 4 * jj + e; bf16* ob = Vg + (row0 + 32 * lt) * PD + h * 256 + vh * 128; const unsigned oo = (unsigned)(8 * jj + 4 * hi + e) * PD + (unsigned)r32;
#pragma unroll
                    for (int vt = 0; vt < 4; ++vt) ob[oo + 32 * vt] = (bf16)(cvtpk(num[vt][r] * f[e], 0.f) & 0xffffu); } }
            m_in = gtot + mm;
            if (w == 0 && c < 15) gate_vectors((ML_LAS float*)(L + LG + ((c + 1) & 1) * GSZ), GT, row0 + 128, h, ibh, fbh, m_in, lane);
            __syncthreads();
        }
    } else {
        const int sw = w - 4, t2 = tid - 256;
        f32x16 acc[2][4];
#pragma unroll
        for (int kt = 0; kt < 2; ++kt)
#pragma unroll
            for (int vt = 0; vt < 4; ++vt) acc[kt][vt] = f32x16{};
        float nreg[2] = {0.f, 0.f};
        for (int c = 0; c < 16; ++c) {
            const size_t row0 = (size_t)b * TT + c * 128;
            ML_LAS float* CF = (ML_LAS float*)(L + LG + (c & 1) * GSZ) + 384; ML_LAS float* SCL = CF + 128;
            __syncthreads();
            {
              const unsigned char* kb = (const unsigned char*)(Kg + row0 * PD + h * 256); const unsigned char* vb = (const unsigned char*)(Vg + row0 * PD + h * 256 + vh * 128);
              const unsigned kvo = (unsigned)(t2 >> 5) * (PD * 2) + (unsigned)(t2 & 31) * 16, vvo = (unsigned)(t2 >> 4) * (PD * 2) + (unsigned)(t2 & 15) * 16;
              const unsigned klo = (unsigned)(t2 >> 5) * PK + (unsigned)(t2 & 31) * 16, vlo = (unsigned)(t2 >> 4) * PV + (unsigned)(t2 & 15) * 16;
              u32x4 t[12];
#pragma unroll
              for (int q = 0; q < 12; ++q) t[q] = *(const u32x4*)(kb + (size_t)q * (8 * PD * 2) + kvo);
#pragma unroll
              for (int q = 0; q < 12; ++q) *(ML_LAS u32x4*)(L + LK + q * (8 * PK) + klo) = t[q];
#pragma unroll
              for (int q = 0; q < 4; ++q) t[q] = *(const u32x4*)(kb + (size_t)(12 + q) * (8 * PD * 2) + kvo);
#pragma unroll
              for (int q = 0; q < 8; ++q) t[4 + q] = *(const u32x4*)(vb + (size_t)q * (16 * PD * 2) + vvo);
#pragma unroll
              for (int q = 0; q < 4; ++q) *(ML_LAS u32x4*)(L + LK + (12 + q) * (8 * PK) + klo) = t[q];
#pragma unroll
              for (int q = 0; q < 8; ++q) *(ML_LAS u32x4*)(L + LVV + q * (16 * PV) + vlo) = t[4 + q]; }
            __syncthreads();
            const float gtot = SCL[0], mm = fmaxf(m_in, SCL[1]), d_old = expf(m_in - mm);
#pragma unroll
            for (int kt = 0; kt < 2; ++kt)
#pragma unroll
                for (int vt = 0; vt < 4; ++vt)
#pragma unroll
                    for (int r = 0; r < 16; ++r) acc[kt][vt][r] *= d_old;
            const ML_LAS unsigned char* kbase = L + LK + (4 * hi + q4) * PK + (64 * sw + 16 * blk) * 2 + 8 * p4;
            const ML_LAS unsigned char* vb4 = L + LVV + (4 * hi + q4) * PV + blk * 32 + 8 * p4;
            float nacc[2] = {0.f, 0.f};
#pragma unroll 2
            for (int ks = 0; ks < 8; ++ks) {
                const f32x4 c0 = *(const ML_LAS f32x4*)(CF + 16 * ks + 4 * hi), c1 = *(const ML_LAS f32x4*)(CF + 16 * ks + 8 + 4 * hi);
                bf16x8 af[2];
#pragma unroll
                for (int kt = 0; kt < 2; ++kt) { const bf16x8 ktf = trfrag(kbase + 16 * ks * PK + kt * 64, 8 * PK);
                    float f[8];
#pragma unroll
                    for (int e = 0; e < 4; ++e) { f[e] = bfx(ktf[e]) * c0[e]; f[4 + e] = bfx(ktf[4 + e]) * c1[e]; }
                    nacc[kt] += ((f[0] + f[1]) + (f[2] + f[3])) + ((f[4] + f[5]) + (f[6] + f[7]));
                    u32x4 pk; pk[0] = cvtpk(f[0], f[1]); pk[1] = cvtpk(f[2], f[3]); pk[2] = cvtpk(f[4], f[5]); pk[3] = cvtpk(f[6], f[7]);
                    af[kt] = __builtin_bit_cast(bf16x8, pk); }
#pragma unroll
                for (int vt = 0; vt < 4; ++vt) { const bf16x8 vf = trfrag(vb4 + 16 * ks * PV + vt * 64, 8 * PV);
                    acc[0][vt] = __builtin_amdgcn_mfma_f32_32x32x16_bf16(af[0], vf, acc[0][vt], 0, 0, 0); acc[1][vt] = __builtin_amdgcn_mfma_f32_32x32x16_bf16(af[1], vf, acc[1][vt], 0, 0, 0); }
            }
            nacc[0] += __shfl_xor(nacc[0], 32); nacc[1] += __shfl_xor(nacc[1], 32);
            nreg[0] = d_old * nreg[0] + nacc[0]; nreg[1] = d_old * nreg[1] + nacc[1];
            __syncthreads();
#pragma unroll
            for (int kt = 0; kt < 2; ++kt)
#pragma unroll
                for (int vt = 0; vt < 4; ++vt)
#pragma unroll
                    for (int jj = 0; jj < 4; ++jj) { u32x2 o; o[0] = cvtpk(acc[kt][vt][4 * jj], acc[kt][vt][4 * jj + 1]); o[1] = cvtpk(acc[kt][vt][4 * jj + 2], acc[kt][vt][4 * jj + 3]);
                        *(u32x2*)(CS + (size_t)(32 * vt + r32) * 256 + 64 * sw + 32 * kt + 8 * jj + 4 * hi) = o; }
            if (hi == 0) { NV[64 * sw + r32] = nreg[0]; NV[64 * sw + 32 + r32] = nreg[1]; }
            m_in = gtot + mm;
        }
    }
    __syncthreads();
}
#undef ML_LAS
}
__device__ __forceinline__ void mamba_naive_unit(LAS unsigned char* L, const bf16* XBC, const float* GT, bf16* YM, const float* cw, const float* cb, const float* dtb, const float* alog, const float* dsk, int b, int g, int tid) {
    LAS float* BC = (LAS float*)L;
    LAS float* DT = (LAS float*)(L + 8192);
    const int hl = tid >> 6, p = tid & 63, head = g * 8 + hl, colx = head * 64 + p;
    const float w0 = cw[colx], w1 = cw[1536 + colx], w2 = cw[2 * 1536 + colx], w3 = cw[3 * 1536 + colx], bb = cb[colx];
    float h0 = 0.f, h1 = 0.f, h2 = 0.f;
    const int colbc = 1024 + ((tid & 255) < 128 ? g * 128 + (tid & 255) : 256 + g * 128 + ((tid & 255) - 128));
    const float v0 = cw[colbc], v1 = cw[1536 + colbc], v2 = cw[2 * 1536 + colbc], v3 = cw[3 * 1536 + colbc], vb = cb[colbc];
    float g0 = 0.f, g1 = 0.f, g2 = 0.f;
    const float dskh = dsk[head];
    float S[128];
#pragma unroll
    for (int n = 0; n < 128; ++n) S[n] = 0.f;
    for (int t0 = 0; t0 < T; t0 += 8) {
        if (tid < 256) {
#pragma unroll
            for (int s = 0; s < 8; ++s) { const float raw = bf2f(XBC[((size_t)b * T + t0 + s) * 1536 + colbc]); const float v = v0 * g0 + v1 * g1 + v2 * g2 + v3 * raw + vb; g0 = g1; g1 = g2; g2 = raw; BC[s * 256 + tid] = silu_g(v); }
        } else if (tid < 320) {
            const int s = (tid - 256) >> 3, hh = (tid - 256) & 7, hd2 = g * 8 + hh;
            const float x = GT[((size_t)b * T + t0 + s) * 32 + hd2] + dtb[hd2]; const float dt = x > 20.f ? x : log1pf(expf(x));
            DT[s * 8 + hh] = dt; DT[64 + s * 8 + hh] = expf(-dt * expf(alog[hd2]));
        }
        __syncthreads();
#pragma unroll 1
        for (int s = 0; s < 8; ++s) {
            const size_t row = (size_t)b * T + t0 + s;
            const float raw = bf2f(XBC[row * 1536 + colx]); const float v = w0 * h0 + w1 * h1 + w2 * h2 + w3 * raw + bb; h0 = h1; h1 = h2; h2 = raw;
            const float xv = silu_g(v), dt = DT[s * 8 + hl], dA = DT[64 + s * 8 + hl], coef = dt * xv;
            float acc = 0.f;
#pragma unroll
            for (int n4 = 0; n4 < 32; ++n4) { const f32x4 Bv = *(const LAS f32x4*)(BC + s * 256 + 4 * n4), Cv = *(const LAS f32x4*)(BC + s * 256 + 128 + 4 * n4);
#pragma unroll
                for (int j = 0; j < 4; ++j) { S[4 * n4 + j] = dA * S[4 * n4 + j] + coef * Bv[j]; acc += Cv[j] * S[4 * n4 + j]; } }
            YM[row * D + colx] = (bf16)f2bf(acc + dskh * xv);
        }
        __syncthreads();
    }
}
__device__ __forceinline__ void mlstm_naive_unit(LAS unsigned char* L, const bf16* U, bf16* V, const float* GT, const float* cw, const float* cb, const float* wq, const float* wk, const float* ib, const float* fb, int b, int h, int vh, int tid) {
    LAS float* UC = (LAS float*)L;
    LAS float* Q8 = (LAS float*)(L + 8192);
    LAS float* K8 = (LAS float*)(L + 8192 + 8704);
    LAS float* IF = (LAS float*)(L + 8192 + 2 * 8704);
    const int vl = tid >> 2, kq = tid & 3, colv = h * 256 + vh * 128 + vl;
    const int ju = tid & 255, colu = h * 256 + ju;
    const float w0 = cw[colu], w1 = cw[1024 + colu], w2 = cw[2048 + colu], w3 = cw[3072 + colu], bu = cb[colu];
    float h0 = 0.f, h1 = 0.f, h2 = 0.f;
    float wqv[4], wkv[4];
    { const int nblk = h * 64 + (ju >> 2), i = ju & 3;
#pragma unroll
      for (int jj = 0; jj < 4; ++jj) { wqv[jj] = wq[(nblk * 4 + jj) * 4 + i]; wkv[jj] = wk[(nblk * 4 + jj) * 4 + i] * 0.0625f; } }
    float C[64], N[64];
#pragma unroll
    for (int j = 0; j < 64; ++j) { C[j] = 0.f; N[j] = 0.f; }
    const float ibh = ib[h], fbh = fb[h];
    for (int t0 = 0; t0 < T; t0 += 8) {
        if (tid < 256) {
#pragma unroll
            for (int s = 0; s < 8; ++s) { const float raw = bf2f(U[((size_t)b * T + t0 + s) * D + colu]); const float v = w0 * h0 + w1 * h1 + w2 * h2 + w3 * raw + bu; h0 = h1; h1 = h2; h2 = raw; UC[s * 256 + tid] = silu_g(v); }
        } else if (tid < 264) {
            const int s = tid - 256; const size_t row = (size_t)b * T + t0 + s;
            IF[2 * s] = expf(GT[row * 32 + 16 + h] + ibh); IF[2 * s + 1] = sigm_g(GT[row * 32 + 20 + h] + fbh);
        }
        __syncthreads();
        if (tid < 256) {
#pragma unroll
            for (int s = 0; s < 8; ++s) { const f32x4 u4 = *(const LAS f32x4*)(UC + s * 256 + (tid & ~3));
                const float qv = u4[0] * wqv[0] + u4[1] * wqv[1] + u4[2] * wqv[2] + u4[3] * wqv[3], kv = u4[0] * wkv[0] + u4[1] * wkv[1] + u4[2] * wkv[2] + u4[3] * wkv[3];
                Q8[s * 272 + (tid >> 6) * 68 + (tid & 63)] = qv; K8[s * 272 + (tid >> 6) * 68 + (tid & 63)] = kv; }
        }
        __syncthreads();
#pragma unroll 1
        for (int s = 0; s < 8; ++s) {
            const size_t row = (size_t)b * T + t0 + s;
            const float vt = bf2f(V[row * D + colv]), ig = IF[2 * s], f = IF[2 * s + 1], iv = ig * vt;
            float num = 0.f, den = 0.f;
#pragma unroll
            for (int j4 = 0; j4 < 16; ++j4) { const f32x4 kv = *(const LAS f32x4*)(K8 + s * 272 + kq * 68 + 4 * j4), qv = *(const LAS f32x4*)(Q8 + s * 272 + kq * 68 + 4 * j4);
#pragma unroll
                for (int j = 0; j < 4; ++j) { C[4 * j4 + j] = f * C[4 * j4 + j] + iv * kv[j]; N[4 * j4 + j] = f * N[4 * j4 + j] + ig * kv[j]; num += C[4 * j4 + j] * qv[j]; den += N[4 * j4 + j] * qv[j]; } }
            num += __shfl_xor(num, 1); num += __shfl_xor(num, 2); den += __shfl_xor(den, 1); den += __shfl_xor(den, 2);
            const float hv = num / fmaxf(fabsf(den), 1.f);
            if (kq == 0) V[row * D + colv] = (bf16)f2bf(hv);
        }
        __syncthreads();
    }
}
__device__ __forceinline__ void gate_row(const bf16* YM, int ymp, const bf16* Z, const bf16* HD, const bf16* OP, bf16* YCD, const float* cnw, const float* dnw, size_t row, int lane) {
    float y[16], z[16];
    ld8f(YM + row * ymp + lane * 16, y); ld8f(YM + row * ymp + lane * 16 + 8, y + 8); ld8f(Z + row * D + lane * 16, z); ld8f(Z + row * D + lane * 16 + 8, z + 8);
    float ss = 0.f;
#pragma unroll
    for (int e = 0; e < 16; ++e) { y[e] = y[e] * silu_g(z[e]); ss += y[e] * y[e]; }
    ss = wave_sum(ss); float rstd = 1.f / sqrtf(ss * (1.f / 1024.f) + RMS_EPS);
#pragma unroll
    for (int e = 0; e < 16; ++e) y[e] = y[e] * rstd * cnw[lane * 16 + e];
    st8f(YCD + row * KCD + lane * 16, y); st8f(YCD + row * KCD + lane * 16 + 8, y + 8);
    ld8f(HD + row * D + lane * 16, y); ld8f(HD + row * D + lane * 16 + 8, y + 8); ld8f(OP + row * D + lane * 16, z); ld8f(OP + row * D + lane * 16 + 8, z + 8);
    ss = 0.f;
#pragma unroll
    for (int e = 0; e < 16; ++e) ss += y[e] * y[e];
    ss += __shfl_xor(ss, 1); ss += __shfl_xor(ss, 2); ss += __shfl_xor(ss, 4); ss += __shfl_xor(ss, 8);
    rstd = 1.f / sqrtf(ss * (1.f / 256.f) + RMS_EPS);
#pragma unroll
    for (int e = 0; e < 16; ++e) y[e] = sigm_g(z[e]) * y[e] * rstd * dnw[lane * 16 + e];
    st8f(YCD + row * KCD + 1024 + lane * 16, y); st8f(YCD + row * KCD + 1024 + lane * 16 + 8, y + 8);
}

struct Args { const float* in[28]; float* out; unsigned char* ws; int ph_lo, ph_hi, li, pad; };
__global__ void __launch_bounds__(NWAVES * 64, 2) fwd_kernel(Args args) {
    extern __shared__ __attribute__((aligned(16))) unsigned char lds[];
    LAS unsigned char* L = (LAS unsigned char*)lds;
    volatile LAS unsigned* MISC = (volatile LAS unsigned*)(L + MISC_OFF);
    const int tid = threadIdx.x, lane = tid & 63, wave = __builtin_amdgcn_readfirstlane(tid >> 6);
    const int G = gridDim.x, bx = blockIdx.x; const int vcu = (G % 8 == 0) ? (bx % 8) * (G / 8) + bx / 8 : bx;
    const int gw = vcu * NWAVES + wave, NGW = G * NWAVES;
    unsigned char* ws = args.ws;
    gu32* ctl = (gu32*)(ws + WS_CTL);
    for (int u = tid; u < (LDS_BYTES - LDSCTL_OFF) / 4; u += NWAVES * 64) ((LAS unsigned*)(L + LDSCTL_OFF))[u] = 0u;
    __syncthreads();
    XcdBarrier bar; bar.bar = (unsigned*)(ctl + CW_BAR) + args.li * XCD_BAR_WORDS; bar.x = 0; bar.st = nullptr;
    if (MK_ONE_LAUNCH) bar = xcd_barrier_post((unsigned*)(ctl + CW_BAR) + args.li * XCD_BAR_WORDS, MISC + 8);
    const int lo = args.ph_lo, hi = args.ph_hi;
#define IN(k) (lo <= (k) && (k) < hi)
#define SEAM(k) do { if (MK_ONE_LAUNCH && IN(k) && IN((k) + 1)) xcd_barrier(bar); } while (0)
    float* out = args.out;
#define XIN (args.in[0])
#define W_ABIN ((bf16*)(ws + WS_W_ABIN))
#define W_ABOUT ((bf16*)(ws + WS_W_ABOUT))
#define W_GU0 ((bf16*)(ws + WS_W_GU0))
#define W_DN0 ((bf16*)(ws + WS_W_DN0))
#define W_CDIN ((bf16*)(ws + WS_W_CDIN))
#define W_CDOUT ((bf16*)(ws + WS_W_CDOUT))
#define W_GU1 ((bf16*)(ws + WS_W_GU1))
#define W_DN1 ((bf16*)(ws + WS_W_DN1))
#define XN ((bf16*)(ws + WS_XN))
#define OB ((bf16*)(ws + WS_OB))
#define QKV ((bf16*)(ws + WS_QKV))
#define ACT ((bf16*)(ws + WS_ACT))
#define ZB ((bf16*)(ws + WS_Z))
#define XBC ((bf16*)(ws + WS_XBC))
#define UB ((bf16*)(ws + WS_U))
#define VB ((bf16*)(ws + WS_V))
#define OPB ((bf16*)(ws + WS_O))
#define YCD ((bf16*)(ws + WS_YCD))
#define GT ((float*)((unsigned char*)args.out + DO_GATES))
#define HB ((bf16*)(ws + WS_HB))
#define WDQ ((float*)(ws + WS_WDQ))
#define PSUM ((float*)(ws + WS_RSS))
#define RED ((LAS float*)(L + RING_OFF + RING_BYTES + 8192))

    if (IN(0)) for (int rep = 0; rep < 1; ++rep) {
        LAS float* scr = (LAS float*)(L + RING_OFF + wave * 16384);
        constexpr int I0 = 16 * 96, I1 = 16 * 32, I2 = 16 * 176, I3 = 44 * 32, I4 = 16 * 184, I5 = 32 * 32;
        constexpr int NITEMS = I0 + I1 + 2 * I3 + I5;
        for (int it = gw; it < NITEMS; it += NGW) {
            int r = it;
            if (r < I0) { tr_item<0>(args.in[3], D, NQKV, W_ABIN, NQKV / 32, scr, r, lane); continue; } r -= I0;
            if (r < I1) { tr_item<0>(args.in[4], D, D, W_ABOUT, D / 32, scr, r, lane); continue; } r -= I1;

            if (r < I3) { tr_item<0>(args.in[26], FF, D, W_DN0, D / 32, scr, r, lane); continue; } r -= I3;

            if (r < I5) { tr_item<0>(args.in[24], KCD, D, W_CDOUT, D / 32, scr, r, lane); continue; } r -= I5;

            tr_item<0>(args.in[26] + (size_t)FF * D, FF, D, W_DN1, D / 32, scr, r, lane);
        }
        for (int blk = gw; blk < 2 * 16 * 88; blk += NGW) {
            const int l = blk / (16 * 88), r2 = blk % (16 * 88), kb = r2 / 88, nb = r2 % 88; const float* wp = args.in[25] + (size_t)l * D * NGU + (size_t)(64 * kb) * NGU + 64 * nb + lane; float am = 0.f;
#pragma unroll 8
            for (int kk = 0; kk < 64; ++kk) am = fmaxf(am, fabsf(wp[(size_t)kk * NGU]));
            __hip_atomic_fetch_max((unsigned*)(ctl + CW_CMAX) + l * NGU + 64 * nb + lane, __float_as_uint(am), __ATOMIC_RELAXED, __HIP_MEMORY_SCOPE_AGENT); }
        for (int blk = gw; blk < 16 * 89; blk += NGW) {
            const int kb = blk / 89, nb = blk % 89, col = 64 * nb + lane; float am = 0.f;
            if (col < NZX_SRC) { const float* wp = args.in[10] + (size_t)(64 * kb) * NZX_SRC + col;
#pragma unroll 8
                for (int kk = 0; kk < 64; ++kk) am = fmaxf(am, fabsf(wp[(size_t)kk * NZX_SRC]));
                __hip_atomic_fetch_max((unsigned*)(ctl + CW_CMAX) + 2 * NGU + col, __float_as_uint(am), __ATOMIC_RELAXED, __HIP_MEMORY_SCOPE_AGENT); } }
        for (int m = gw; m < M; m += NGW) rms_row_to_bf16(XIN + (size_t)m * D, args.in[1], XN + (size_t)m * D, lane);
    }
    SEAM(0);
    if (IN(1)) {
        pg8::Gemm g{XN, W_ABIN, M, NQKV, D, nullptr, nullptr}; pg8::StaticOrder S; S.init(M, NQKV, G, bx);
        pg8::EpiQKV E{QKV, NQKV, 0, 2, 6, 8, attn_body::C2};
        pg8::gemm_phase<pg8::EpiQKV, pg8::StaticOrder, true, true>(L + RING_OFF, g, S, E);
        if (PROBE_G) pg8::gemm_phase<pg8::EpiQKV, pg8::StaticOrder, true, true>(L + RING_OFF, g, S, E);
    }
    SEAM(1);
    if (IN(2)) for (int rep = 0; rep < (PROBE_T ? 2 : 1); ++rep) {
        bf16* Y = XN;
        { const attn_body::AttnTensors AT{(const attn_body::bf16*)QKV, (const attn_body::bf16*)QKV, (const attn_body::bf16*)QKV, (attn_body::bf16*)OB}; const attn_body::StaticOrder S((int)G, (int)blockIdx.x);
          attn_body::attn_phase<attn_body::StaticOrder>((char*)lds + RING_OFF, AT, S); }
        static_assert(mixa::LDS_NEED <= RING_BYTES, "mixer A LDS");
        int tid2 = tid, vcu2 = vcu; asm volatile("" : "+v"(tid2), "+s"(vcu2));
        for (int u = vcu2; u < NBATCH * 8; u += G) {
#pragma unroll 1
            for (int tb = 0; tb < 8; ++tb) mixa::unit(QKV, Y, u >> 3, u & 7, tb * 256, L + RING_OFF, tid2);
        }
    }
    SEAM(2);
    if (IN(3)) for (int rep = 0; rep < (PROBE_T ? 2 : 1); ++rep) {
        bf16* Y = XN;
        const float s1 = wave_sum(args.in[5][lane] * args.in[6][lane]), s2 = wave_sum(args.in[7][lane] * args.in[8][lane]);
        const float lam = expf(s1) - expf(s2) + 0.2f;
        for (int m = gw; m < M; m += NGW) attnB_post_row(OB, Y, args.in[9], lam, 0.8f, (size_t)m, lane);
        { LAS float* scr = (LAS float*)(L + RING_OFF + wave * 16384);
          for (int it = gw; it < 16 * 176; it += NGW) tr_item_i8<1>(args.in[25], D, NGU, (unsigned char*)W_GU0, NGU / 32, scr, it, lane, (const unsigned*)(ctl + CW_CMAX), WDQ);
          for (int it = gw; it < 16 * 176; it += NGW) tr_item_i8<1>(args.in[25] + (size_t)D * NGU, D, NGU, (unsigned char*)W_GU1, NGU / 32, scr, it, lane, (const unsigned*)(ctl + CW_CMAX) + NGU, WDQ + NGU);
          for (int it = gw; it < 16 * 184; it += NGW) tr_item_i8<2>(args.in[10], D, NZX_SRC, (unsigned char*)W_CDIN, NZX / 32, scr, it, lane, (const unsigned*)(ctl + CW_CMAX) + 2 * NGU, WDQ + 2 * NGU); }
    }
    SEAM(3);
    if (IN(4)) {
        pg8::Gemm g{XN, W_ABOUT, M, D, D, nullptr, nullptr}; pg8::StaticOrder S; S.init(M, D, G, bx);
        pg8::EpiResidBf<true, false, false> E{XIN, HB, D, nullptr, nullptr};
        pg8::gemm_phase<pg8::EpiResidBf<true, false, false>, pg8::StaticOrder, true, true>(L + RING_OFF, g, S, E);
    }
    SEAM(4);
    if (IN(5)) { for (int m = gw; m < M; m += NGW) rms_row_i8(HB + (size_t)m * D, args.in[2], (unsigned char*)XN + (size_t)m * D, PSUM + (size_t)m * 4, lane); }
    SEAM(5);
    if (IN(6)) {
        pg8::Gemm g{XN, W_GU0, M, NGU, D / 2, PSUM, WDQ};   pg8::StaticOrder S; S.init(M, NGU, G, bx, 8);
        pg8::EpiSwiglu<false, 2> E{(unsigned char*)ACT, FF, 0.f};
        pg8::gemm_phase<pg8::EpiSwiglu<false, 2>, pg8::StaticOrder, true, true>(L + RING_OFF, g, S, E);
        if (PROBE_G) pg8::gemm_phase<pg8::EpiSwiglu<false, 2>, pg8::StaticOrder, true, true>(L + RING_OFF, g, S, E);
    }
    SEAM(6);
    if (IN(7)) {
        pg8::Gemm g{ACT, W_DN0, M, D, FF, nullptr, nullptr}; pg8::StaticOrder S; S.init(M, D, G, bx);
        pg8::EpiResidBf<false, false, false> E{nullptr, HB, D, nullptr, nullptr};
        pg8::gemm_phase<pg8::EpiResidBf<false, false, false>, pg8::StaticOrder, true, true>(L + RING_OFF, g, S, E);
    }
    SEAM(7);
    if (IN(8)) { for (int m = gw; m < M; m += NGW) rms_row_i8(HB + (size_t)m * D, args.in[1] + D, (unsigned char*)XN + (size_t)m * D, PSUM + (size_t)m * 4, lane); }
    SEAM(8);
    if (IN(9)) {
        pg8::Gemm g{XN, W_CDIN, M, NZX, D / 2, PSUM, WDQ + 2 * NGU};   pg8::StaticOrder S; S.init(M, NZX, G, bx, 8);
        pg8::EpiZX<2> E{ZB, XBC, UB, VB, OPB, GT};
        pg8::gemm_phase<pg8::EpiZX<2>, pg8::StaticOrder, true, true>(L + RING_OFF, g, S, E);
        if (PROBE_G) pg8::gemm_phase<pg8::EpiZX<2>, pg8::StaticOrder, true, true>(L + RING_OFF, g, S, E);
    }
    SEAM(9);
    if (IN(10)) {
        for (int u = bx; u < NBATCH * 20; u += G) { const int bb = u / 20, cg = u % 20;
            if (cg < 12) conv_unit<0>(XBC, 1536, cg * 128, args.in[11], 1536, args.in[12], bb, tid, nullptr, nullptr, nullptr);
            else conv_unit<1>(UB, 1024, (cg - 12) * 128, args.in[17], 1024, args.in[18], bb, tid, args.in[19], args.in[20], XN); }
    }
    SEAM(10);
    if (IN(11)) {
        static_assert(mam::LDS_NEED <= LDSCTL_OFF && mls::LDS_NEED <= LDSCTL_OFF, "mixer LDS");
        for (int u = vcu; u < NBATCH * 8; u += G) mls::unit(UB, XN, VB, (bf16*)((unsigned char*)args.out + DO_CS) + (size_t)u * 32768, GT, args.in[21], args.in[22], u >> 3, (u >> 1) & 3, u & 1, L, tid);
        int tid2 = tid, vcu2 = vcu; asm volatile("" : "+v"(tid2), "+s"(vcu2));
        for (int u = vcu2; u < NBATCH * 8; u += G) mam::unit(XBC, GT, args.in[13], args.in[14], args.in[15], u >> 3, (u >> 2) & 1, u & 3, L, tid2);
    }
    SEAM(11);
    if (IN(12)) for (int rep = 0; rep < 1; ++rep) { for (int m = gw; m < M; m += NGW) gate_row(XBC, 1536, ZB, VB, OPB, YCD, args.in[16], args.in[23], (size_t)m, lane); }
    SEAM(12);
    if (IN(13)) {
        pg8::Gemm g{YCD, W_CDOUT, M, D, KCD, nullptr, nullptr}; pg8::StaticOrder S; S.init(M, D, G, bx);
        pg8::EpiResidBf<false, false, false> E{nullptr, HB, D, nullptr, nullptr};
        pg8::gemm_phase<pg8::EpiResidBf<false, false, false>, pg8::StaticOrder, true, true>(L + RING_OFF, g, S, E);
    }
    SEAM(13);
    if (IN(14)) { for (int m = gw; m < M; m += NGW) rms_row_i8(HB + (size_t)m * D, args.in[2] + D, (unsigned char*)XN + (size_t)m * D, PSUM + (size_t)m * 4, lane); }
    SEAM(14);
    if (IN(15)) {
        pg8::Gemm g{XN, W_GU1, M, NGU, D / 2, PSUM, WDQ + NGU};   pg8::StaticOrder S; S.init(M, NGU, G, bx, 8);
        pg8::EpiSwiglu<false, 2> E{(unsigned char*)ACT, FF, 0.f};
        pg8::gemm_phase<pg8::EpiSwiglu<false, 2>, pg8::StaticOrder, true, true>(L + RING_OFF, g, S, E);
        if (PROBE_G) pg8::gemm_phase<pg8::EpiSwiglu<false, 2>, pg8::StaticOrder, true, true>(L + RING_OFF, g, S, E);
    }
    SEAM(15);
    if (IN(16)) {
        pg8::Gemm g{ACT, W_DN1, M, D, FF, nullptr, nullptr}; pg8::StaticOrder S; S.init(M, D, G, bx);
        pg8::EpiResidBf<false, false, false> E{nullptr, HB, D, nullptr, nullptr};
        pg8::gemm_phase<pg8::EpiResidBf<false, false, false>, pg8::StaticOrder, true, true>(L + RING_OFF, g, S, E);
    }
    SEAM(16);
    if (IN(17)) { int ln = threadIdx.x; asm volatile("" : "+v"(ln)); ln &= 63;
        for (int m = gw; m < M; m += NGW) final_row(HB + (size_t)m * D, args.in[27], out + (size_t)m * D, ln); }
#undef IN
#undef SEAM
#undef XIN
}

extern "C" void kernel_launch(void* const* d_in, const int* in_sizes, int n_in, void* d_out, int out_size, void* d_ws, size_t ws_size, hipStream_t stream) {
    static int grid = 0;
    if (grid == 0) {
        if (n_in != 28 || in_sizes[0] != M * D || out_size != M * D || ws_size < WS_END) { fprintf(stderr, "kernel_launch: unexpected shapes / workspace (%d inputs, ws %zu < %zu); nothing launched\n", n_in, ws_size, (size_t)WS_END); grid = -1; return; }
        int dev = 0, cus = 0;
        if (hipGetDevice(&dev) != hipSuccess || hipDeviceGetAttribute(&cus, hipDeviceAttributeMultiprocessorCount, dev) != hipSuccess) { grid = -1; return; }
        if (hipFuncSetAttribute((const void*)fwd_kernel, hipFuncAttributeMaxDynamicSharedMemorySize, LDS_BYTES) != hipSuccess) { grid = -1; return; }
        int per_cu = 0;
        if (hipOccupancyMaxActiveBlocksPerMultiprocessor(&per_cu, (const void*)fwd_kernel, NWAVES * 64, LDS_BYTES) != hipSuccess || per_cu < 1) fprintf(stderr, "kernel_launch: occupancy query reports %d\n", per_cu);
        (void)hipGetLastError();
        grid = cus;
    }
    if (grid < 0) return;
    if (hipMemsetAsync((char*)d_ws + WS_CTL, 0, CTL_ZERO_BYTES, stream) != hipSuccess) return;
    Args a{};
    for (int i = 0; i < 28; ++i) a.in[i] = (const float*)d_in[i];
    a.out = (float*)d_out; a.ws = (unsigned char*)d_ws;
#if MK_ONE_LAUNCH
    if (PROBE_HI > PROBE_LO) {
        a.ph_lo = 0; a.ph_hi = PROBE_HI; a.li = 0; hipLaunchKernelGGL(fwd_kernel, dim3(grid), dim3(NWAVES * 64), LDS_BYTES, stream, a);
        a.ph_lo = PROBE_LO; a.ph_hi = NPH; a.li = 1; hipLaunchKernelGGL(fwd_kernel, dim3(grid), dim3(NWAVES * 64), LDS_BYTES, stream, a);
        return;
    }
    a.ph_lo = 0; a.ph_hi = NPH;
    hipLaunchKernelGGL(fwd_kernel, dim3(grid), dim3(NWAVES * 64), LDS_BYTES, stream, a);
#else
    for (int p = 0; p < NPH; ++p) { a.ph_lo = p; a.ph_hi = p + 1; hipLaunchKernelGGL(fwd_kernel, dim3(grid), dim3(NWAVES * 64), LDS_BYTES, stream, a); }
#endif
}
```

```cpp
#include <hip/hip_runtime.h>
#include <cstdio>
#include <cstdint>
#ifndef MK_ONE_LAUNCH
#define MK_ONE_LAUNCH 1
#endif
#define PROBE_G 0
#define PROBE_T 0
#define PROBE_LO 0
#define PROBE_HI 0
namespace pg8 {
#define PG8_LAS __attribute__((address_space(3)))
typedef unsigned short bf16_t;
typedef short bf16x8 __attribute__((ext_vector_type(8)));
typedef float f32x4 __attribute__((ext_vector_type(4)));
typedef unsigned u32x4 __attribute__((ext_vector_type(4)));
constexpr int BM = 256, BK = 64, HALF = 128, HTB = HALF * BK * 2  , STAGE_BYTES = 8 * HTB, NXCD = 8, WGM = 4;

__host__ __device__ __forceinline__ int lds_byte(int r, int c) { const int st = (r >> 4) * 2 + (c >> 5), rr = r & 15, cc = c & 31, ob = rr * 64 + cc * 2; return st * 1024 + (ob ^ (((ob >> 9) & 1) << 5)); }
__host__ __device__ __forceinline__ void stage_rc(int b, int& R, int& C) { const int st = b / 1024, sb = b % 1024, swz = sb ^ (((sb >> 9) & 1) << 5); R = (st >> 1) * 16 + swz / 64; C = (st & 1) * 32 + (swz % 64) / 2; }
__host__ __device__ __forceinline__ int perm32(int rho) { const int n = rho >> 4, i = rho & 15; return 8 * (i >> 2) + 4 * n + (i & 3); }

struct Unit { int pm, pn; };
struct Gemm { const bf16_t* A; const bf16_t* Bt; int M, N, K; const float* ps; const float* wq; };

struct StaticOrder {
    int nM, nN, nwg, G, c;
    __host__ __device__ void init(int M, int N, int G_, int c_) { nM = M / BM; nN = N / BM; nwg = nM * nN; G = G_; c = c_; }
    __host__ __device__ bool next(int i, Unit& u) const {
        const long L = (long)i * G + c; if (L >= nwg) return false;
        int wgid = (int)L; { const int q = nwg / NXCD, r = nwg % NXCD, xcd = wgid % NXCD, off = wgid / NXCD; wgid = (xcd < r ? xcd * (q + 1) : r * (q + 1) + (xcd - r) * q) + off; }
        const int nig = WGM * nN, gid = wgid / nig, fm = gid * WGM, gsz = (nM - fm) < WGM ? (nM - fm) : WGM;
        u.pm = fm + ((wgid % nig) % gsz); u.pn = (wgid % nig) / gsz; return true;
    }
    __device__ __forceinline__ void a_ready(const Unit&) const {}
    __device__ __forceinline__ void done(const Unit&) const {}
};

__device__ __forceinline__ unsigned cvt_pk_bf16(float lo, float hi) { unsigned r; asm volatile("v_cvt_pk_bf16_f32 %0, %1, %2" : "=v"(r) : "v"(lo), "v"(hi)); return r; }
typedef float f32x2 __attribute__((ext_vector_type(2)));
typedef int i32x4 __attribute__((ext_vector_type(4)));
typedef int i32x8 __attribute__((ext_vector_type(8)));
__device__ __forceinline__ i32x8 cat8(bf16x8 a, bf16x8 b) { const i32x4 x = __builtin_bit_cast(i32x4, a), y = __builtin_bit_cast(i32x4, b); return __builtin_shufflevector(x, y, 0, 1, 2, 3, 4, 5, 6, 7); }
__device__ __forceinline__ float clamp8(float v) { return __builtin_fminf(__builtin_fmaxf(v, -448.f), 448.f); }
__device__ __forceinline__ unsigned pk4_fp8(float a, float b, float c, float d) { int w = 0; w = __builtin_amdgcn_cvt_pk_fp8_f32(clamp8(a), clamp8(b), w, false); w = __builtin_amdgcn_cvt_pk_fp8_f32(clamp8(c), clamp8(d), w, true); return (unsigned)w; }
constexpr float ACT8_SC = 8.f, W8_SC = 64.f;
__device__ __forceinline__ float silu_f(float x) { return x * __builtin_amdgcn_rcpf(1.f + __expf(-x)); }
__device__ __forceinline__ float row_rstd(const PG8_LAS f32x4* rst, int rl) { const f32x4 p = rst[rl]; return 1.f / sqrtf(((p[0] + p[1]) + (p[2] + p[3])) * (1.f / 1024.f) + 1e-6f); }
struct EpiQKV {
    static constexpr bool PERM = true, AFTER_DRAIN = false, RSTD = false, FP8 = false, I8 = false;
    bf16_t* O; int ldc; int sa_lo, sa_hi, sc_lo, sc_hi; float scale;
    __device__ __forceinline__ void operator()(const f32x4 (&acc)[2][2][4][2], const Unit& u, int wr, int wc, int fr, int fq) const {
        const int row0 = u.pm * BM + wr * 64 + fr, col0 = u.pn * BM + wc * 32 + 8 * fq;
        const float sc = ((u.pn >= sc_lo && u.pn < sc_hi) || (u.pn >= sa_lo && u.pn < sa_hi)) ? scale : 1.f;
#pragma unroll
        for (int ai = 0; ai < 2; ++ai)
#pragma unroll
            for (int m = 0; m < 4; ++m) { bf16_t* rowp = O + (size_t)(row0 + ai * HALF + m * 16) * ldc + col0;
#pragma unroll
                for (int bj = 0; bj < 2; ++bj) { const f32x4 v0 = acc[ai][bj][m][0] * sc, v1 = acc[ai][bj][m][1] * sc;
                    u32x4 w; w.x = cvt_pk_bf16(v0[0], v0[1]); w.y = cvt_pk_bf16(v0[2], v0[3]); w.z = cvt_pk_bf16(v1[0], v1[1]); w.w = cvt_pk_bf16(v1[2], v1[3]);
                    *(u32x4*)(rowp + bj * HALF) = w; } }
    }
};
template <int MODE> struct EpiZX {
    static constexpr bool PERM = true, AFTER_DRAIN = false, RSTD = true, FP8 = false, I8 = (MODE == 2);
    bf16_t *Z, *XBC, *U, *V, *O; float* G;
    static __device__ __forceinline__ f32x4 accf(const f32x4& a) { if constexpr (MODE == 2) return __builtin_convertvector(__builtin_bit_cast(i32x4, a), f32x4); else return a; }
    __device__ __forceinline__ void operator()(const f32x4 (&acc)[2][2][4][2], const Unit& u, int wr, int wc, int fr, int fq, const PG8_LAS f32x4* rst, const PG8_LAS f32x4* wqt) const {
        const int row0 = u.pm * BM + wr * 64 + fr; const int pn = u.pn;
        f32x4 wq[2][2];
#pragma unroll
        for (int bj = 0; bj < 2; ++bj)
#pragma unroll
            for (int n = 0; n < 2; ++n) { if constexpr (MODE == 2) wq[bj][n] = wqt[32 * bj + 8 * wc + 2 * fq + n]; else wq[bj][n] = (f32x4){1.f, 1.f, 1.f, 1.f}; }

        if (pn == 22) {
            if (wc == 0) {
#pragma unroll
                for (int ai = 0; ai < 2; ++ai)
#pragma unroll
                    for (int m = 0; m < 4; ++m) { float* gp = G + (size_t)(row0 + ai * HALF + m * 16) * 32 + 8 * fq; const int rl = ai * HALF + wr * 64 + m * 16 + fr; const float rs = (MODE == 2) ? rst[rl][0] : row_rstd(rst, rl);
                        *(f32x4*)gp = accf(acc[ai][0][m][0]) * (wq[0][0] * rs); *(f32x4*)(gp + 4) = accf(acc[ai][0][m][1]) * (wq[0][1] * rs); }
            }
            return;
        }
        bf16_t* base; int ldc, colt;
        if (pn < 4) { base = Z; ldc = 1024; colt = pn * 256; }
        else if (pn < 10) { base = XBC; ldc = 1536; colt = (pn - 4) * 256; }
        else if (pn < 14) { base = U; ldc = 1024; colt = (pn - 10) * 256; }
        else if (pn < 18) { base = V; ldc = 1024; colt = (pn - 14) * 256; }
        else { base = O; ldc = 1024; colt = (pn - 18) * 256; }
        const int col0 = colt + wc * 32 + 8 * fq;
#pragma unroll
        for (int ai = 0; ai < 2; ++ai)
#pragma unroll
            for (int m = 0; m < 4; ++m) { bf16_t* rowp = base + (size_t)(row0 + ai * HALF + m * 16) * ldc + col0; const int rl = ai * HALF + wr * 64 + m * 16 + fr; const float rs = (MODE == 2) ? rst[rl][0] : row_rstd(rst, rl);
#pragma unroll
                for (int bj = 0; bj < 2; ++bj) { const f32x4 v0 = accf(acc[ai][bj][m][0]) * (wq[bj][0] * rs), v1 = accf(acc[ai][bj][m][1]) * (wq[bj][1] * rs);
                    u32x4 w; w.x = cvt_pk_bf16(v0[0], v0[1]); w.y = cvt_pk_bf16(v0[2], v0[3]); w.z = cvt_pk_bf16(v1[0], v1[1]); w.w = cvt_pk_bf16(v1[2], v1[3]);
                    *(u32x4*)(rowp + bj * HALF) = w; } }
    }
};
template <bool O8, int MODE> struct EpiSwiglu {
    static constexpr bool PERM = true, AFTER_DRAIN = false, RSTD = true, FP8 = false, I8 = (MODE == 2);
    unsigned char* O; int ldc; float wdq;
    __device__ __forceinline__ void operator()(const f32x4 (&acc)[2][2][4][2], const Unit& u, int wr, int wc, int fr, int fq, const PG8_LAS f32x4* rst, const PG8_LAS f32x4* wqt) const {
        const int row0 = u.pm * BM + wr * 64 + fr, col0 = u.pn * HALF + wc * 32 + 8 * fq;
        f32x4 wg0, wg1, wu0, wu1;
        if constexpr (MODE == 2) { const int q = 8 * wc + 2 * fq; wg0 = wqt[q]; wg1 = wqt[q + 1]; wu0 = wqt[32 + q]; wu1 = wqt[32 + q + 1]; }
#pragma unroll
        for (int ai = 0; ai < 2; ++ai)
#pragma unroll
            for (int m = 0; m < 4; ++m) {
                const int rl = ai * HALF + wr * 64 + m * 16 + fr;
                f32x4 g0, g1, u0, u1;
                if constexpr (MODE == 2) { const float rs = rst[rl][0];
                    g0 = __builtin_convertvector(__builtin_bit_cast(i32x4, acc[ai][0][m][0]), f32x4) * (wg0 * rs); g1 = __builtin_convertvector(__builtin_bit_cast(i32x4, acc[ai][0][m][1]), f32x4) * (wg1 * rs);
                    u0 = __builtin_convertvector(__builtin_bit_cast(i32x4, acc[ai][1][m][0]), f32x4) * (wu0 * rs); u1 = __builtin_convertvector(__builtin_bit_cast(i32x4, acc[ai][1][m][1]), f32x4) * (wu1 * rs); }
                else { const float rs = row_rstd(rst, rl); g0 = acc[ai][0][m][0] * rs; g1 = acc[ai][0][m][1] * rs; u0 = acc[ai][1][m][0] * rs; u1 = acc[ai][1][m][1] * rs; }
                float r[8];
#pragma unroll
                for (int j = 0; j < 4; ++j) { r[j] = silu_f(g0[j]) * u0[j]; r[4 + j] = silu_f(g1[j]) * u1[j]; }
                if constexpr (O8) { typedef unsigned u32x2 __attribute__((ext_vector_type(2)));
                    u32x2 w; w.x = pk4_fp8(r[0] * ACT8_SC, r[1] * ACT8_SC, r[2] * ACT8_SC, r[3] * ACT8_SC); w.y = pk4_fp8(r[4] * ACT8_SC, r[5] * ACT8_SC, r[6] * ACT8_SC, r[7] * ACT8_SC);
                    *(u32x2*)(O + (size_t)(row0 + ai * HALF + m * 16) * ldc + col0) = w; }
                else { u32x4 w; w.x = cvt_pk_bf16(r[0], r[1]); w.y = cvt_pk_bf16(r[2], r[3]); w.z = cvt_pk_bf16(r[4], r[5]); w.w = cvt_pk_bf16(r[6], r[7]);
                    *(u32x4*)((bf16_t*)O + (size_t)(row0 + ai * HALF + m * 16) * ldc + col0) = w; } }
    }
};
template <bool SRC_F32, bool PART, bool F8, bool Q8 = false> struct EpiResidBf {
    static constexpr bool PERM = true, AFTER_DRAIN = false, RSTD = Q8, FP8 = F8, I8 = Q8;
    const float* srcf; bf16_t* H; int ldc; float* ps; PG8_LAS float* red;
    __device__ __forceinline__ void operator()(const f32x4 (&acc)[2][2][4][2], const Unit& u, int wr, int wc, int fr, int fq, const PG8_LAS f32x4* rst = nullptr, const PG8_LAS f32x4* wqt = nullptr) const {
        const int row0 = u.pm * BM + wr * 64 + fr, col0 = u.pn * BM + wc * 32 + 8 * fq;
        f32x4 wq[2][2];
        if constexpr (Q8) {
#pragma unroll
            for (int bj = 0; bj < 2; ++bj)
#pragma unroll
                for (int n = 0; n < 2; ++n) wq[bj][n] = wqt[32 * bj + 8 * wc + 2 * fq + n]; }
#pragma unroll
        for (int ai = 0; ai < 2; ++ai)
#pragma unroll
            for (int m = 0; m < 4; ++m) { const size_t off = (size_t)(row0 + ai * HALF + m * 16) * ldc + col0; float ss = 0.f;
#pragma unroll
                for (int bj = 0; bj < 2; ++bj) { f32x4 s0, s1;
                    if (SRC_F32) { s0 = *(const f32x4*)(srcf + off + bj * HALF); s1 = *(const f32x4*)(srcf + off + bj * HALF + 4); }
                    else { const u32x4 hv = *(const u32x4*)(H + off + bj * HALF);
                        s0 = (f32x4){__uint_as_float(hv.x << 16), __uint_as_float(hv.x & 0xffff0000u), __uint_as_float(hv.y << 16), __uint_as_float(hv.y & 0xffff0000u)};
                        s1 = (f32x4){__uint_as_float(hv.z << 16), __uint_as_float(hv.z & 0xffff0000u), __uint_as_float(hv.w << 16), __uint_as_float(hv.w & 0xffff0000u)}; }
                    constexpr float dsc = F8 ? 1.f / (ACT8_SC * W8_SC) : 1.f;
                    f32x4 v0, v1;
                    if constexpr (Q8) { const float rs = rst[ai * HALF + wr * 64 + m * 16 + fr][0];
                        v0 = s0 + __builtin_convertvector(__builtin_bit_cast(i32x4, acc[ai][bj][m][0]), f32x4) * (wq[bj][0] * rs); v1 = s1 + __builtin_convertvector(__builtin_bit_cast(i32x4, acc[ai][bj][m][1]), f32x4) * (wq[bj][1] * rs); }
                    else { v0 = s0 + acc[ai][bj][m][0] * dsc; v1 = s1 + acc[ai][bj][m][1] * dsc; }
                    if (PART) ss += ((v0[0] * v0[0] + v0[1] * v0[1]) + (v0[2] * v0[2] + v0[3] * v0[3])) + ((v1[0] * v1[0] + v1[1] * v1[1]) + (v1[2] * v1[2] + v1[3] * v1[3]));
                    u32x4 w; w.x = cvt_pk_bf16(v0[0], v0[1]); w.y = cvt_pk_bf16(v0[2], v0[3]); w.z = cvt_pk_bf16(v1[0], v1[1]); w.w = cvt_pk_bf16(v1[2], v1[3]);
                    *(u32x4*)(H + off + bj * HALF) = w; }
                if constexpr (PART) { ss += __shfl_xor(ss, 16); ss += __shfl_xor(ss, 32); if (fq == 0) red[(ai * HALF + wr * 64 + m * 16 + fr) * 4 + wc] = ss; } }
        if constexpr (PART) {
            asm volatile("s_waitcnt lgkmcnt(0)" ::: "memory"); __builtin_amdgcn_s_barrier(); asm volatile("" ::: "memory");
            const int t = threadIdx.x;
            if (t < 256) { const f32x4 r = *(const PG8_LAS f32x4*)(red + t * 4); ps[((size_t)u.pm * BM + t) * 4 + u.pn] = (r[0] + r[1]) + (r[2] + r[3]); }
        }
    }
};

template <class Epi, class Sched, bool ALIGN_EPI = false, bool SP2 = false>
__device__ __forceinline__ void gemm_phase(PG8_LAS unsigned char* lds, const Gemm g, const Sched& S, const Epi& E) {
    const int tid = threadIdx.x, wid = __builtin_amdgcn_readfirstlane(tid >> 6), lane = tid & 63, wr = wid >> 2, wc = wid & 3, fr = lane & 15, fq = lane >> 4;
    const int K = g.K, nt = K / BK;
    unsigned voffA[2], voffB[2];
#pragma unroll
    for (int i = 0; i < 2; ++i) { int R, C; stage_rc(tid * 16 + i * 8192, R, C); const int Rb = Epi::PERM ? ((R & ~31) + perm32(R & 31)) : R;
        voffA[i] = (unsigned)(R * K + C) * 2u; voffB[i] = (unsigned)(Rb * K + C) * 2u; }
    int one8 = 0x7f7f7f7f; asm volatile("" : "+v"(one8));
    const size_t kstep = (size_t)(BK * 2);
    const size_t hstep = (size_t)HALF * K * 2;
    const size_t tstep = 2 * hstep;
    const unsigned ldsw = (unsigned)wid * 1024u;
    const int aoff = lds_byte(wr * 64 + fr, fq * 8), boff = lds_byte(wc * 32 + fr, fq * 8);
#define PG8_SA(b, h) (((b) * 2 + (h)) * HTB)
#define PG8_SB(b, h) ((4 + (b) * 2 + (h)) * HTB)
#define PG8_STAGE(bufoff, gbase, voff) do { _Pragma("unroll") for (int _i = 0; _i < 2; ++_i) \
        __builtin_amdgcn_global_load_lds((const unsigned*)((const char*)(gbase) + (voff)[_i]), (PG8_LAS unsigned*)(lds + (bufoff) + ldsw + _i * 8192), 16, 0, 0); } while (0)
#define PG8_LDA(dst, b, h) do { _Pragma("unroll") for (int m = 0; m < 4; ++m) _Pragma("unroll") for (int k = 0; k < 2; ++k) dst[m][k] = *(const PG8_LAS bf16x8*)(lds + PG8_SA(b, h) + aoff + m * 2048 + k * 1024); } while (0)
#define PG8_LDB(dst, b, h) do { _Pragma("unroll") for (int n = 0; n < 2; ++n) _Pragma("unroll") for (int k = 0; k < 2; ++k) dst[n][k] = *(const PG8_LAS bf16x8*)(lds + PG8_SB(b, h) + boff + n * 2048 + k * 1024); } while (0)
#define PG8_MMA(ai, bj, At, Bt) do { __builtin_amdgcn_s_setprio(1); \
        if constexpr (Epi::FP8) { _Pragma("unroll") for (int m = 0; m < 4; ++m) _Pragma("unroll") for (int n = 0; n < 2; ++n) \
            { const i32x8 b8 = cat8(Bt[n][0], Bt[n][1]), a8 = cat8(At[m][0], At[m][1]);     \
              asm volatile("v_mfma_scale_f32_16x16x128_f8f6f4 %0, %1, %2, %0, %3, %3 op_sel_hi:[0,0,0]" : "+v"(acc[ai][bj][m][n]) : "v"(b8), "v"(a8), "v"(one8)); } } \
        else if constexpr (Epi::I8) { _Pragma("unroll") for (int m = 0; m < 4; ++m) _Pragma("unroll") for (int n = 0; n < 2; ++n) _Pragma("unroll") for (int k = 0; k < 2; ++k)     \
            acc[ai][bj][m][n] = __builtin_bit_cast(f32x4, __builtin_amdgcn_mfma_i32_16x16x64_i8(__builtin_bit_cast(i32x4, Bt[n][k]), __builtin_bit_cast(i32x4, At[m][k]), __builtin_bit_cast(i32x4, acc[ai][bj][m][n]), 0, 0, 0)); } \
        else { _Pragma("unroll") for (int m = 0; m < 4; ++m) _Pragma("unroll") for (int n = 0; n < 2; ++n) _Pragma("unroll") for (int k = 0; k < 2; ++k) \
            acc[ai][bj][m][n] = __builtin_amdgcn_mfma_f32_16x16x32_bf16(Bt[n][k], At[m][k], acc[ai][bj][m][n], 0, 0, 0); } \
        __builtin_amdgcn_s_setprio(0); } while (0)
#define PG8_WAIT_V(n) asm volatile("s_waitcnt vmcnt(" #n ")" ::: "memory")
#define PG8_WAIT_L(n) asm volatile("s_waitcnt lgkmcnt(" #n ")" ::: "memory")
#define PG8_BAR __builtin_amdgcn_s_barrier()
#define PG8_SCHED __builtin_amdgcn_sched_barrier(0)
    Unit cur, nxt; int ui = 0;
    if (!S.next(0, cur)) return;
    f32x4 acc[2][2][4][2];
#pragma unroll
    for (int a = 0; a < 2; ++a)
#pragma unroll
        for (int b = 0; b < 2; ++b)
#pragma unroll
            for (int m = 0; m < 4; ++m)
#pragma unroll
                for (int n = 0; n < 2; ++n) acc[a][b][m][n] = (f32x4){0.f, 0.f, 0.f, 0.f};
    bf16x8 At[4][2], B0[2][2], B1[2][2];
    const char* cA = (const char*)g.A + (size_t)cur.pm * tstep; const char* cB = (const char*)g.Bt + (size_t)cur.pn * tstep;
    S.a_ready(cur);
    if constexpr (SP2) {
        PG8_STAGE(PG8_SB(0, 0), cB, voffB); PG8_STAGE(PG8_SB(0, 1), cB + hstep, voffB); PG8_STAGE(PG8_SA(0, 0), cA, voffA); PG8_STAGE(PG8_SA(0, 1), cA + hstep, voffA);
        if (wr == 1) PG8_BAR;
        PG8_WAIT_V(2); PG8_BAR;
        PG8_STAGE(PG8_SB(1, 0), cB + kstep, voffB); PG8_STAGE(PG8_SA(1, 0), cA + kstep, voffA); PG8_STAGE(PG8_SB(1, 1), cB + hstep + kstep, voffB);
        PG8_WAIT_V(6); PG8_BAR;
    } else {
        PG8_STAGE(PG8_SB(0, 0), cB, voffB); PG8_STAGE(PG8_SA(0, 0), cA, voffA); PG8_STAGE(PG8_SB(0, 1), cB + hstep, voffB); PG8_STAGE(PG8_SA(0, 1), cA + hstep, voffA);
        if (wr == 1) PG8_BAR;
        PG8_WAIT_V(4); PG8_BAR;
        PG8_STAGE(PG8_SB(1, 0), cB + kstep, voffB); PG8_STAGE(PG8_SA(1, 0), cA + kstep, voffA); PG8_STAGE(PG8_SB(1, 1), cB + hstep + kstep, voffB);
        PG8_WAIT_V(6); PG8_BAR;
    }
    for (;;) {
        const bool has_next = S.next(ui + 1, nxt);
        const char* nA = has_next ? (const char*)g.A + (size_t)nxt.pm * tstep : cA; const char* nB = has_next ? (const char*)g.Bt + (size_t)nxt.pn * tstep : cB;
        if constexpr (Epi::RSTD) { if (wid < 4)
            __builtin_amdgcn_global_load_lds((const unsigned*)(g.ps + ((size_t)cur.pm * BM + wid * 64 + lane) * 4), (PG8_LAS unsigned*)(lds + STAGE_BYTES + (ui & 1) * 4096 + wid * 1024), 16, 0, 0); }
        if constexpr (Epi::I8) { if (wid == 4)
            __builtin_amdgcn_global_load_lds((const unsigned*)(g.wq + (size_t)cur.pn * BM + lane * 4), (PG8_LAS unsigned*)(lds + STAGE_BYTES + 12288 + (ui & 1) * 1024), 16, 0, 0); }
        for (int t = 0; t < nt; t += 2) {
            const bool last = (t == nt - 2);
            const char* a1 = cA + (size_t)(t + 1) * kstep;
            const char* a2 = last ? nA : cA + (size_t)(t + 2) * kstep; const char* b2 = last ? nB : cB + (size_t)(t + 2) * kstep;
            const char* a3 = a2 + kstep; const char* b3 = b2 + kstep;
            if (last && has_next) S.a_ready(nxt);
            if constexpr (SP2) {
            PG8_LDB(B0, 0, 0); PG8_LDB(B1, 0, 1); PG8_SCHED; PG8_LDA(At, 0, 0); PG8_STAGE(PG8_SA(1, 1), a1 + hstep, voffA);
            PG8_WAIT_V(8); PG8_WAIT_L(0); PG8_BAR; PG8_MMA(0, 0, At, B0); PG8_MMA(0, 1, At, B1); PG8_BAR; PG8_SCHED;
            PG8_LDA(At, 0, 1); PG8_STAGE(PG8_SB(0, 0), b2, voffB); PG8_STAGE(PG8_SB(0, 1), b2 + hstep, voffB); PG8_STAGE(PG8_SA(0, 0), a2, voffA);
            PG8_WAIT_V(8); PG8_WAIT_L(0); PG8_BAR; PG8_MMA(1, 0, At, B0); PG8_MMA(1, 1, At, B1); PG8_BAR; PG8_SCHED;
            PG8_LDB(B0, 1, 0); PG8_LDB(B1, 1, 1); PG8_SCHED; PG8_LDA(At, 1, 0); PG8_STAGE(PG8_SA(0, 1), a2 + hstep, voffA);
            PG8_WAIT_V(8); PG8_WAIT_L(0); PG8_BAR; PG8_MMA(0, 0, At, B0); PG8_MMA(0, 1, At, B1); PG8_BAR; PG8_SCHED;
            PG8_LDA(At, 1, 1); PG8_STAGE(PG8_SB(1, 0), b3, voffB); PG8_STAGE(PG8_SB(1, 1), b3 + hstep, voffB); PG8_STAGE(PG8_SA(1, 0), a3, voffA);
            PG8_WAIT_V(8); PG8_WAIT_L(0); PG8_BAR; PG8_MMA(1, 0, At, B0); PG8_MMA(1, 1, At, B1); PG8_BAR; PG8_SCHED;
            } else {
            PG8_LDB(B0, 0, 0); PG8_SCHED; PG8_LDA(At, 0, 0); PG8_STAGE(PG8_SA(1, 1), a1 + hstep, voffA);
            PG8_WAIT_L(8); PG8_BAR; PG8_WAIT_L(0); PG8_MMA(0, 0, At, B0); PG8_BAR; PG8_SCHED;
            PG8_LDB(B1, 0, 1); PG8_STAGE(PG8_SB(0, 0), b2, voffB);
            PG8_BAR; PG8_WAIT_L(0); PG8_MMA(0, 1, At, B1); PG8_BAR;
            PG8_LDA(At, 0, 1); PG8_STAGE(PG8_SA(0, 0), a2, voffA);
            PG8_BAR; PG8_WAIT_L(0); PG8_MMA(1, 0, At, B0); PG8_BAR; PG8_SCHED;
            PG8_STAGE(PG8_SB(0, 1), b2 + hstep, voffB);
            PG8_WAIT_V(6); PG8_BAR; PG8_MMA(1, 1, At, B1); PG8_BAR;
            PG8_LDB(B0, 1, 0); PG8_SCHED; PG8_LDA(At, 1, 0); PG8_STAGE(PG8_SA(0, 1), a2 + hstep, voffA);
            PG8_WAIT_L(8); PG8_BAR; PG8_WAIT_L(0); PG8_MMA(0, 0, At, B0); PG8_BAR; PG8_SCHED;
            PG8_LDB(B1, 1, 1); PG8_STAGE(PG8_SB(1, 0), b3, voffB);
            PG8_BAR; PG8_WAIT_L(0); PG8_MMA(0, 1, At, B1); PG8_BAR;
            PG8_LDA(At, 1, 1); PG8_STAGE(PG8_SA(1, 0), a3, voffA);
            PG8_BAR; PG8_WAIT_L(0); PG8_MMA(1, 0, At, B0); PG8_BAR; PG8_SCHED;
            PG8_STAGE(PG8_SB(1, 1), b3 + hstep, voffB);
            PG8_WAIT_V(6); PG8_BAR; PG8_MMA(1, 1, At, B1); PG8_BAR;
            }
        }
        if constexpr (ALIGN_EPI) { if (wr == 0) PG8_BAR; }
        if constexpr (!Epi::AFTER_DRAIN) { if constexpr (Epi::RSTD) E(acc, cur, wr, wc, fr, fq, (const PG8_LAS f32x4*)(lds + STAGE_BYTES + (ui & 1) * 4096), (const PG8_LAS f32x4*)(lds + STAGE_BYTES + 12288 + (ui & 1) * 1024)); else E(acc, cur, wr, wc, fr, fq); S.done(cur); }
        if (!has_next) break;
#pragma unroll
        for (int a = 0; a < 2; ++a)
#pragma unroll
            for (int b = 0; b < 2; ++b)
#pragma unroll
                for (int m = 0; m < 4; ++m)
#pragma unroll
                    for (int n = 0; n < 2; ++n) acc[a][b][m][n] = (f32x4){0.f, 0.f, 0.f, 0.f};
        cur = nxt; cA = nA; cB = nB; ++ui;
        if constexpr (ALIGN_EPI) { if (wr == 1) PG8_BAR; }
    }
    PG8_WAIT_V(0);
    if constexpr (!ALIGN_EPI) { if (wr == 0) PG8_BAR; }
    PG8_BAR;
    if constexpr (Epi::AFTER_DRAIN) { E.fused(acc, cur, wr, wc, fr, fq, lds, wid, lane); S.done(cur); }
#undef PG8_SA
#undef PG8_SB
#undef PG8_STAGE
#undef PG8_LDA
#undef PG8_LDB
#undef PG8_MMA
#undef PG8_WAIT_V
#undef PG8_WAIT_L
#undef PG8_BAR
#undef PG8_SCHED
}
}
#include <hip/hip_bf16.h>
#include <cmath>
namespace attn_body {
using bf16=__hip_bfloat16;
using bf16x8=__attribute__((ext_vector_type(8)))short;
using s16x4=__attribute__((ext_vector_type(4)))short;
using f32x16=__attribute__((ext_vector_type(16)))float;
using u32x4=__attribute__((ext_vector_type(4)))unsigned;
constexpr int BATCH=32,NHEAD=16,SEQ=2048,D=64,DM=3072,DMO=1024;
constexpr int NW=8,QBLK=32,QB=QBLK*NW,KVBLK=64,NQB=SEQ/QB;
constexpr int ATTN_PITCH=DM, ATTN_UNIT_ROWS=QB;
__device__ __forceinline__ int crow(int r,int hi){return (r&3)+8*(r>>2)+4*hi;}
#define SBAR() __builtin_amdgcn_sched_barrier(0)
__device__ __forceinline__ void cmask(f32x16&p0,f32x16&p1,int jb,int qrel,int hi){
  const float NEG=-INFINITY; int kb=64*jb+4*hi;
  #pragma unroll
  for(int r=0;r<16;++r){int kv=kb+(r&3)+8*(r>>2); if(kv>qrel)p0[r]=NEG; if(kv+32>qrel)p1[r]=NEG;}
}

constexpr int NSLOT=3, SLOTB=8192;
constexpr int LDS_K=0, LDS_V=NSLOT*SLOTB, LDS_WS=2*NSLOT*SLOTB, LDS_OST=LDS_WS+NW*64*4, LDS_BYTES=LDS_OST+NW*4096;
constexpr float C2=0.125f*1.4426950408889634f;
__device__ __forceinline__ void glds16(const void*gsrc,unsigned lds_dst){unsigned keep;
  asm volatile("s_mov_b32 %0, m0\n\ts_mov_b32 m0, %2\n\ts_nop 0\n\tglobal_load_lds_dwordx4 %1, off\n\ts_mov_b32 m0, %0":"=&s"(keep):"v"(gsrc),"s"(lds_dst):"memory");}
__device__ __forceinline__ float max3f(float a,float b,float c){float r;asm("v_max3_f32 %0, %1, %2, %3":"=v"(r):"v"(a),"v"(b),"v"(c));return r;}
__device__ __forceinline__ float max2f(float a,float b){float r;asm("v_max_f32_e32 %0, %1, %2":"=v"(r):"v"(a),"v"(b));return r;}
__device__ __forceinline__ float fadd_s(float a,float b){float r;asm("v_add_f32_e32 %0, %1, %2":"=v"(r):"v"(a),"v"(b));return r;}
__device__ __forceinline__ float fsub_s(float a,float b){float r;asm("v_sub_f32_e32 %0, %1, %2":"=v"(r):"v"(a),"v"(b));return r;}
typedef float f32x2_t __attribute__((ext_vector_type(2))); typedef __bf16 bf16x2_t __attribute__((ext_vector_type(2)));
__device__ __forceinline__ unsigned cvtpk_s(float lo,float hi){f32x2_t v={lo,hi};bf16x2_t b=__builtin_convertvector(v,bf16x2_t);return __builtin_bit_cast(unsigned,b);}
#define WAIT_BAR(N) asm volatile("s_waitcnt vmcnt(" #N ") lgkmcnt(0)\n\ts_barrier":::"memory")

__device__ __forceinline__ void qkt(f32x16&p0,f32x16&p1,const char*Kslot,const bf16x8*qr,const f32x16&negm,int r32,int hi){
  const char*kb=Kslot+hi*1024+r32*16;
  #pragma unroll
  for(int d0=0;d0<4;++d0){
    const bf16x8 b0=*reinterpret_cast<const bf16x8*>(kb+d0*2048);
    const bf16x8 b1=*reinterpret_cast<const bf16x8*>(kb+d0*2048+512);
    if(d0==0){p0=__builtin_amdgcn_mfma_f32_32x32x16_bf16(b0,qr[0],negm,0,0,0);p1=__builtin_amdgcn_mfma_f32_32x32x16_bf16(b1,qr[0],negm,0,0,0);}
    else{p0=__builtin_amdgcn_mfma_f32_32x32x16_bf16(b0,qr[d0],p0,0,0,0);p1=__builtin_amdgcn_mfma_f32_32x32x16_bf16(b1,qr[d0],p1,0,0,0);}}
}
typedef __attribute__((address_space(3))) const char* lds_cptr;
typedef short v4i16_t __attribute__((ext_vector_type(4)));
__device__ __forceinline__ void kload8(bf16x8*kf,lds_cptr kp){
  kf[0]=*(const __attribute__((address_space(3))) bf16x8*)(kp);      kf[1]=*(const __attribute__((address_space(3))) bf16x8*)(kp+512);
  kf[2]=*(const __attribute__((address_space(3))) bf16x8*)(kp+2048); kf[3]=*(const __attribute__((address_space(3))) bf16x8*)(kp+2560);
  kf[4]=*(const __attribute__((address_space(3))) bf16x8*)(kp+4096); kf[5]=*(const __attribute__((address_space(3))) bf16x8*)(kp+4608);
  kf[6]=*(const __attribute__((address_space(3))) bf16x8*)(kp+6144); kf[7]=*(const __attribute__((address_space(3))) bf16x8*)(kp+6656);
}
__device__ __forceinline__ void kload2(bf16x8*kf,lds_cptr kp,int j){ kf[2*j]=*(const __attribute__((address_space(3))) bf16x8*)(kp+j*2048); kf[2*j+1]=*(const __attribute__((address_space(3))) bf16x8*)(kp+j*2048+512); }
__device__ __forceinline__ s16x4 vtr(lds_cptr p){ return __builtin_bit_cast(s16x4,__builtin_amdgcn_ds_read_tr16_b64_v4i16((__attribute__((address_space(3))) v4i16_t*)p)); }
__device__ __forceinline__ float rowmax(const f32x16&p0,const f32x16&p1){
  float a=max3f(p0[0],p0[1],p1[0]),b=max3f(p0[2],p0[3],p1[1]);a=max3f(a,p1[2],p1[3]);
  #pragma unroll
  for(int r=4;r<16;r+=4){a=max3f(a,p0[r],p0[r+1]);b=max3f(b,p0[r+2],p0[r+3]);a=max3f(a,p1[r],p1[r+1]);b=max3f(b,p1[r+2],p1[r+3]);}
  const float m=max2f(a,b);
  auto rr=__builtin_amdgcn_permlane32_swap(__float_as_uint(m),__float_as_uint(m),false,false);
  return max2f(__uint_as_float(rr[0]),__uint_as_float(rr[1]));
}
__device__ __forceinline__ void pv(f32x16*o,int vb,bf16x8 pa0,bf16x8 pa1,bf16x8 pa2,bf16x8 pa3){
  #pragma unroll
  for(int d0=0;d0<2;++d0){s16x4 lo[4],hi[4];
    #pragma unroll
    for(int ks=0;ks<4;++ks){
      asm volatile("ds_read_b64_tr_b16 %0,%1 offset:%c2":"=&v"(lo[ks]):"v"(vb),"i"(d0*4096+ks*1024):"memory");
      asm volatile("ds_read_b64_tr_b16 %0,%1 offset:%c2":"=&v"(hi[ks]):"v"(vb),"i"(d0*4096+ks*1024+512):"memory");}
    asm volatile("s_waitcnt lgkmcnt(0)":::"memory");SBAR();
    #define PK(k) (bf16x8){lo[k][0],lo[k][1],lo[k][2],lo[k][3],hi[k][0],hi[k][1],hi[k][2],hi[k][3]}
    o[d0]=__builtin_amdgcn_mfma_f32_32x32x16_bf16(pa0,PK(0),o[d0],0,0,0);
    o[d0]=__builtin_amdgcn_mfma_f32_32x32x16_bf16(pa1,PK(1),o[d0],0,0,0);
    o[d0]=__builtin_amdgcn_mfma_f32_32x32x16_bf16(pa2,PK(2),o[d0],0,0,0);
    o[d0]=__builtin_amdgcn_mfma_f32_32x32x16_bf16(pa3,PK(3),o[d0],0,0,0);
    #undef PK
  }
}

#ifndef ATTN_STORE16
#define ATTN_STORE16(p,v) (*(u32x4*)(p)=(v))
#endif
template<int THRL> __device__ __forceinline__ void attn_unit(int b,int h,int qb,const bf16*Q,const bf16*__restrict__ K,const bf16*__restrict__ V,bf16*O,char*shm){
  const int tid=threadIdx.x,lane=tid&63,r32=lane&31,hi=lane>>5; const int wid=__builtin_amdgcn_readfirstlane(tid>>6);
  const long rowbase=(long)b*SEQ; const int q0=qb*QB;
  const bf16*Qw=Q+(rowbase+q0+wid*QBLK)*DM+1536+(h>>1)*64;
  const bf16*Kh=K+rowbase*DM+2048+(h>>1)*64,*Vh=V+rowbase*DM+2560+(h>>2)*128+(h&1)*64;
  const unsigned lds0=(unsigned)(uintptr_t)shm;
  float*wsf=(float*)(shm+LDS_WS)+wid*64;
  const bf16*ksrc=Kh+(long)lane*DM+wid*8;
  const bf16*vsrc=Vh+(long)(16*(wid&3)+(lane>>2))*DM+(wid>>2)*32+(lane&3)*8;
  const unsigned kdst=lds0+LDS_K+wid*1024, vdst=lds0+LDS_V+wid*1024;
  #define DMA_K(t,slot) glds16(ksrc+(long)(t)*KVBLK*DM,(unsigned)__builtin_amdgcn_readfirstlane(kdst+(slot)))
  #define DMA_V(t,slot) glds16(vsrc+(long)(t)*KVBLK*DM,(unsigned)__builtin_amdgcn_readfirstlane(vdst+(slot)))
  const int vb0=(int)(lds0+LDS_V)+((lane>>4)&1)*32+(lane&3)*8+(4*hi+((lane&15)>>2))*64;
  const char*Kbase=shm+LDS_K; bf16x8 kf[8];
  const lds_cptr shm3=(lds_cptr)shm; const lds_cptr kp0=shm3+LDS_K+hi*1024+r32*16; const lds_cptr vp0=shm3+LDS_V+((lane>>4)&1)*32+(lane&3)*8+(4*hi+((lane&15)>>2))*64;
  const int NT=(q0+QB)/KVBLK;
  DMA_K(0,0);DMA_V(0,0);DMA_K(1,SLOTB);
  bf16x8 qr[4];
  #pragma unroll
  for(int d0=0;d0<4;++d0)qr[d0]=*reinterpret_cast<const bf16x8*>(&Qw[(long)r32*DM+d0*16+hi*8]);
  float mhat=0.f,l_reg=0.f;f32x16 o[2];o[0]=f32x16{};o[1]=f32x16{};f32x16 negm=f32x16{};asm volatile("":"+v"(negm));
  const int qrel=wid*QBLK+r32;
  #define CMASK(P0,P1,t) do{int jb_=(t)-(NT-4); if(jb_>=0)cmask(P0,P1,jb_,qrel,hi);}while(0)
  bool resc=false;
  #define START(P0,P1) do{ const float rm=rowmax(P0,P1); resc=false; \
    { const float dl=rm; mhat=fadd_s(mhat,dl); \
      _Pragma("unroll") for(int r=0;r<16;++r){P0[r]=fsub_s(P0[r],dl);P1[r]=fsub_s(P1[r],dl);} \
      _Pragma("unroll") for(int r=0;r<16;++r)negm[r]=-mhat; asm volatile("":"+v"(negm)); } \
    _Pragma("unroll") for(int r=0;r<16;++r)P0[r]=__builtin_amdgcn_exp2f(P0[r]); }while(0)
  #define RESC() do{ if(resc){ asm volatile("s_waitcnt lgkmcnt(0)":::"memory"); \
      _Pragma("unroll") for(int d_=0;d_<2;++d_) _Pragma("unroll") for(int r=0;r<16;++r)o[d_][r]*=wsf[crow(r,hi)]; } }while(0)
  f32x16 pA0,pA1,pB0,pB1;
  int sl_prev=0,sl_cur=0,sl_next=SLOTB;
  #define ROT() do{sl_prev=sl_cur;sl_cur=sl_next;sl_next=(sl_next==(NSLOT-1)*SLOTB)?0:sl_next+SLOTB;}while(0)
  DMA_K(2,2*SLOTB);
  WAIT_BAR(3);
  qkt(pA0,pA1,Kbase,qr,negm,r32,hi);asm volatile("s_nop 15\n\ts_nop 7":"+v"(pA0),"+v"(pA1));CMASK(pA0,pA1,0);
  START(pA0,pA1);
  _Pragma("unroll") for(int r=0;r<16;++r)pA1[r]=__builtin_amdgcn_exp2f(pA1[r]);
  WAIT_BAR(0);
  DMA_K(3,0);DMA_V(1,SLOTB);
  ROT();
  kload8(kf,kp0+sl_cur);
  WAIT_BAR(2);
  s16x4 vlo[8],vhi[8]; u32x4 pw0,pw1,pw2,pw3;
  #define PKW(P,B) cvtpk_s(P[B],P[B+1])
  #define PAF(k) __builtin_bit_cast(bf16x8,pw##k)
  #define VFR(i) (bf16x8){vlo[i][0],vlo[i][1],vlo[i][2],vlo[i][3],vhi[i][0],vhi[i][1],vhi[i][2],vhi[i][3]}
  #define PIN(x) asm volatile("":"+v"(x))
  #define MX3(a,b,c) __builtin_fmaxf(__builtin_fmaxf((a),(b)),(c))
  #define GAPA(MF,A0,A1,A2,A3,W0,W1,PW) do{ MF; sacc+=A0; sacc+=A1; sacc+=A2; sacc+=A3; PIN(sacc); W0; W1; PIN(PW); SBAR(); }while(0)
  #define EX(v) __builtin_amdgcn_exp2f(v)
  #define GAPB(MF,X,B) do{ MF; X[B]=EX(X[B]); X[B+1]=EX(X[B+1]); X[B+2]=EX(X[B+2]); X[B+3]=EX(X[B+3]); PIN(X); SBAR(); }while(0)
  #define VRD(i) do{ vlo[i]=vtr(vp_+(((i)>>2)*4096+((i)&3)*1024)); vhi[i]=vtr(vp_+(((i)>>2)*4096+((i)&3)*1024+512)); }while(0)
  #define KRD(G,j) do{ if(G){ kload2(kf,kp0+sl_next,j); SBAR(); } }while(0)
  #define STEP(C0,C1,P0,P1,t,GK,GV,GL) do{ SBAR(); \
    const lds_cptr vp_=vp0+sl_prev; \
    VRD(0); SBAR(); float sacc=(P0[0]+P0[1]); \
    GAPA(C0=__builtin_amdgcn_mfma_f32_32x32x16_bf16(kf[0],qr[0],negm,0,0,0), P0[2],P0[3],P0[4],P0[5],     pw0[0]=PKW(P0,0), pw0[1]=PKW(P0,2), pw0); \
    VRD(4); SBAR(); GAPA(C1=__builtin_amdgcn_mfma_f32_32x32x16_bf16(kf[1],qr[0],negm,0,0,0), P0[6],P0[7],P0[8],P0[9],     pw0[2]=PKW(P0,4), pw0[3]=PKW(P0,6), pw0); \
    VRD(1); SBAR(); GAPA(C0=__builtin_amdgcn_mfma_f32_32x32x16_bf16(kf[2],qr[1],C0,0,0,0),   P0[10],P0[11],P0[12],P0[13], pw1[0]=PKW(P0,8), pw1[1]=PKW(P0,10), pw1); \
    VRD(5); SBAR(); GAPA(C1=__builtin_amdgcn_mfma_f32_32x32x16_bf16(kf[3],qr[1],C1,0,0,0),   P0[14],P0[15],P1[0],P1[1],   pw1[2]=PKW(P0,12),pw1[3]=PKW(P0,14), pw1); \
    VRD(2); SBAR(); GAPA(C0=__builtin_amdgcn_mfma_f32_32x32x16_bf16(kf[4],qr[2],C0,0,0,0),   P1[2],P1[3],P1[4],P1[5],     pw2[0]=PKW(P1,0), pw2[1]=PKW(P1,2), pw2); \
    VRD(6); SBAR(); GAPA(C1=__builtin_amdgcn_mfma_f32_32x32x16_bf16(kf[5],qr[2],C1,0,0,0),   P1[6],P1[7],P1[8],P1[9],     pw2[2]=PKW(P1,4), pw2[3]=PKW(P1,6), pw2); \
    VRD(3); SBAR(); GAPA(C0=__builtin_amdgcn_mfma_f32_32x32x16_bf16(kf[6],qr[3],C0,0,0,0),   P1[10],P1[11],P1[12],P1[13], pw3[0]=PKW(P1,8), pw3[1]=PKW(P1,10), pw3); \
    VRD(7); SBAR(); GAPA(C1=__builtin_amdgcn_mfma_f32_32x32x16_bf16(kf[7],qr[3],C1,0,0,0),   P1[14],P1[15],0.f,0.f,       pw3[2]=PKW(P1,12),pw3[3]=PKW(P1,14), pw3); \
    l_reg+=sacc; \
    if(GK){DMA_K((t)+3,sl_cur);} if(GV){DMA_V((t)+1,sl_next);} \
    CMASK(C0,C1,t); \
    { float a=MX3(C0[0],C0[1],C1[0]),b=MX3(C0[2],C0[3],C1[1]); a=MX3(a,C1[2],C1[3]); \
      _Pragma("unroll") for(int r=4;r<16;r+=4){a=MX3(a,C0[r],C0[r+1]);b=MX3(b,C0[r+2],C0[r+3]);a=MX3(a,C1[r],C1[r+1]);b=MX3(b,C1[r+2],C1[r+3]);} \
      float rm=__builtin_fmaxf(a,b); { auto rr=__builtin_amdgcn_permlane32_swap(__float_as_uint(rm),__float_as_uint(rm),false,false); rm=__builtin_fmaxf(__uint_as_float(rr[0]),__uint_as_float(rr[1])); } \
      resc=false; \
      if(__builtin_expect(__any(rm>(float)THRL),0)){ const float dl=__builtin_fmaxf(rm,0.f); mhat+=dl; \
        _Pragma("unroll") for(int r=0;r<16;++r){C0[r]-=dl;C1[r]-=dl;} \
        _Pragma("unroll") for(int r=0;r<16;++r)negm[r]=-mhat; asm volatile("":"+v"(negm)); \
        const float f=__builtin_amdgcn_exp2f(-dl); l_reg*=f; if(hi==0)wsf[r32]=f; resc=true; } } \
    SBAR(); \
    GAPB(o[0]=__builtin_amdgcn_mfma_f32_32x32x16_bf16(PAF(0),VFR(0),o[0],0,0,0), C0,0); \
    GAPB(o[1]=__builtin_amdgcn_mfma_f32_32x32x16_bf16(PAF(0),VFR(4),o[1],0,0,0), C0,4); \
    KRD(GL,0); GAPB(o[0]=__builtin_amdgcn_mfma_f32_32x32x16_bf16(PAF(1),VFR(1),o[0],0,0,0), C0,8); \
    KRD(GL,1); GAPB(o[1]=__builtin_amdgcn_mfma_f32_32x32x16_bf16(PAF(1),VFR(5),o[1],0,0,0), C0,12); \
    KRD(GL,2); GAPB(o[0]=__builtin_amdgcn_mfma_f32_32x32x16_bf16(PAF(2),VFR(2),o[0],0,0,0), C1,0); \
    KRD(GL,3); GAPB(o[1]=__builtin_amdgcn_mfma_f32_32x32x16_bf16(PAF(2),VFR(6),o[1],0,0,0), C1,4); \
    GAPB(o[0]=__builtin_amdgcn_mfma_f32_32x32x16_bf16(PAF(3),VFR(3),o[0],0,0,0), C1,8); \
    GAPB(o[1]=__builtin_amdgcn_mfma_f32_32x32x16_bf16(PAF(3),VFR(7),o[1],0,0,0), C1,12); \
    }while(0)
  int t=1;
  #undef CMASK
  #define CMASK(P0,P1,t) do{}while(0)
  for(;t+5<NT;t+=2){
    STEP(pB0,pB1,pA0,pA1,t,true,true,true);     WAIT_BAR(2); RESC(); ROT();
    STEP(pA0,pA1,pB0,pB1,t+1,true,true,true);   WAIT_BAR(2); RESC(); ROT();
  }
  #undef CMASK
  #define CMASK(P0,P1,t) do{int jb_=(t)-(NT-4); if(jb_>=0)cmask(P0,P1,jb_,qrel,hi);}while(0)
  #define ENDW(tt) do{ if((tt)+3<NT){WAIT_BAR(2);} else if((tt)+2<NT){WAIT_BAR(1);} else {WAIT_BAR(0);} }while(0)
  for(;t+1<NT;t+=2){
    STEP(pB0,pB1,pA0,pA1,t,(t+3<NT),(t+1<NT),(t+1<NT));       ENDW(t);   RESC(); ROT();
    STEP(pA0,pA1,pB0,pB1,t+1,(t+4<NT),(t+2<NT),(t+2<NT));     ENDW(t+1); RESC(); ROT();
  }
  STEP(pB0,pB1,pA0,pA1,NT-1,false,false,false); RESC();
  { float sacc=pB0[0]+pB0[1]; _Pragma("unroll") for(int r=2;r<16;++r)sacc+=pB0[r]; _Pragma("unroll") for(int r=0;r<16;++r)sacc+=pB1[r]; l_reg+=sacc;
    pw0=(u32x4){PKW(pB0,0),PKW(pB0,2),PKW(pB0,4),PKW(pB0,6)};pw1=(u32x4){PKW(pB0,8),PKW(pB0,10),PKW(pB0,12),PKW(pB0,14)};pw2=(u32x4){PKW(pB1,0),PKW(pB1,2),PKW(pB1,4),PKW(pB1,6)};pw3=(u32x4){PKW(pB1,8),PKW(pB1,10),PKW(pB1,12),PKW(pB1,14)};
    SBAR(); pv(o,vb0+sl_cur,PAF(0),PAF(1),PAF(2),PAF(3)); }
  #undef PKW
  #undef PAF
  #undef VFR
  #undef PIN
  #undef MX3
  #undef GAPA
  #undef GAPB
  #undef EX
  #undef VRD
  #undef KRD
  #undef STEP
  #undef ENDW
  {auto rr=__builtin_amdgcn_permlane32_swap(__float_as_uint(l_reg),__float_as_uint(l_reg),false,false);l_reg=__uint_as_float(rr[0])+__uint_as_float(rr[1]);}
  if(hi==0)wsf[32+r32]=l_reg;asm volatile("s_waitcnt lgkmcnt(0)":::"memory");
  float rli[16];
  #pragma unroll
  for(int r=0;r<16;++r)rli[r]=__builtin_amdgcn_rcpf(wsf[32+crow(r,hi)]);
  bf16*Ow=O+(rowbase+q0+wid*QBLK)*DMO+h*D;
  { bf16*stg=(bf16*)(shm+LDS_OST)+wid*2048;
    #pragma unroll
    for(int r=0;r<16;++r){const int orow=crow(r,hi);
      #pragma unroll
      for(int d0=0;d0<2;++d0)stg[orow*64+d0*32+r32]=__float2bfloat16(o[d0][r]*rli[r]);}
    asm volatile("s_waitcnt lgkmcnt(0)":::"memory");
    #pragma unroll
    for(int i=0;i<4;++i){const int row=i*8+(lane>>3),ch=lane&7; const u32x4 v=*(const u32x4*)(stg+row*64+ch*8); ATTN_STORE16(Ow+(long)row*DMO+ch*8,v);} }
  asm volatile("s_waitcnt lgkmcnt(0)\n\ts_barrier":::"memory");
  #undef DMA_K
  #undef DMA_V
  #undef CMASK
  #undef START
  #undef RESC
  #undef ROT
}
constexpr int ATTN_LDS_BYTES=LDS_BYTES;
struct AttnTensors { const bf16* Q; const bf16* K; const bf16* V; bf16* O; };
struct AttnUnit { int bh; int qb; };
struct StaticOrder {
  int vcu;
  __device__ __forceinline__ explicit StaticOrder(int grid,int block):vcu((block%8)*(grid/8)+block/8){}
  __device__ __forceinline__ bool next(int i,AttnUnit&u)const{ if(i>=16)return false; const int j=i&7; u.bh=vcu*2+(i>>3); u.qb=(j&1)?7-(j>>1):(j>>1); return true; }
  __device__ __forceinline__ void a_ready(const AttnUnit&)const{}
  __device__ __forceinline__ void done(const AttnUnit&)const{}
};
template<class Sched,int THRL=8> __device__ __forceinline__ void attn_phase(char*lds,const AttnTensors&T,const Sched&S){
  AttnUnit u;
  for(int i=0;S.next(i,u);++i){ S.a_ready(u); attn_unit<THRL>(u.bh/NHEAD,u.bh%NHEAD,u.qb,T.Q,T.K,T.V,T.O,lds); S.done(u); }
}
#undef SBAR
#undef WAIT_BAR
}
namespace mixa {
using bf16x8 = __attribute__((ext_vector_type(8))) short;
using s16x4 = __attribute__((ext_vector_type(4))) short;
using f32x16 = __attribute__((ext_vector_type(16))) float;
using f32x4 = __attribute__((ext_vector_type(4))) float;
using u32x4 = __attribute__((ext_vector_type(4))) unsigned;
typedef short v4i16_t __attribute__((ext_vector_type(4)));
#define MA_LAS __attribute__((address_space(3)))
typedef unsigned short bf16;
constexpr int PQ = 3072, TT = 2048, PY = 1024;
constexpr int XO = 0, XM = 65536, XL = XM + 1024, WV = XL + 1024, WSZ = 4096 + 256;
constexpr int LDS_NEED = WV + 8 * WSZ;
__device__ __forceinline__ int crow(int r, int hi) { return (r & 3) + 8 * (r >> 2) + 4 * hi; }
__device__ __forceinline__ unsigned cvtpk(float lo, float hi) { typedef float f2 __attribute__((ext_vector_type(2))); typedef __bf16 b2 __attribute__((ext_vector_type(2))); f2 v = {lo, hi}; b2 b = __builtin_convertvector(v, b2); return __builtin_bit_cast(unsigned, b); }
template <int BR> __device__ __forceinline__ int qloc(int w, int i) {
    if (BR == 0) return 32 * w + i;
    if (BR == 1) return (w & 3) + 4 * (32 * (w >> 2) + i);
    return (2 * w + (i >> 4)) + 16 * (i & 15);
}
struct State { f32x16 o[2]; float m, l; };
template <int BR> __device__ __forceinline__ void xchg_write(const State& S, MA_LAS unsigned char* L, int w, int r32, int hi) {
    MA_LAS float* xo = (MA_LAS float*)(L + XO);
#pragma unroll
    for (int r = 0; r < 16; ++r) { const int ql = qloc<BR>(w, crow(r, hi)); xo[ql * 64 + r32] = S.o[0][r]; xo[ql * 64 + 32 + r32] = S.o[1][r]; }
    const float lt = S.l + __shfl_xor(S.l, 32);
    if (hi == 0) { const int ql = qloc<BR>(w, r32); ((MA_LAS float*)(L + XM))[ql] = S.m; ((MA_LAS float*)(L + XL))[ql] = lt; }
}
template <int BR> __device__ __forceinline__ void xchg_read(State& S, MA_LAS unsigned char* L, int w, int r32, int hi) {
    const MA_LAS float* xo = (const MA_LAS float*)(L + XO);
#pragma unroll
    for (int r = 0; r < 16; ++r) { const int ql = qloc<BR>(w, crow(r, hi)); S.o[0][r] = xo[ql * 64 + r32]; S.o[1][r] = xo[ql * 64 + 32 + r32]; }
    const int ql = qloc<BR>(w, r32);
    S.m = ((const MA_LAS float*)(L + XM))[ql]; const float lt = ((const MA_LAS float*)(L + XL))[ql]; S.l = (hi == 0) ? lt : 0.f;
}
template <int BR> __device__ __forceinline__ void branch(State& S, const bf16* Qb, int t0, MA_LAS unsigned char* L, int w, int lane) {
    constexpr int STRIDE = (BR == 0) ? 1 : (BR == 1) ? 4 : 16;
    const int r32 = lane & 31, hi = lane >> 5;
    const bf16* Kb = Qb + 512; const bf16* Vb = Qb + 1024;
    MA_LAS unsigned char* img = L + WV + w * WSZ; MA_LAS float* SC = (MA_LAS float*)(img + 4096);
    const int qi = (BR == 0) ? t0 + 32 * w + r32 : (BR == 1) ? (t0 >> 2) + 32 * (w >> 2) + r32 : (t0 >> 4) + (r32 & 15);
    const int qc = (BR == 2) ? (r32 >> 4) : 0;
    bf16x8 qf[4];
    { const bf16* qp = Qb + (size_t)(t0 + qloc<BR>(w, r32)) * PQ + 8 * hi;
#pragma unroll
      for (int d0 = 0; d0 < 4; ++d0) qf[d0] = *(const bf16x8*)(qp + 16 * d0); }
    const int nt2 = ((t0 >> 4) + 16 + 31) >> 5;
    const int ntile = (BR == 2) ? 2 * nt2 : 5;
    const int kbase = (BR == 0) ? t0 + 32 * w - 128 : (BR == 1) ? (t0 >> 2) + 32 * (w >> 2) - 128 : 0;
    const int res01 = (BR == 1) ? (w & 3) : 0;
    int n = 0;
    if (BR != 2) { while (n < ntile && kbase + 32 * n + 31 < 0) ++n; }
#define MA_TILE(nn, cls_, k0_, res_) const int cls_ = (BR == 2) ? ((nn) >= nt2 ? 1 : 0) : 0; const int k0_ = (BR == 2) ? 32 * ((nn) - cls_ * nt2) : kbase + 32 * (nn); const int res_ = (BR == 2) ? 2 * w + cls_ : res01
#define MA_LOADS(kf_, vr_, k0_, res_) do { \
        int kj_ = k0_ + r32; kj_ = kj_ < 0 ? 0 : kj_; const bf16* kp_ = Kb + (size_t)(res_ + STRIDE * kj_) * PQ + 8 * hi; \
        _Pragma("unroll") for (int d0 = 0; d0 < 4; ++d0) kf_[d0] = *(const bf16x8*)(kp_ + 16 * d0); \
        int vj_ = k0_ + (lane >> 1); vj_ = vj_ < 0 ? 0 : vj_; const bf16* vp_ = Vb + (size_t)(res_ + STRIDE * vj_) * PQ + 32 * (lane & 1); \
        _Pragma("unroll") for (int c = 0; c < 4; ++c) vr_[c] = *(const u32x4*)(vp_ + 8 * c); } while (0)
    bf16x8 kfn[4]; u32x4 vrn[4];
    if (n < ntile) { MA_TILE(n, c0, k00, r00); MA_LOADS(kfn, vrn, k00, r00); }
    const int trb = ((lane >> 4) & 1) * 32 + (lane & 3) * 8 + (4 * hi + ((lane & 15) >> 2)) * 64;
    for (; n < ntile; ++n) {
        MA_TILE(n, cls, k0, res); (void)res;
        bf16x8 kf[4]; u32x4 vr[4];
#pragma unroll
        for (int c = 0; c < 4; ++c) { kf[c] = kfn[c]; vr[c] = vrn[c]; }
        asm volatile("" ::: "memory");
#pragma unroll
        for (int c = 0; c < 4; ++c) *(MA_LAS u32x4*)(img + (lane & 1) * 2048 + (lane >> 1) * 64 + c * 16) = vr[c];
        if (n + 1 < ntile) { MA_TILE(n + 1, c1, k01, r01); (void)c1; MA_LOADS(kfn, vrn, k01, r01); }
        f32x16 s = {};
#pragma unroll
        for (int d0 = 0; d0 < 4; ++d0) s = __builtin_amdgcn_mfma_f32_32x32x16_bf16(kf[d0], qf[d0], s, 0, 0, 0);
        const int dbase = k0 + 4 * hi - qi; const int lo = (-qi > -128) ? -qi : -128; const bool tok = (BR != 2) || (qc == cls);
        float tm = -INFINITY;
#pragma unroll
        for (int r = 0; r < 16; ++r) { const int d = dbase + (r & 3) + 8 * (r >> 2); s[r] = (tok && d <= 0 && d >= lo) ? s[r] : -INFINITY; tm = fmaxf(tm, s[r]); }
        tm = fmaxf(tm, __shfl_xor(tm, 32));
        const float mn = fmaxf(S.m, tm), sc = __builtin_amdgcn_exp2f(S.m - mn);
        float ps = 0.f;
#pragma unroll
        for (int r = 0; r < 16; ++r) { s[r] = __builtin_amdgcn_exp2f(s[r] - mn); ps += s[r]; }
        S.l = S.l * sc + ps; S.m = mn;
        if (__any(sc != 1.f)) {
            if (hi == 0) SC[r32] = sc;
            asm volatile("s_waitcnt lgkmcnt(0)" ::: "memory");
#pragma unroll
            for (int j = 0; j < 4; ++j) { const f32x4 f = *(const MA_LAS f32x4*)(SC + 8 * j + 4 * hi);
#pragma unroll
                for (int e = 0; e < 4; ++e) { S.o[0][4 * j + e] *= f[e]; S.o[1][4 * j + e] *= f[e]; } }
        }
        u32x4 p0, p1;
        p0[0] = cvtpk(s[0], s[1]); p0[1] = cvtpk(s[2], s[3]); p0[2] = cvtpk(s[4], s[5]); p0[3] = cvtpk(s[6], s[7]);
        p1[0] = cvtpk(s[8], s[9]); p1[1] = cvtpk(s[10], s[11]); p1[2] = cvtpk(s[12], s[13]); p1[3] = cvtpk(s[14], s[15]);
        const bf16x8 pa0 = __builtin_bit_cast(bf16x8, p0), pa1 = __builtin_bit_cast(bf16x8, p1);
        asm volatile("s_waitcnt lgkmcnt(0)" ::: "memory");
#pragma unroll
        for (int dh = 0; dh < 2; ++dh) {
#pragma unroll
            for (int ks = 0; ks < 2; ++ks) {
                const s16x4 vlo = __builtin_bit_cast(s16x4, __builtin_amdgcn_ds_read_tr16_b64_v4i16((MA_LAS v4i16_t*)(img + dh * 2048 + ks * 1024 + trb)));
                const s16x4 vhi = __builtin_bit_cast(s16x4, __builtin_amdgcn_ds_read_tr16_b64_v4i16((MA_LAS v4i16_t*)(img + dh * 2048 + ks * 1024 + 512 + trb)));
                const bf16x8 vf = (bf16x8){vlo[0], vlo[1], vlo[2], vlo[3], vhi[0], vhi[1], vhi[2], vhi[3]};
                S.o[dh] = __builtin_amdgcn_mfma_f32_32x32x16_bf16(ks == 0 ? pa0 : pa1, vf, S.o[dh], 0, 0, 0);
            }
        }
        asm volatile("s_waitcnt lgkmcnt(0)" ::: "memory");
    }
#undef MA_TILE
#undef MA_LOADS
}
__device__ __forceinline__ void unit(const bf16* QKV, bf16* Y, int b, int h, int t0, MA_LAS unsigned char* L, int tid) {
    const int lane = tid & 63, r32 = lane & 31, hi = lane >> 5; const int w = __builtin_amdgcn_readfirstlane(tid >> 6);
    const bf16* Qb = QKV + (size_t)b * TT * PQ + h * 64;
    State S; S.o[0] = f32x16{}; S.o[1] = f32x16{}; S.m = -1e30f; S.l = 0.f;
    branch<0>(S, Qb, t0, L, w, lane);
    xchg_write<0>(S, L, w, r32, hi); __syncthreads(); xchg_read<1>(S, L, w, r32, hi); __syncthreads();
    branch<1>(S, Qb, t0, L, w, lane);
    xchg_write<1>(S, L, w, r32, hi); __syncthreads(); xchg_read<2>(S, L, w, r32, hi); __syncthreads();
    branch<2>(S, Qb, t0, L, w, lane);
    { MA_LAS unsigned char* img = L + WV + w * WSZ; MA_LAS float* SC = (MA_LAS float*)(img + 4096);
      const float lt = S.l + __shfl_xor(S.l, 32);
      if (hi == 0) SC[r32] = 1.f / lt;
      asm volatile("s_waitcnt lgkmcnt(0)" ::: "memory");
      MA_LAS float* xo = (MA_LAS float*)(L + XO);
#pragma unroll
      for (int r = 0; r < 16; ++r) { const float f = SC[crow(r, hi)]; const int ql = qloc<2>(w, crow(r, hi)); xo[ql * 64 + r32] = S.o[0][r] * f; xo[ql * 64 + 32 + r32] = S.o[1][r] * f; } }
    __syncthreads();
    { const int row = tid >> 1, hf = tid & 1; const MA_LAS float* xr = (const MA_LAS float*)(L + XO) + row * 64 + 32 * hf;
      bf16* yp = Y + ((size_t)b * TT + t0 + row) * PY + h * 64 + 32 * hf;
#pragma unroll
      for (int c = 0; c < 4; ++c) { const f32x4 a = *(const MA_LAS f32x4*)(xr + 8 * c), bq = *(const MA_LAS f32x4*)(xr + 8 * c + 4);
          u32x4 o; o[0] = cvtpk(a[0], a[1]); o[1] = cvtpk(a[2], a[3]); o[2] = cvtpk(bq[0], bq[1]); o[3] = cvtpk(bq[2], bq[3]); *(u32x4*)(yp + 8 * c) = o; } }
    __syncthreads();
}
#undef MA_LAS
}
constexpr int NBATCH = 32, T = 2048, D = 1024, M = NBATCH * T, FF = 2816;
constexpr int NQKV = 3072, NGU = 2 * FF, NZX = 5888, NZX_SRC = 5656, KCD = 2048;
constexpr float RMS_EPS = 1e-6f;
constexpr int NWAVES = 8;
constexpr int NPH = 18;
constexpr size_t MiB = 1u << 20;
constexpr size_t WS_CTL = 0, CTL_ZERO_BYTES = 192 * 1024;
constexpr size_t WS_WDQ = 192 * 1024;
constexpr size_t DO_GATES = 0;
constexpr size_t DO_CS = 16 * MiB;
constexpr size_t WS_W_ABIN = 1 * MiB, WS_W_ABOUT = 7 * MiB, WS_W_GU0 = 9 * MiB, WS_W_DN0 = 20 * MiB, WS_W_CDIN = 26 * MiB, WS_W_CDOUT = 38 * MiB, WS_W_GU1 = 42 * MiB, WS_W_DN1 = 53 * MiB;
constexpr size_t WS_XN = 59 * MiB;
constexpr size_t WS_OB = 187 * MiB;
constexpr size_t WS_R = 315 * MiB;
constexpr size_t WS_QKV = WS_R, WS_ACT = WS_R, WS_U = WS_OB, WS_Z = WS_R, WS_XBC = WS_R + 128 * MiB, WS_V = WS_XBC + 192 * MiB, WS_O = WS_V + 128 * MiB, WS_YCD = WS_XN;
constexpr size_t WS_HB = WS_O + 128 * MiB;
constexpr size_t WS_RSS = WS_HB + 128 * MiB;
constexpr size_t WS_END = WS_RSS + 4 * MiB;
static_assert(WS_W_DN1 + (size_t)D * FF * 2 <= WS_XN && WS_W_CDIN + (size_t)NZX * D * 2 <= WS_W_CDOUT && WS_W_DN0 + (size_t)D * FF * 2 <= WS_W_CDIN, "weights map");
static_assert(WS_QKV + (size_t)M * NQKV * 2 <= WS_HB && WS_ACT + (size_t)M * FF * 2 <= WS_HB && WS_YCD + (size_t)M * KCD * 2 <= WS_R && WS_U + (size_t)M * D * 2 <= WS_R && WS_END <= 1024 * MiB, "activation map");
constexpr int CW_TMO = 0, CW_CODE = 1, CW_WMAX = 64, CW_BAR = 4096, CW_CMAX = 16384  ;
constexpr int RING_OFF = 0, RING_BYTES = 131072;
constexpr int LDSCTL_OFF = 147456 - 512, MISC_OFF = LDSCTL_OFF + 320;
constexpr int LDS_BYTES = 147456;
#define GAS __attribute__((address_space(1)))
#define LAS __attribute__((address_space(3)))
typedef unsigned short bf16;
typedef unsigned v4u __attribute__((ext_vector_type(4)));
typedef float f32x4 __attribute__((ext_vector_type(4)));
typedef short bf16x8 __attribute__((ext_vector_type(8)));
typedef GAS unsigned gu32;
typedef GAS unsigned long long gu64;
#define RLX_AGENT __ATOMIC_RELAXED, __HIP_MEMORY_SCOPE_AGENT
#define LDS_WAIT() asm volatile("s_waitcnt lgkmcnt(0)" ::: "memory")
#define VM_WAIT() asm volatile("s_waitcnt vmcnt(0)" ::: "memory")
__device__ __forceinline__ unsigned long long rt() { return __builtin_amdgcn_s_memrealtime(); }
__device__ __forceinline__ unsigned f2bf(float f) { unsigned u = __builtin_bit_cast(unsigned, f); return (u + 0x7fffu + ((u >> 16) & 1u)) >> 16; }
__device__ __forceinline__ unsigned pk2(float lo, float hi) { return f2bf(lo) | (f2bf(hi) << 16); }

#define XB_TMO      128
#define XB_XCNT(j)  (256  + 64 * (j))
#define XB_XSUB(j)  (1280 + 64 * (j))
#define XB_XGEN(j)  (2304 + 64 * (j))
#define XB_TOP      3328
#define XB_TOPGEN   3392
#define XCD_BAR_WORDS 3456
#define XB_SPIN_CAP (1u << 18)

__device__ __forceinline__ unsigned xb_ld(unsigned* p)              { return __hip_atomic_load(p, __ATOMIC_RELAXED, __HIP_MEMORY_SCOPE_AGENT); }
__device__ __forceinline__ unsigned xb_add(unsigned* p, unsigned v) { return __hip_atomic_fetch_add(p, v, __ATOMIC_RELAXED, __HIP_MEMORY_SCOPE_AGENT); }
__device__ __forceinline__ unsigned xb_xcc_id() { return (unsigned)__builtin_amdgcn_s_getreg((3 << 11) | 20) & 0xFu; }
#define XB_SPIN(cond, bar) do { unsigned _sp = 0; while (cond) { __builtin_amdgcn_s_sleep(1); \
    if ((++_sp & 255u) == 0u) { if (xb_ld(&(bar)[XB_TMO])) break; if (_sp > XB_SPIN_CAP) { atomicAdd(&(bar)[XB_TMO], 1u); break; } } } } while (0)

struct XcdBarrier {
    unsigned* bar; unsigned x;
    volatile LAS unsigned* st;
};

__device__ __forceinline__ XcdBarrier xcd_barrier_post(unsigned* bar, volatile LAS unsigned* st) {
    XcdBarrier b; b.bar = bar; b.x = xb_xcc_id(); b.st = st;
    if (threadIdx.x == 0) (void)xb_add(&bar[XB_XCNT(b.x)], 1u);
    return b;
}
__device__ __forceinline__ void xcd_barrier_complete(unsigned* bar, unsigned x, unsigned& nloc, unsigned& nx) {
    const unsigned G = gridDim.x * gridDim.y * gridDim.z;
    unsigned sum, cnt, mine, sp = 0u;
    for (;;) {
        sum = 0u; cnt = 0u; mine = 0u;
#pragma unroll
        for (unsigned j = 0; j < 16; ++j) { const unsigned c = xb_ld(&bar[XB_XCNT(j)]); sum += c; cnt += (c > 0u) ? 1u : 0u; mine = (j == x) ? c : mine; }
        if (sum == G) break;
        __builtin_amdgcn_s_sleep(1);
        if ((++sp & 255u) == 0u) { if (xb_ld(&bar[XB_TMO])) break; if (sp > XB_SPIN_CAP) { atomicAdd(&bar[XB_TMO], 1u); break; } }
    }
    nloc = mine > 0u ? mine : 1u; nx = cnt > 0u ? cnt : 1u;
}

__device__ __forceinline__ void xcd_barrier(const XcdBarrier& b) {
    asm volatile("s_waitcnt vmcnt(0)" ::: "memory");
    __syncthreads();
    if (threadIdx.x == 0) {
        unsigned* bar = b.bar;
        __builtin_amdgcn_s_waitcnt(0);
        unsigned nloc = b.st[0], nx = b.st[1];
        if (nloc == 0u) { xcd_barrier_complete(bar, b.x, nloc, nx); b.st[0] = nloc; b.st[1] = nx; }
        const unsigned old = xb_add(&bar[XB_XSUB(b.x)], 1u);
        const unsigned gen = old / nloc;
        if (old + 1u == (gen + 1u) * nloc) {
            __builtin_amdgcn_fence(__ATOMIC_RELEASE, "agent");
            asm volatile("s_waitcnt vmcnt(0)" ::: "memory");
            const unsigned og = xb_add(&bar[XB_TOP], 1u);
            const unsigned tg = og / nx;
            if (og + 1u == (tg + 1u) * nx) xb_add(&bar[XB_TOPGEN], 1u);
            else XB_SPIN(xb_ld(&bar[XB_TOPGEN]) == tg, bar);
            __builtin_amdgcn_fence(__ATOMIC_ACQUIRE, "agent");
            xb_add(&bar[XB_XGEN(b.x)], 1u);
            asm volatile("s_waitcnt vmcnt(0)" ::: "memory");
        } else {
            XB_SPIN(xb_ld(&bar[XB_XGEN(b.x)]) == gen, bar);
            __builtin_amdgcn_fence(__ATOMIC_ACQUIRE, "agent");
            asm volatile("s_waitcnt vmcnt(0)" ::: "memory");
        }
    }
    __syncthreads();
}
static_assert((CW_BAR + 2 * XCD_BAR_WORDS) * 4 <= (int)CTL_ZERO_BYTES, "CTL words inside the memset region");
typedef unsigned long long u64;
__device__ __forceinline__ float wave_sum(float v) {
#pragma unroll
    for (int o = 1; o < 64; o <<= 1) v += __shfl_xor(v, o);
    return v;
}
__device__ __forceinline__ float silu_g(float x) { return x * __builtin_amdgcn_rcpf(1.f + __expf(-x)); }
__device__ __forceinline__ float sigm_g(float x) { return __builtin_amdgcn_rcpf(1.f + __expf(-x)); }
__device__ __forceinline__ float bf2f(bf16 v) { return __uint_as_float((unsigned)v << 16); }
__device__ __forceinline__ void ld8f(const bf16* p, float* f) {
    const v4u v = *(const v4u*)p;
    f[0] = __uint_as_float(v.x << 16); f[1] = __uint_as_float(v.x & 0xffff0000u); f[2] = __uint_as_float(v.y << 16); f[3] = __uint_as_float(v.y & 0xffff0000u);
    f[4] = __uint_as_float(v.z << 16); f[5] = __uint_as_float(v.z & 0xffff0000u); f[6] = __uint_as_float(v.w << 16); f[7] = __uint_as_float(v.w & 0xffff0000u);
}
__device__ __forceinline__ void st8f(bf16* p, const float* f) { v4u o; o.x = pk2(f[0], f[1]); o.y = pk2(f[2], f[3]); o.z = pk2(f[4], f[5]); o.w = pk2(f[6], f[7]); *(v4u*)p = o; }

__device__ __forceinline__ int map_gu(int n) { const int p = n >> 8, r = n & 255; return r < 128 ? 128 * p + r : FF + 128 * p + (r - 128); }
__device__ __forceinline__ int map_cdin(int n) {
    if (n < 2560) return n; if (n < 3584) return 2576 + (n - 2560); if (n < 4608) return 3600 + (n - 3584); if (n < 5632) return 4624 + (n - 4608);
    const int j = n - 5632; if (j < 16) return 2560 + j; if (j < 24) return 5648 + (j - 16); return -1;
}
template <int MAP> __device__ __forceinline__ void tr_item(const float* W, int K, int Nsrc, bf16* WT, int nblk, LAS float* scr, int item, int lane, const float* nw = nullptr) {
    const int kb = item / nblk, nb = item % nblk, k0 = 64 * kb, n0 = 32 * nb;
    const int nd = n0 + (lane & 31); const int sc = (MAP == 0) ? nd : (MAP == 1) ? map_gu(nd) : map_cdin(nd);
#pragma unroll 8
    for (int i = 0; i < 32; ++i) { const int kk = 2 * i + (lane >> 5); scr[kk * 33 + (lane & 31)] = (sc >= 0) ? W[(size_t)(k0 + kk) * Nsrc + sc] * (nw ? nw[k0 + kk] : 1.f) : 0.f; }
    LDS_WAIT(); asm volatile("" ::: "memory");
    const int c = lane & 7;
#pragma unroll
    for (int j = 0; j < 4; ++j) { const int n = (lane >> 3) + 8 * j; const LAS float* s = scr + (8 * c) * 33 + n;
        v4u o; o.x = pk2(s[0 * 33], s[1 * 33]); o.y = pk2(s[2 * 33], s[3 * 33]); o.z = pk2(s[4 * 33], s[5 * 33]); o.w = pk2(s[6 * 33], s[7 * 33]);
        *(GAS v4u*)(WT + (size_t)(n0 + n) * K + k0 + 8 * c) = o; }
    LDS_WAIT(); asm volatile("" ::: "memory");
}
__device__ __forceinline__ void tr_item8(const float* W, int K, int Nsrc, unsigned char* WT, int nblk, LAS float* scr, int item, int lane, float sc) {
    const int kb = item / nblk, nb = item % nblk, k0 = 64 * kb, n0 = 32 * nb; const int nd = n0 + (lane & 31);
#pragma unroll 8
    for (int i = 0; i < 32; ++i) { const int kk = 2 * i + (lane >> 5); scr[kk * 33 + (lane & 31)] = W[(size_t)(k0 + kk) * Nsrc + nd] * sc; }
    LDS_WAIT(); asm volatile("" ::: "memory");
    const int c = lane & 7;
#pragma unroll
    for (int j = 0; j < 4; ++j) { const int n = (lane >> 3) + 8 * j; const LAS float* s = scr + (8 * c) * 33 + n;
        const u64 o = (u64)pg8::pk4_fp8(s[0 * 33], s[1 * 33], s[2 * 33], s[3 * 33]) | ((u64)pg8::pk4_fp8(s[4 * 33], s[5 * 33], s[6 * 33], s[7 * 33]) << 32);
        *(GAS u64*)(WT + (size_t)(n0 + n) * K + k0 + 8 * c) = o; }
    LDS_WAIT(); asm volatile("" ::: "memory");
}
__device__ __forceinline__ unsigned pk4_i8(float a, float b, float c, float d) {
    const int x = __float2int_rn(a), y = __float2int_rn(b), z = __float2int_rn(c), w = __float2int_rn(d);
    return (unsigned)(x & 255) | ((unsigned)(y & 255) << 8) | ((unsigned)(z & 255) << 16) | ((unsigned)w << 24);
}
template <int MAP> __device__ __forceinline__ void tr_item_i8(const float* W, int K, int Nsrc, unsigned char* WT, int nblk, LAS float* scr, int item, int lane, const unsigned* cmax, float* wdq) {
    const int kb = item / nblk, nb = item % nblk, k0 = 64 * kb, n0 = 32 * nb; const int nd = n0 + (lane & 31); const int scn = (MAP == 0) ? nd : (MAP == 1) ? map_gu(nd) : map_cdin(nd);
    const float cm = fmaxf(__uint_as_float(cmax[scn >= 0 ? scn : 0]), 1e-30f), sc = 127.f / cm;
    if (kb == 0 && lane < 32) wdq[nd] = (scn >= 0) ? cm * (1.f / 127.f) : 0.f;
#pragma unroll 8
    for (int i = 0; i < 32; ++i) { const int kk = 2 * i + (lane >> 5); scr[kk * 33 + (lane & 31)] = (scn >= 0) ? W[(size_t)(k0 + kk) * Nsrc + scn] * sc : 0.f; }
    LDS_WAIT(); asm volatile("" ::: "memory");
    const int c = lane & 7;
#pragma unroll
    for (int j = 0; j < 4; ++j) { const int n = (lane >> 3) + 8 * j; const LAS float* s = scr + (8 * c) * 33 + n;
        const u64 o = (u64)pk4_i8(s[0 * 33], s[1 * 33], s[2 * 33], s[3 * 33]) | ((u64)pk4_i8(s[4 * 33], s[5 * 33], s[6 * 33], s[7 * 33]) << 32);
        *(GAS u64*)(WT + (size_t)(n0 + n) * K + k0 + 8 * c) = o; }
    LDS_WAIT(); asm volatile("" ::: "memory");
}
__device__ __forceinline__ void wht16(float* v) {
#pragma unroll
    for (int h = 1; h < 16; h <<= 1)
#pragma unroll
        for (int i = 0; i < 16; ++i) if ((i & h) == 0) { const float a = v[i], b = v[i + h]; v[i] = a + b; v[i + h] = a - b; }
}
__device__ __forceinline__ void tr_item_i8rot(const float* W, int K, int Nsrc, unsigned char* WT, int nblk, LAS float* scr, int item, int lane, const unsigned* cmax, float* wdq) {
    const int kb = item / nblk, nb = item % nblk, k0 = 64 * kb, n0 = 32 * nb; const int nd = n0 + (lane & 31);
    const float cm = fmaxf(__uint_as_float(cmax[nd]), 1e-30f), sc = 0.25f * 127.f / cm;
    if (kb == 0 && lane < 32) wdq[nd] = cm * (1.f / 127.f);
#pragma unroll 8
    for (int i = 0; i < 32; ++i) { const int kk = 2 * i + (lane >> 5); scr[kk * 33 + (lane & 31)] = W[(size_t)(k0 + kk) * Nsrc + nd]; }
    LDS_WAIT(); asm volatile("" ::: "memory");
#pragma unroll 1
    for (int g2 = 0; g2 < 2; ++g2) { const int grp = (lane >> 5) + 2 * g2; LAS float* s = scr + (16 * grp) * 33 + (lane & 31); float v[16];
#pragma unroll
        for (int j = 0; j < 16; ++j) v[j] = s[j * 33];
        wht16(v);
#pragma unroll
        for (int j = 0; j < 16; ++j) s[j * 33] = v[j] * sc; }
    LDS_WAIT(); asm volatile("" ::: "memory");
    const int c = lane & 7;
#pragma unroll
    for (int j = 0; j < 4; ++j) { const int n = (lane >> 3) + 8 * j; const LAS float* s = scr + (8 * c) * 33 + n;
        const u64 o = (u64)pk4_i8(s[0 * 33], s[1 * 33], s[2 * 33], s[3 * 33]) | ((u64)pk4_i8(s[4 * 33], s[5 * 33], s[6 * 33], s[7 * 33]) << 32);
        *(GAS u64*)(WT + (size_t)(n0 + n) * K + k0 + 8 * c) = o; }
    LDS_WAIT(); asm volatile("" ::: "memory");
}
__device__ __forceinline__ void act_row_rot_i8(const bf16* arow, unsigned char* orow, float* dq, int lane) {
    float v[3][16]; float am = 0.f;
#pragma unroll
    for (int i = 0; i < 3; ++i) { const int blk = lane + 64 * i;
        if (blk < FF / 16) { ld8f(arow + blk * 16, v[i]); ld8f(arow + blk * 16 + 8, v[i] + 8); wht16(v[i]);
#pragma unroll
            for (int e = 0; e < 16; ++e) { v[i][e] *= 0.25f; am = fmaxf(am, fabsf(v[i][e])); } } }
#pragma unroll
    for (int o = 1; o < 64; o <<= 1) am = fmaxf(am, __shfl_xor(am, o));
    am = fmaxf(am, 1e-20f); const float sc = 127.f / am;
#pragma unroll
    for (int i = 0; i < 3; ++i) { const int blk = lane + 64 * i;
        if (blk < FF / 16) { v4u q; q.x = pk4_i8(v[i][0] * sc, v[i][1] * sc, v[i][2] * sc, v[i][3] * sc); q.y = pk4_i8(v[i][4] * sc, v[i][5] * sc, v[i][6] * sc, v[i][7] * sc);
            q.z = pk4_i8(v[i][8] * sc, v[i][9] * sc, v[i][10] * sc, v[i][11] * sc); q.w = pk4_i8(v[i][12] * sc, v[i][13] * sc, v[i][14] * sc, v[i][15] * sc);
            *(v4u*)(orow + blk * 16) = q; } }
    if (lane == 0) dq[0] = am * (1.f / 127.f);
}
__device__ __forceinline__ void rms_row_i8(const bf16* hrow, const float* w, unsigned char* orow, float* dq, int lane) {
    float h[16]; ld8f(hrow + lane * 16, h); ld8f(hrow + lane * 16 + 8, h + 8);
    float s = 0.f;
#pragma unroll
    for (int e = 0; e < 16; ++e) s += h[e] * h[e];
    const float rstd = 1.f / sqrtf(wave_sum(s) * (1.f / D) + RMS_EPS);
    float am = 0.f;
#pragma unroll
    for (int j = 0; j < 4; ++j) { const f32x4 g = *(const f32x4*)(w + lane * 16 + 4 * j); h[4 * j] *= rstd * g.x; h[4 * j + 1] *= rstd * g.y; h[4 * j + 2] *= rstd * g.z; h[4 * j + 3] *= rstd * g.w;
        am = fmaxf(fmaxf(am, fmaxf(fabsf(h[4 * j]), fabsf(h[4 * j + 1]))), fmaxf(fabsf(h[4 * j + 2]), fabsf(h[4 * j + 3]))); }
#pragma unroll
    for (int o = 1; o < 64; o <<= 1) am = fmaxf(am, __shfl_xor(am, o));
    am = fmaxf(am, 1e-20f); const float sc = 127.f / am;
    v4u q; q.x = pk4_i8(h[0] * sc, h[1] * sc, h[2] * sc, h[3] * sc); q.y = pk4_i8(h[4] * sc, h[5] * sc, h[6] * sc, h[7] * sc); q.z = pk4_i8(h[8] * sc, h[9] * sc, h[10] * sc, h[11] * sc); q.w = pk4_i8(h[12] * sc, h[13] * sc, h[14] * sc, h[15] * sc);
    *(v4u*)(orow + lane * 16) = q;
    if (lane == 0) dq[0] = am * (1.f / 127.f);
}
__device__ __forceinline__ void rms_row_to_bf16(const float* xrow, const float* w, bf16* orow, int lane) {
    const f32x4* xr = (const f32x4*)xrow + lane; const f32x4* wr = (const f32x4*)w + lane;
    f32x4 v[4]; float s = 0.f;
#pragma unroll
    for (int j = 0; j < 4; ++j) { v[j] = xr[64 * j]; s += (v[j].x * v[j].x + v[j].y * v[j].y) + (v[j].z * v[j].z + v[j].w * v[j].w); }
    const float rstd = 1.f / sqrtf(wave_sum(s) * (1.f / D) + RMS_EPS);
    u64* o8 = (u64*)orow + lane;
#pragma unroll
    for (int j = 0; j < 4; ++j) { const f32x4 g = wr[64 * j]; o8[64 * j] = (u64)pk2(v[j].x * rstd * g.x, v[j].y * rstd * g.y) | ((u64)pk2(v[j].z * rstd * g.z, v[j].w * rstd * g.w) << 32); }
}
__device__ __forceinline__ void rms_row_bf16(const bf16* hrow, const float* w, bf16* orow, int lane) {
    float h[16]; ld8f(hrow + lane * 16, h); ld8f(hrow + lane * 16 + 8, h + 8);
    float s = 0.f;
#pragma unroll
    for (int e = 0; e < 16; ++e) s += h[e] * h[e];
    const float rstd = 1.f / sqrtf(wave_sum(s) * (1.f / D) + RMS_EPS);
#pragma unroll
    for (int j = 0; j < 4; ++j) { const f32x4 g = *(const f32x4*)(w + lane * 16 + 4 * j); h[4 * j] *= rstd * g.x; h[4 * j + 1] *= rstd * g.y; h[4 * j + 2] *= rstd * g.z; h[4 * j + 3] *= rstd * g.w; }
    st8f(orow + lane * 16, h); st8f(orow + lane * 16 + 8, h + 8);
}
__device__ __forceinline__ void final_row(const bf16* hrow, const float* w, float* orow, int lane) {
    float h[16]; ld8f(hrow + lane * 16, h); ld8f(hrow + lane * 16 + 8, h + 8);
    float s = 0.f;
#pragma unroll
    for (int e = 0; e < 16; ++e) s += h[e] * h[e];
    const float rstd = 1.f / sqrtf(wave_sum(s) * (1.f / D) + RMS_EPS);
#pragma unroll
    for (int j = 0; j < 4; ++j) { const f32x4 g = *(const f32x4*)(w + lane * 16 + 4 * j); *(f32x4*)(orow + lane * 16 + 4 * j) = (f32x4){h[4 * j] * rstd * g.x, h[4 * j + 1] * rstd * g.y, h[4 * j + 2] * rstd * g.z, h[4 * j + 3] * rstd * g.w}; }
}
__device__ __forceinline__ void rms_row_inplace_f32(float* xrow, const float* w, int lane) {
    f32x4* xr = (f32x4*)xrow + lane; const f32x4* wr = (const f32x4*)w + lane;
    f32x4 v[4]; float s = 0.f;
#pragma unroll
    for (int j = 0; j < 4; ++j) { v[j] = xr[64 * j]; s += (v[j].x * v[j].x + v[j].y * v[j].y) + (v[j].z * v[j].z + v[j].w * v[j].w); }
    const float rstd = 1.f / sqrtf(wave_sum(s) * (1.f / D) + RMS_EPS);
#pragma unroll
    for (int j = 0; j < 4; ++j) { const f32x4 g = wr[64 * j]; xr[64 * j] = v[j] * rstd * g; }
}

__device__ __forceinline__ void attnA_naive_item(const bf16* QKV, bf16* Y, int b, int h, int tb, int lane) {
    const int t = tb * 64 + lane; const size_t row = (size_t)b * T + t;
    float q[64], o[64];
#pragma unroll
    for (int c = 0; c < 8; ++c) ld8f(QKV + row * NQKV + h * 64 + 8 * c, q + 8 * c);
#pragma unroll
    for (int e = 0; e < 64; ++e) { q[e] *= 0.125f; o[e] = 0.f; }
    float m = -1e30f, l = 0.f;
#define A_KEY(tk, cw) do { const bf16* kr = QKV + ((size_t)b * T + (tk)) * NQKV + 512 + h * 64; float s = 0.f; \
    _Pragma("unroll") for (int c = 0; c < 8; ++c) { float kf[8]; ld8f(kr + 8 * c, kf); _Pragma("unroll") for (int e = 0; e < 8; ++e) s += q[8 * c + e] * kf[e]; } \
    const float mn = fmaxf(m, s); const float sc = __expf(m - mn); const float p = (cw) * __expf(s - mn); l = l * sc + p; m = mn; \
    const bf16* vr = kr + 512; \
    _Pragma("unroll") for (int c = 0; c < 8; ++c) { float vf[8]; ld8f(vr + 8 * c, vf); _Pragma("unroll") for (int e = 0; e < 8; ++e) o[8 * c + e] = o[8 * c + e] * sc + p * vf[e]; } } while (0)
    for (int d = 0; d <= 128 && d <= t; ++d) { const float cw = 1.f + ((d & 3) == 0 ? 1.f : 0.f) + ((d & 15) == 0 ? 1.f : 0.f); A_KEY(t - d, cw); }
    for (int d = 132; d <= 512 && d <= t; d += 4) { const float cw = 1.f + ((d & 15) == 0 ? 1.f : 0.f); A_KEY(t - d, cw); }
    for (int d = 528; d <= t; d += 16) { A_KEY(t - d, 1.f); }
#undef A_KEY
    const float il = 1.f / l;
#pragma unroll
    for (int e = 0; e < 64; ++e) o[e] *= il;
#pragma unroll
    for (int c = 0; c < 8; ++c) st8f(Y + row * D + h * 64 + 8 * c, o + 8 * c);
}
__device__ __forceinline__ void attnB_naive_item(const bf16* QKV, bf16* OB, int b, int hv, int tb, int lane, float qscale) {
    const int h = hv >> 2, c2 = (hv >> 1) & 1, vh = hv & 1;
    const bf16* Qp = QKV + 1536 + h * 128 + c2 * 64; const bf16* Kp = QKV + 2048 + h * 128 + c2 * 64; const bf16* Vp = QKV + 2560 + h * 128 + vh * 64;
    const int t = tb * 64 + lane; const size_t row = (size_t)b * T + t;
    float q[64], o[64];
#pragma unroll
    for (int c = 0; c < 8; ++c) ld8f(Qp + row * NQKV + 8 * c, q + 8 * c);
#pragma unroll
    for (int e = 0; e < 64; ++e) { q[e] *= qscale; o[e] = 0.f; }
    float m = -1e30f, l = 0.f;
    const int nk = tb * 64 + 64;
    for (int kk = 0; kk < nk; ++kk) {
        const bf16* kr = Kp + ((size_t)b * T + kk) * NQKV; float s = 0.f;
#pragma unroll
        for (int c = 0; c < 8; ++c) { float kf[8]; ld8f(kr + 8 * c, kf);
#pragma unroll
            for (int e = 0; e < 8; ++e) s += q[8 * c + e] * kf[e]; }
        const bool valid = kk <= t; const float sv = valid ? s : -1e30f;
        const float mn = fmaxf(m, sv); const float sc = __expf(m - mn); const float p = valid ? __expf(sv - mn) : 0.f; l = l * sc + p; m = mn;
        const bf16* vr = Vp + ((size_t)b * T + kk) * NQKV;
#pragma unroll
        for (int c = 0; c < 8; ++c) { float vf[8]; ld8f(vr + 8 * c, vf);
#pragma unroll
            for (int e = 0; e < 8; ++e) o[8 * c + e] = o[8 * c + e] * sc + p * vf[e]; }
    }
    const float il = 1.f / l;
#pragma unroll
    for (int e = 0; e < 64; ++e) o[e] *= il;
#pragma unroll
    for (int c = 0; c < 8; ++c) st8f(OB + row * D + hv * 64 + 8 * c, o + 8 * c);
}
__device__ __forceinline__ void attnB_post_row(const bf16* OB, bf16* Y, const float* subw, float lam, float outscale, size_t row, int lane) {
    const int h = lane >> 4, sub = lane & 15, vh = sub >> 3, d0 = (sub & 7) * 8;
    float a[8], b[8], r[8];
    ld8f(OB + row * D + ((h * 2 + 0) * 2 + vh) * 64 + d0, a); ld8f(OB + row * D + ((h * 2 + 1) * 2 + vh) * 64 + d0, b);
    float ss = 0.f;
#pragma unroll
    for (int e = 0; e < 8; ++e) { r[e] = a[e] - lam * b[e]; ss += r[e] * r[e]; }
    ss += __shfl_xor(ss, 1); ss += __shfl_xor(ss, 2); ss += __shfl_xor(ss, 4); ss += __shfl_xor(ss, 8);
    const float rstd = 1.f / sqrtf(ss * (1.f / 128.f) + RMS_EPS);
    const int dv = vh * 64 + d0;
#pragma unroll
    for (int e = 0; e < 8; ++e) r[e] = r[e] * rstd * subw[dv + e] * outscale;
    st8f(Y + row * D + 512 + h * 128 + dv, r);
}
template <int MODE> __device__ __forceinline__ void conv_unit(bf16* X, int pitch, int c0, const float* cw, int cwp, const float* cb, int b, int tid, const float* wq, const float* wk, bf16* KB) {
    const int oct = tid & 15, seg = tid >> 4, ch = c0 + 8 * oct;
    float w0[8], w1[8], w2[8], w3[8], bs[8], h0[8], h1[8], h2[8];
#pragma unroll
    for (int e = 0; e < 8; ++e) { w0[e] = cw[ch + e]; w1[e] = cw[cwp + ch + e]; w2[e] = cw[2 * cwp + ch + e]; w3[e] = cw[3 * cwp + ch + e]; bs[e] = cb[ch + e]; }
    bf16* base = X + ((size_t)b * T + seg * 64) * pitch + ch;
    if (seg == 0) {
#pragma unroll
        for (int e = 0; e < 8; ++e) { h0[e] = 0.f; h1[e] = 0.f; h2[e] = 0.f; }
    } else { ld8f(base - 3 * (size_t)pitch, h0); ld8f(base - 2 * (size_t)pitch, h1); ld8f(base - (size_t)pitch, h2); }
    float wqv[2][4][4], wkv[2][4][4];
    if (MODE == 1) {
#pragma unroll
        for (int a = 0; a < 2; ++a)
#pragma unroll
            for (int j = 0; j < 4; ++j)
#pragma unroll
                for (int i = 0; i < 4; ++i) { const int nb = (ch >> 2) + a; wqv[a][j][i] = wq[(nb * 4 + j) * 4 + i]; wkv[a][j][i] = wk[(nb * 4 + j) * 4 + i] * 0.0625f; }
    }
    __syncthreads();
#pragma unroll 4
    for (int s = 0; s < 64; ++s) {
        float raw[8], o[8];
        ld8f(base + (size_t)s * pitch, raw);
#pragma unroll
        for (int e = 0; e < 8; ++e) { const float v = w0[e] * h0[e] + w1[e] * h1[e] + w2[e] * h2[e] + w3[e] * raw[e] + bs[e]; o[e] = silu_g(v); h0[e] = h1[e]; h1[e] = h2[e]; h2[e] = raw[e]; }
        if (MODE == 0) st8f(base + (size_t)s * pitch, o);
        else {
            float q[8], k[8];
#pragma unroll
            for (int a = 0; a < 2; ++a)
#pragma unroll
                for (int i = 0; i < 4; ++i) { float qa = 0.f, ka = 0.f;
#pragma unroll
                    for (int j = 0; j < 4; ++j) { qa += o[4 * a + j] * wqv[a][j][i]; ka += o[4 * a + j] * wkv[a][j][i]; }
                    q[4 * a + i] = qa; k[4 * a + i] = ka; }
            st8f(base + (size_t)s * pitch, q); st8f(KB + ((size_t)b * T + seg * 64 + s) * D + ch, k);
        }
    }
    __syncthreads();
}
namespace mam {
using bf16x8 = __attribute__((ext_vector_type(8))) short;
using s16x4 = __attribute__((ext_vector_type(4))) short;
using f32x16 = __attribute__((ext_vector_type(16))) float;
using f32x4 = __attribute__((ext_vector_type(4))) float;
using u32x4 = __attribute__((ext_vector_type(4))) unsigned;
using u32x2 = __attribute__((ext_vector_type(2))) unsigned;
typedef short v4i16_t __attribute__((ext_vector_type(4)));
#define MM_LAS __attribute__((address_space(3)))
typedef unsigned short bf16;
constexpr int PXBC = 1536, TT = 2048;
constexpr int PB = 272, PX = 144, PS = 272;
constexpr int LB = 0, LC = LB + 128 * PB, LX = LC + 128 * PB, LS = LX + 2 * 128 * PX, LV = LS + 2 * 64 * PS, VSZ = 5 * 512;
constexpr int LDS_NEED = LV + 2 * VSZ;
__device__ __forceinline__ int crow(int r, int hi) { return (r & 3) + 8 * (r >> 2) + 4 * hi; }
__device__ __forceinline__ unsigned cvtpk(float lo, float hi) { typedef float f2 __attribute__((ext_vector_type(2))); typedef __bf16 b2 __attribute__((ext_vector_type(2))); f2 v = {lo, hi}; b2 b = __builtin_convertvector(v, b2); return __builtin_bit_cast(unsigned, b); }
__device__ __forceinline__ bf16x8 trfrag(const MM_LAS unsigned char* p, int rowpitch8) {
    const s16x4 lo = __builtin_bit_cast(s16x4, __builtin_amdgcn_ds_read_tr16_b64_v4i16((MM_LAS v4i16_t*)p));
    const s16x4 hi = __builtin_bit_cast(s16x4, __builtin_amdgcn_ds_read_tr16_b64_v4i16((MM_LAS v4i16_t*)(p + rowpitch8)));
    return (bf16x8){lo[0], lo[1], lo[2], lo[3], hi[0], hi[1], hi[2], hi[3]};
}
__device__ __forceinline__ void unit(bf16* XBC, const float* GT, const float* dtb, const float* alog, const float* dsk, int b, int g, int hp, MM_LAS unsigned char* L, int tid) {
    const int lane = tid & 63, r32 = lane & 31, hi = lane >> 5; const int w = __builtin_amdgcn_readfirstlane(tid >> 6);
    const int hh = w >> 2, it = hh ? 3 - (w & 3) : (w & 3), head = g * 8 + 2 * hp + hh;
    const float a_neg = -expf(alog[head]), dskh = dsk[head];
    const int q4 = (lane & 15) >> 2, p4 = lane & 3, blk = (lane >> 4) & 1;
    MM_LAS float* V = (MM_LAS float*)(L + LV + hh * VSZ);
    f32x16 st[2]; st[0] = f32x16{}; st[1] = f32x16{};
    for (int i = tid; i < 2 * 64 * PS / 4; i += 512) ((MM_LAS unsigned*)(L + LS))[i] = 0u;
    const unsigned sgo = (unsigned)(tid >> 4) * (PXBC * 2) + (unsigned)(tid & 15) * 16;
    const unsigned slo = (unsigned)(tid >> 4) * PB + (unsigned)(tid & 15) * 16;
    const unsigned sxo = (unsigned)((tid & 15) >> 3) * 128 * PX + (unsigned)(tid >> 4) * PX + (unsigned)(tid & 7) * 16;
    u32x4 tb[4], tc[4], tx[4];
    { const unsigned char* g0 = (const unsigned char*)(XBC + (size_t)b * TT * PXBC);
#pragma unroll
      for (int q = 0; q < 4; ++q) { tb[q] = *(const u32x4*)(g0 + (size_t)q * (32 * PXBC * 2) + (1024 + g * 128) * 2 + sgo); tc[q] = *(const u32x4*)(g0 + (size_t)q * (32 * PXBC * 2) + (1280 + g * 128) * 2 + sgo);
          tx[q] = *(const u32x4*)(g0 + (size_t)q * (32 * PXBC * 2) + ((g * 8 + 2 * hp) * 64) * 2 + sgo); } }
    for (int c = 0; c < 16; ++c) {
        const size_t row0 = (size_t)b * TT + c * 128;
        __syncthreads();
#pragma unroll
        for (int q = 0; q < 4; ++q) { *(MM_LAS u32x4*)(L + LB + q * (32 * PB) + slo) = tb[q]; *(MM_LAS u32x4*)(L + LC + q * (32 * PB) + slo) = tc[q]; *(MM_LAS u32x4*)(L + LX + q * (32 * PX) + sxo) = tx[q]; }
        if ((w & 3) == 0) {
            const float x0 = GT[(row0 + 2 * lane) * 32 + head] + dtb[head], x1 = GT[(row0 + 2 * lane + 1) * 32 + head] + dtb[head];
            const float dt0 = x0 > 20.f ? x0 : log1pf(expf(x0)), dt1 = x1 > 20.f ? x1 : log1pf(expf(x1));
            const float v0 = dt0 * a_neg, v1 = dt1 * a_neg, ps = v0 + v1; float inc = ps;
#pragma unroll
            for (int o = 1; o < 64; o <<= 1) { const float t = __shfl_up(inc, o); if (lane >= o) inc += t; }
            const float ac0 = inc - ps + v0, ac1 = inc, aend = __shfl(inc, 63);
            V[2 * lane] = dt0; V[2 * lane + 1] = dt1; V[128 + 2 * lane] = ac0 * 1.4426950408889634f; V[128 + 2 * lane + 1] = ac1 * 1.4426950408889634f;
            V[256 + 2 * lane] = dt0 * expf(aend - ac0); V[256 + 2 * lane + 1] = dt1 * expf(aend - ac1); V[384 + 2 * lane] = expf(ac0); V[384 + 2 * lane + 1] = expf(ac1);
            if (lane == 0) V[512] = expf(aend);
        }
        __syncthreads();
        if (c < 15) { const unsigned char* g0 = (const unsigned char*)(XBC + (row0 + 128) * PXBC);
#pragma unroll
            for (int q = 0; q < 4; ++q) { tb[q] = *(const u32x4*)(g0 + (size_t)q * (32 * PXBC * 2) + (1024 + g * 128) * 2 + sgo); tc[q] = *(const u32x4*)(g0 + (size_t)q * (32 * PXBC * 2) + (1280 + g * 128) * 2 + sgo);
                tx[q] = *(const u32x4*)(g0 + (size_t)q * (32 * PXBC * 2) + ((g * 8 + 2 * hp) * 64) * 2 + sgo); } }
        const MM_LAS unsigned char* cfp = L + LC + (32 * it + r32) * PB + 8 * hi * 2;
#define MM_CF(kn) (*(const MM_LAS bf16x8*)(cfp + 32 * (kn)))
        f32x16 yd[2]; yd[0] = f32x16{}; yd[1] = f32x16{};
#pragma unroll
        for (int pt = 0; pt < 2; ++pt)
#pragma unroll
            for (int kn = 0; kn < 8; ++kn) { const bf16x8 sf = *(const MM_LAS bf16x8*)(L + LS + hh * 64 * PS + (32 * pt + r32) * PS + (16 * kn + 8 * hi) * 2);
                yd[pt] = __builtin_amdgcn_mfma_f32_32x32x16_bf16(MM_CF(kn), sf, yd[pt], 0, 0, 0); }
#pragma unroll
        for (int jj = 0; jj < 4; ++jj) { const f32x4 ea = *(const MM_LAS f32x4*)(V + 384 + 32 * it + 8 * jj + 4 * hi);
#pragma unroll
            for (int e = 0; e < 4; ++e) { yd[0][4 * jj + e] *= ea[e]; yd[1][4 * jj + e] *= ea[e]; } }
        const float a2l = V[128 + 32 * it + r32];
        const MM_LAS unsigned char* xbase = L + LX + hh * 128 * PX + (4 * hi + q4) * PX + blk * 32 + 8 * p4;
        for (int j = 0; j <= it; ++j) {
            f32x16 X = {};
            unsigned cfo = (unsigned)((32 * it + r32) * PB + 16 * hi); asm volatile("" : "+v"(cfo));
#pragma unroll
            for (int kn = 0; kn < 8; ++kn) { const bf16x8 bfr = *(const MM_LAS bf16x8*)(L + LB + (32 * j + r32) * PB + (16 * kn + 8 * hi) * 2);
                X = __builtin_amdgcn_mfma_f32_32x32x16_bf16(bfr, *(const MM_LAS bf16x8*)(L + LC + cfo + 32 * kn), X, 0, 0, 0); }
#pragma unroll
            for (int jj = 0; jj < 4; ++jj) { const f32x4 a2s = *(const MM_LAS f32x4*)(V + 128 + 32 * j + 8 * jj + 4 * hi), dts = *(const MM_LAS f32x4*)(V + 32 * j + 8 * jj + 4 * hi);
#pragma unroll
                for (int e = 0; e < 4; ++e) { const int r = 4 * jj + e; const bool ok = (j < it) || (8 * jj + 4 * hi + e <= r32);
                    X[r] = ok ? X[r] * __builtin_amdgcn_exp2f(a2l - a2s[e]) * dts[e] : 0.f; } }
            u32x4 p0, p1;
            p0[0] = cvtpk(X[0], X[1]); p0[1] = cvtpk(X[2], X[3]); p0[2] = cvtpk(X[4], X[5]); p0[3] = cvtpk(X[6], X[7]);
            p1[0] = cvtpk(X[8], X[9]); p1[1] = cvtpk(X[10], X[11]); p1[2] = cvtpk(X[12], X[13]); p1[3] = cvtpk(X[14], X[15]);
            const bf16x8 pa0 = __builtin_bit_cast(bf16x8, p0), pa1 = __builtin_bit_cast(bf16x8, p1);
#pragma unroll
            for (int pt = 0; pt < 2; ++pt)
#pragma unroll
                for (int ks = 0; ks < 2; ++ks) { const bf16x8 xf = trfrag(xbase + (32 * j + 16 * ks) * PX + pt * 64, 8 * PX);
                    yd[pt] = __builtin_amdgcn_mfma_f32_32x32x16_bf16(ks == 0 ? pa0 : pa1, xf, yd[pt], 0, 0, 0); }
        }
        { const float eend = V[512];
#pragma unroll
          for (int r = 0; r < 16; ++r) { st[0][r] *= eend; st[1][r] *= eend; } }
        const MM_LAS unsigned char* bbase = L + LB + (4 * hi + q4) * PB + (32 * it + 16 * blk) * 2 + 8 * p4;
#pragma unroll
        for (int ks = 0; ks < 8; ++ks) {
            const bf16x8 bt = trfrag(bbase + 16 * ks * PB, 8 * PB);
            const f32x4 c0 = *(const MM_LAS f32x4*)(V + 256 + 16 * ks + 4 * hi), c1 = *(const MM_LAS f32x4*)(V + 256 + 16 * ks + 8 + 4 * hi);
            float f[8];
#pragma unroll
            for (int e = 0; e < 4; ++e) { f[e] = __uint_as_float((unsigned)(unsigned short)bt[e] << 16) * c0[e]; f[4 + e] = __uint_as_float((unsigned)(unsigned short)bt[4 + e] << 16) * c1[e]; }
            u32x4 pk; pk[0] = cvtpk(f[0], f[1]); pk[1] = cvtpk(f[2], f[3]); pk[2] = cvtpk(f[4], f[5]); pk[3] = cvtpk(f[6], f[7]);
            const bf16x8 af = __builtin_bit_cast(bf16x8, pk);
#pragma unroll
            for (int pt = 0; pt < 2; ++pt) { const bf16x8 xf = trfrag(xbase + 16 * ks * PX + pt * 64, 8 * PX); st[pt] = __builtin_amdgcn_mfma_f32_32x32x16_bf16(af, xf, st[pt], 0, 0, 0); }
        }
#pragma unroll
        for (int r = 0; r < 16; ++r) { const int l = 32 * it + crow(r, hi);
#pragma unroll
            for (int pt = 0; pt < 2; ++pt) { const float xv = __uint_as_float((unsigned)*(const MM_LAS unsigned short*)(L + LX + hh * 128 * PX + l * PX + (32 * pt + r32) * 2) << 16);
                const float y = yd[pt][r] + dskh * xv;
                XBC[(row0 + l) * PXBC + head * 64 + 32 * pt + r32] = (bf16)(cvtpk(y, 0.f) & 0xffffu); } }
        __syncthreads();
#pragma unroll
        for (int pt = 0; pt < 2; ++pt) {
#pragma unroll
            for (int jj = 0; jj < 4; ++jj) { u32x2 o; o[0] = cvtpk(st[pt][4 * jj], st[pt][4 * jj + 1]); o[1] = cvtpk(st[pt][4 * jj + 2], st[pt][4 * jj + 3]);
                *(MM_LAS u32x2*)(L + LS + hh * 64 * PS + (32 * pt + r32) * PS + (32 * it + 8 * jj + 4 * hi) * 2) = o; }
        }
    }
    __syncthreads();
}
#undef MM_CF
#undef MM_LAS
}
namespace mls {
using bf16x8 = __attribute__((ext_vector_type(8))) short;
using s16x4 = __attribute__((ext_vector_type(4))) short;
using f32x16 = __attribute__((ext_vector_type(16))) float;
using f32x4 = __attribute__((ext_vector_type(4))) float;
using u32x4 = __attribute__((ext_vector_type(4))) unsigned;
using u32x2 = __attribute__((ext_vector_type(2))) unsigned;
typedef short v4i16_t __attribute__((ext_vector_type(4)));
#define ML_LAS __attribute__((address_space(3)))
typedef unsigned short bf16;
constexpr int PD = 1024, TT = 2048;
constexpr int PK = 528, PV = 272;
constexpr int LK = 0, LVV = LK + 128 * PK, LG = LVV + 128 * PV, GSZ = 5 * 512, LN = LG + 2 * GSZ, LW = LN + 1024, LDS_NEED = LW + 8 * 256;
constexpr float LOG2E = 1.4426950408889634f;
__device__ __forceinline__ int crow(int r, int hi) { return (r & 3) + 8 * (r >> 2) + 4 * hi; }
__device__ __forceinline__ unsigned cvtpk(float lo, float hi) { typedef float f2 __attribute__((ext_vector_type(2))); typedef __bf16 b2 __attribute__((ext_vector_type(2))); f2 v = {lo, hi}; b2 b = __builtin_convertvector(v, b2); return __builtin_bit_cast(unsigned, b); }
__device__ __forceinline__ float bfx(short v) { return __uint_as_float((unsigned)(unsigned short)v << 16); }
__device__ __forceinline__ bf16x8 trfrag(const ML_LAS unsigned char* p, int rowpitch8) {
    const s16x4 lo = __builtin_bit_cast(s16x4, __builtin_amdgcn_ds_read_tr16_b64_v4i16((ML_LAS v4i16_t*)p));
    const s16x4 hi = __builtin_bit_cast(s16x4, __builtin_amdgcn_ds_read_tr16_b64_v4i16((ML_LAS v4i16_t*)(p + rowpitch8)));
    return (bf16x8){lo[0], lo[1], lo[2], lo[3], hi[0], hi[1], hi[2], hi[3]};
}
__device__ __forceinline__ void gate_vectors(ML_LAS float* gv, const float* GT, size_t row0, int h, float ibh, float fbh, float m_in, int lane) {
    const float* gb = GT + row0 * 32 + h; const unsigned go = (unsigned)lane * 64u;
    const float xi0 = gb[go + 16] + ibh, xi1 = gb[go + 48] + ibh;
    const float xf0 = gb[go + 20] + fbh, xf1 = gb[go + 52] + fbh;
    const float lf0 = xf0 > 0.f ? -log1pf(expf(-xf0)) : xf0 - log1pf(expf(xf0)), lf1 = xf1 > 0.f ? -log1pf(expf(-xf1)) : xf1 - log1pf(expf(xf1));
    const float ps = lf0 + lf1; float inc = ps;
#pragma unroll
    for (int o = 1; o < 64; o <<= 1) { const float t = __shfl_up(inc, o); if (lane >= o) inc += t; }
    const float bc0 = inc - ps + lf0, bc1 = inc, g0 = xi0 - bc0, g1 = xi1 - bc1;
    float pmx = fmaxf(g0, g1);
#pragma unroll
    for (int o = 1; o < 64; o <<= 1) { const float t = __shfl_up(pmx, o); if (lane >= o) pmx = fmaxf(pmx, t); }
    float pex = __shfl_up(pmx, 1); if (lane == 0) pex = -INFINITY;
    const float gtot0 = __shfl(inc, 63), pm127 = __shfl(pmx, 63), mm0 = fmaxf(m_in, pm127);
    gv[2 * lane] = g0 * LOG2E; gv[2 * lane + 1] = g1 * LOG2E; gv[128 + 2 * lane] = fmaxf(pex, g0); gv[128 + 2 * lane + 1] = pmx; gv[256 + 2 * lane] = bc0; gv[256 + 2 * lane + 1] = bc1;
    gv[384 + 2 * lane] = expf(g0 - mm0); gv[384 + 2 * lane + 1] = expf(g1 - mm0);
    if (lane == 0) { gv[512] = gtot0; gv[513] = pm127; }
}
__device__ __forceinline__ void unit(const bf16* Qg, const bf16* Kg, bf16* Vg, bf16* CS, const float* GT, const float* ib, const float* fb, int b, int h, int vh, ML_LAS unsigned char* L, int tid) {
    const int lane = tid & 63, r32 = lane & 31, hi = lane >> 5; const int w = __builtin_amdgcn_readfirstlane(tid >> 6);
    const int q4 = (lane & 15) >> 2, p4 = lane & 3, blk = (lane >> 4) & 1;
    ML_LAS float* NV = (ML_LAS float*)(L + LN); ML_LAS float* WS = (ML_LAS float*)(L + LW + w * 256);
    float m_in = 0.f;
    if (tid < 256) NV[tid] = 0.f;
    if (w < 4) {
        const int lt = w, l = 32 * lt + r32;
        const float ibh = ib[h], fbh = fb[h];
        if (w == 0) gate_vectors((ML_LAS float*)(L + LG), GT, (size_t)b * TT, h, ibh, fbh, 0.f, lane);
        for (int c = 0; c < 16; ++c) {
            const size_t row0 = (size_t)b * TT + c * 128;
            ML_LAS float* G2 = (ML_LAS float*)(L + LG + (c & 1) * GSZ); ML_LAS float* PM = G2 + 128; ML_LAS float* BC = G2 + 256; ML_LAS float* SCL = G2 + 512;
            __syncthreads();
            const bf16* qp = Qg + (row0 + l) * PD + h * 256 + 8 * hi;
            f32x16 num[4]; num[0] = f32x16{}; num[1] = f32x16{}; num[2] = f32x16{}; num[3] = f32x16{};
            float qn = 0.f;
            if (c > 0) {
                const bf16* cp = CS + (size_t)r32 * 256 + 8 * hi;
#pragma unroll 4
                for (int kk = 0; kk < 16; ++kk) {
                    const bf16x8 q8 = *(const bf16x8*)(qp + 16 * kk);
                    const f32x4 n0 = *(const ML_LAS f32x4*)(NV + 16 * kk + 8 * hi), n1 = *(const ML_LAS f32x4*)(NV + 16 * kk + 8 * hi + 4);
#pragma unroll
                    for (int e = 0; e < 4; ++e) { qn += bfx(q8[e]) * n0[e]; qn += bfx(q8[4 + e]) * n1[e]; }
#pragma unroll
                    for (int vt = 0; vt < 4; ++vt) { const bf16x8 cs = *(const bf16x8*)(cp + (size_t)vt * 32 * 256 + 16 * kk); num[vt] = __builtin_amdgcn_mfma_f32_32x32x16_bf16(q8, cs, num[vt], 0, 0, 0); }
                }
                qn += __shfl_xor(qn, 32);
            }
            asm volatile("" ::: "memory");
            bf16x8 qf[16];
#pragma unroll
            for (int kk = 0; kk < 16; ++kk) qf[kk] = *(const bf16x8*)(qp + 16 * kk);
            __syncthreads();
            const float gtot = SCL[0], mm = fmaxf(m_in, SCL[1]);
            const float ml = fmaxf(PM[l], m_in), ei = expf(m_in - ml), ml2 = ml * LOG2E;
            if (hi == 0) WS[r32] = ei;
            asm volatile("s_waitcnt lgkmcnt(0)" ::: "memory");
#pragma unroll
            for (int jj = 0; jj < 4; ++jj) { const f32x4 f = *(const ML_LAS f32x4*)(WS + 8 * jj + 4 * hi);
#pragma unroll
                for (int e = 0; e < 4; ++e) { num[0][4 * jj + e] *= f[e]; num[1][4 * jj + e] *= f[e]; num[2][4 * jj + e] *= f[e]; num[3][4 * jj + e] *= f[e]; } }
            float dsum = 0.f;
            const ML_LAS unsigned char* vbase = L + LVV + (4 * hi + q4) * PV + blk * 32 + 8 * p4;
            for (int j = 0; j <= lt; ++j) {
                f32x16 S = {};
#pragma unroll
                for (int kk = 0; kk < 16; ++kk) { const bf16x8 kf = *(const ML_LAS bf16x8*)(L + LK + (32 * j + r32) * PK + (16 * kk + 8 * hi) * 2);
                    S = __builtin_amdgcn_mfma_f32_32x32x16_bf16(kf, qf[kk], S, 0, 0, 0);
                    if ((kk & 3) == 3) asm volatile("" ::: "memory"); }
#pragma unroll
                for (int jj = 0; jj < 4; ++jj) { const f32x4 g2 = *(const ML_LAS f32x4*)(G2 + 32 * j + 8 * jj + 4 * hi);
#pragma unroll
                    for (int e = 0; e < 4; ++e) { const int r = 4 * jj + e; const bool ok = (j < lt) || (8 * jj + 4 * hi + e <= r32);
                        S[r] = ok ? S[r] * __builtin_amdgcn_exp2f(g2[e] - ml2) : 0.f; dsum += S[r]; } }
                u32x4 p0, p1;
                p0[0] = cvtpk(S[0], S[1]); p0[1] = cvtpk(S[2], S[3]); p0[2] = cvtpk(S[4], S[5]); p0[3] = cvtpk(S[6], S[7]);
                p1[0] = cvtpk(S[8], S[9]); p1[1] = cvtpk(S[10], S[11]); p1[2] = cvtpk(S[12], S[13]); p1[3] = cvtpk(S[14], S[15]);
                const bf16x8 pa0 = __builtin_bit_cast(bf16x8, p0), pa1 = __builtin_bit_cast(bf16x8, p1);
#pragma unroll
                for (int vt = 0; vt < 4; ++vt)
#pragma unroll
                    for (int ks = 0; ks < 2; ++ks) { const bf16x8 vf = trfrag(vbase + (32 * j + 16 * ks) * PV + vt * 64, 8 * PV);
                        num[vt] = __builtin_amdgcn_mfma_f32_32x32x16_bf16(ks == 0 ? pa0 : pa1, vf, num[vt], 0, 0, 0); }
            }
            { const float dtot = dsum + __shfl_xor(dsum, 32); const float den = dtot + ei * qn; const float mo = BC[l] + ml;
              const float dn = fmaxf(fabsf(den), expf(-mo));
              if (hi == 0) WS[32 + r32] = 1.f / dn; }
            asm volatile("s_waitcnt lgkmcnt(0)" ::: "memory");
#pragma unroll
            for (int jj = 0; jj < 4; ++jj) { const f32x4 f = *(const ML_LAS f32x4*)(WS + 32 + 8 * jj + 4 * hi);
#pragma unroll
                for (int e = 0; e < 4; ++e) { const int r = 4 * jj + e; bf16* ob = Vg + (row0 + 32 * lt) * PD + h * 256 + vh * 128; const unsigned oo = (unsigned)(8 * jj + 4 * hi + e) * PD + (unsigned)r32;
#pragma unroll
                    for (int vt = 0; vt < 4; ++vt) ob[oo + 32 * vt] = (bf16)(cvtpk(num[vt][r] * f[e], 0.f) & 0xffffu); } }
            m_in = gtot + mm;
            if (w == 0 && c < 15) gate_vectors((ML_LAS float*)(L + LG + ((c + 1) & 1) * GSZ), GT, row0 + 128, h, ibh, fbh, m_in, lane);
            __syncthreads();
        }
    } else {
        const int sw = w - 4, t2 = tid - 256;
        f32x16 acc[2][4];
#pragma unroll
        for (int kt = 0; kt < 2; ++kt)
#pragma unroll
            for (int vt = 0; vt < 4; ++vt) acc[kt][vt] = f32x16{};
        float nreg[2] = {0.f, 0.f};
        for (int c = 0; c < 16; ++c) {
            const size_t row0 = (size_t)b * TT + c * 128;
            ML_LAS float* CF = (ML_LAS float*)(L + LG + (c & 1) * GSZ) + 384; ML_LAS float* SCL = CF + 128;
            __syncthreads();
            {
              const unsigned char* kb = (const unsigned char*)(Kg + row0 * PD + h * 256); const unsigned char* vb = (const unsigned char*)(Vg + row0 * PD + h * 256 + vh * 128);
              const unsigned kvo = (unsigned)(t2 >> 5) * (PD * 2) + (unsigned)(t2 & 31) * 16, vvo = (unsigned)(t2 >> 4) * (PD * 2) + (unsigned)(t2 & 15) * 16;
              const unsigned klo = (unsigned)(t2 >> 5) * PK + (unsigned)(t2 & 31) * 16, vlo = (unsigned)(t2 >> 4) * PV + (unsigned)(t2 & 15) * 16;
              u32x4 t[12];
#pragma unroll
              for (int q = 0; q < 12; ++q) t[q] = *(const u32x4*)(kb + (size_t)q * (8 * PD * 2) + kvo);
#pragma unroll
              for (int q = 0; q < 12; ++q) *(ML_LAS u32x4*)(L + LK + q * (8 * PK) + klo) = t[q];
#pragma unroll
              for (int q = 0; q < 4; ++q) t[q] = *(const u32x4*)(kb + (size_t)(12 + q) * (8 * PD * 2) + kvo);
#pragma unroll
              for (int q = 0; q < 8; ++q) t[4 + q] = *(const u32x4*)(vb + (size_t)q * (16 * PD * 2) + vvo);
#pragma unroll
              for (int q = 0; q < 4; ++q) *(ML_LAS u32x4*)(L + LK + (12 + q) * (8 * PK) + klo) = t[q];
#pragma unroll
              for (int q = 0; q < 8; ++q) *(ML_LAS u32x4*)(L + LVV + q * (16 * PV) + vlo) = t[4 + q]; }
            __syncthreads();
            const float gtot = SCL[0], mm = fmaxf(m_in, SCL[1]), d_old = expf(m_in - mm);
#pragma unroll
            for (int kt = 0; kt < 2; ++kt)
#pragma unroll
                for (int vt = 0; vt < 4; ++vt)
#pragma unroll
                    for (int r = 0; r < 16; ++r) acc[kt][vt][r] *= d_old;
            const ML_LAS unsigned char* kbase = L + LK + (4 * hi + q4) * PK + (64 * sw + 16 * blk) * 2 + 8 * p4;
            const ML_LAS unsigned char* vb4 = L + LVV + (4 * hi + q4) * PV + blk * 32 + 8 * p4;
            float nacc[2] = {0.f, 0.f};
#pragma unroll 2
            for (int ks = 0; ks < 8; ++ks) {
                const f32x4 c0 = *(const ML_LAS f32x4*)(CF + 16 * ks + 4 * hi), c1 = *(const ML_LAS f32x4*)(CF + 16 * ks + 8 + 4 * hi);
                bf16x8 af[2];
#pragma unroll
                for (int kt = 0; kt < 2; ++kt) { const bf16x8 ktf = trfrag(kbase + 16 * ks * PK + kt * 64, 8 * PK);
                    float f[8];
#pragma unroll
                    for (int e = 0; e < 4; ++e) { f[e] = bfx(ktf[e]) * c0[e]; f[4 + e] = bfx(ktf[4 + e]) * c1[e]; }
                    nacc[kt] += ((f[0] + f[1]) + (f[2] + f[3])) + ((f[4] + f[5]) + (f[6] + f[7]));
                    u32x4 pk; pk[0] = cvtpk(f[0], f[1]); pk[1] = cvtpk(f[2], f[3]); pk[2] = cvtpk(f[4], f[5]); pk[3] = cvtpk(f[6], f[7]);
                    af[kt] = __builtin_bit_cast(bf16x8, pk); }
#pragma unroll
                for (int vt = 0; vt < 4; ++vt) { const bf16x8 vf = trfrag(vb4 + 16 * ks * PV + vt * 64, 8 * PV);
                    acc[0][vt] = __builtin_amdgcn_mfma_f32_32x32x16_bf16(af[0], vf, acc[0][vt], 0, 0, 0); acc[1][vt] = __builtin_amdgcn_mfma_f32_32x32x16_bf16(af[1], vf, acc[1][vt], 0, 0, 0); }
            }
            nacc[0] += __shfl_xor(nacc[0], 32); nacc[1] += __shfl_xor(nacc[1], 32);
            nreg[0] = d_old * nreg[0] + nacc[0]; nreg[1] = d_old * nreg[1] + nacc[1];
            __syncthreads();
#pragma unroll
            for (int kt = 0; kt < 2; ++kt)
#pragma unroll
                for (int vt = 0; vt < 4; ++vt)
#pragma unroll
                    for (int jj = 0; jj < 4; ++jj) { u32x2 o; o[0] = cvtpk(acc[kt][vt][4 * jj], acc[kt][vt][4 * jj + 1]); o[1] = cvtpk(acc[kt][vt][4 * jj + 2], acc[kt][vt][4 * jj + 3]);
                        *(u32x2*)(CS + (size_t)(32 * vt + r32) * 256 + 64 * sw + 32 * kt + 8 * jj + 4 * hi) = o; }
            if (hi == 0) { NV[64 * sw + r32] = nreg[0]; NV[64 * sw + 32 + r32] = nreg[1]; }
            m_in = gtot + mm;
        }
    }
    __syncthreads();
}
#undef ML_LAS
}
__device__ __forceinline__ void mamba_naive_unit(LAS unsigned char* L, const bf16* XBC, const float* GT, bf16* YM, const float* cw, const float* cb, const float* dtb, const float* alog, const float* dsk, int b, int g, int tid) {
    LAS float* BC = (LAS float*)L;
    LAS float* DT = (LAS float*)(L + 8192);
    const int hl = tid >> 6, p = tid & 63, head = g * 8 + hl, colx = head * 64 + p;
    const float w0 = cw[colx], w1 = cw[1536 + colx], w2 = cw[2 * 1536 + colx], w3 = cw[3 * 1536 + colx], bb = cb[colx];
    float h0 = 0.f, h1 = 0.f, h2 = 0.f;
    const int colbc = 1024 + ((tid & 255) < 128 ? g * 128 + (tid & 255) : 256 + g * 128 + ((tid & 255) - 128));
    const float v0 = cw[colbc], v1 = cw[1536 + colbc], v2 = cw[2 * 1536 + colbc], v3 = cw[3 * 1536 + colbc], vb = cb[colbc];
    float g0 = 0.f, g1 = 0.f, g2 = 0.f;
    const float dskh = dsk[head];
    float S[128];
#pragma unroll
    for (int n = 0; n < 128; ++n) S[n] = 0.f;
    for (int t0 = 0; t0 < T; t0 += 8) {
        if (tid < 256) {
#pragma unroll
            for (int s = 0; s < 8; ++s) { const float raw = bf2f(XBC[((size_t)b * T + t0 + s) * 1536 + colbc]); const float v = v0 * g0 + v1 * g1 + v2 * g2 + v3 * raw + vb; g0 = g1; g1 = g2; g2 = raw; BC[s * 256 + tid] = silu_g(v); }
        } else if (tid < 320) {
            const int s = (tid - 256) >> 3, hh = (tid - 256) & 7, hd2 = g * 8 + hh;
            const float x = GT[((size_t)b * T + t0 + s) * 32 + hd2] + dtb[hd2]; const float dt = x > 20.f ? x : log1pf(expf(x));
            DT[s * 8 + hh] = dt; DT[64 + s * 8 + hh] = expf(-dt * expf(alog[hd2]));
        }
        __syncthreads();
#pragma unroll 1
        for (int s = 0; s < 8; ++s) {
            const size_t row = (size_t)b * T + t0 + s;
            const float raw = bf2f(XBC[row * 1536 + colx]); const float v = w0 * h0 + w1 * h1 + w2 * h2 + w3 * raw + bb; h0 = h1; h1 = h2; h2 = raw;
            const float xv = silu_g(v), dt = DT[s * 8 + hl], dA = DT[64 + s * 8 + hl], coef = dt * xv;
            float acc = 0.f;
#pragma unroll
            for (int n4 = 0; n4 < 32; ++n4) { const f32x4 Bv = *(const LAS f32x4*)(BC + s * 256 + 4 * n4), Cv = *(const LAS f32x4*)(BC + s * 256 + 128 + 4 * n4);
#pragma unroll
                for (int j = 0; j < 4; ++j) { S[4 * n4 + j] = dA * S[4 * n4 + j] + coef * Bv[j]; acc += Cv[j] * S[4 * n4 + j]; } }
            YM[row * D + colx] = (bf16)f2bf(acc + dskh * xv);
        }
        __syncthreads();
    }
}
__device__ __forceinline__ void mlstm_naive_unit(LAS unsigned char* L, const bf16* U, bf16* V, const float* GT, const float* cw, const float* cb, const float* wq, const float* wk, const float* ib, const float* fb, int b, int h, int vh, int tid) {
    LAS float* UC = (LAS float*)L;
    LAS float* Q8 = (LAS float*)(L + 8192);
    LAS float* K8 = (LAS float*)(L + 8192 + 8704);
    LAS float* IF = (LAS float*)(L + 8192 + 2 * 8704);
    const int vl = tid >> 2, kq = tid & 3, colv = h * 256 + vh * 128 + vl;
    const int ju = tid & 255, colu = h * 256 + ju;
    const float w0 = cw[colu], w1 = cw[1024 + colu], w2 = cw[2048 + colu], w3 = cw[3072 + colu], bu = cb[colu];
    float h0 = 0.f, h1 = 0.f, h2 = 0.f;
    float wqv[4], wkv[4];
    { const int nblk = h * 64 + (ju >> 2), i = ju & 3;
#pragma unroll
      for (int jj = 0; jj < 4; ++jj) { wqv[jj] = wq[(nblk * 4 + jj) * 4 + i]; wkv[jj] = wk[(nblk * 4 + jj) * 4 + i] * 0.0625f; } }
    float C[64], N[64];
#pragma unroll
    for (int j = 0; j < 64; ++j) { C[j] = 0.f; N[j] = 0.f; }
    const float ibh = ib[h], fbh = fb[h];
    for (int t0 = 0; t0 < T; t0 += 8) {
        if (tid < 256) {
#pragma unroll
            for (int s = 0; s < 8; ++s) { const float raw = bf2f(U[((size_t)b * T + t0 + s) * D + colu]); const float v = w0 * h0 + w1 * h1 + w2 * h2 + w3 * raw + bu; h0 = h1; h1 = h2; h2 = raw; UC[s * 256 + tid] = silu_g(v); }
        } else if (tid < 264) {
            const int s = tid - 256; const size_t row = (size_t)b * T + t0 + s;
            IF[2 * s] = expf(GT[row * 32 + 16 + h] + ibh); IF[2 * s + 1] = sigm_g(GT[row * 32 + 20 + h] + fbh);
        }
        __syncthreads();
        if (tid < 256) {
#pragma unroll
            for (int s = 0; s < 8; ++s) { const f32x4 u4 = *(const LAS f32x4*)(UC + s * 256 + (tid & ~3));
                const float qv = u4[0] * wqv[0] + u4[1] * wqv[1] + u4[2] * wqv[2] + u4[3] * wqv[3], kv = u4[0] * wkv[0] + u4[1] * wkv[1] + u4[2] * wkv[2] + u4[3] * wkv[3];
                Q8[s * 272 + (tid >> 6) * 68 + (tid & 63)] = qv; K8[s * 272 + (tid >> 6) * 68 + (tid & 63)] = kv; }
        }
        __syncthreads();
#pragma unroll 1
        for (int s = 0; s < 8; ++s) {
            const size_t row = (size_t)b * T + t0 + s;
            const float vt = bf2f(V[row * D + colv]), ig = IF[2 * s], f = IF[2 * s + 1], iv = ig * vt;
            float num = 0.f, den = 0.f;
#pragma unroll
            for (int j4 = 0; j4 < 16; ++j4) { const f32x4 kv = *(const LAS f32x4*)(K8 + s * 272 + kq * 68 + 4 * j4), qv = *(const LAS f32x4*)(Q8 + s * 272 + kq * 68 + 4 * j4);
#pragma unroll
                for (int j = 0; j < 4; ++j) { C[4 * j4 + j] = f * C[4 * j4 + j] + iv * kv[j]; N[4 * j4 + j] = f * N[4 * j4 + j] + ig * kv[j]; num += C[4 * j4 + j] * qv[j]; den += N[4 * j4 + j] * qv[j]; } }
            num += __shfl_xor(num, 1); num += __shfl_xor(num, 2); den += __shfl_xor(den, 1); den += __shfl_xor(den, 2);
            const float hv = num / fmaxf(fabsf(den), 1.f);
            if (kq == 0) V[row * D + colv] = (bf16)f2bf(hv);
        }
        __syncthreads();
    }
}
__device__ __forceinline__ void gate_row(const bf16* YM, int ymp, const bf16* Z, const bf16* HD, const bf16* OP, bf16* YCD, const float* cnw, const float* dnw, size_t row, int lane) {
    float y[16], z[16];
    ld8f(YM + row * ymp + lane * 16, y); ld8f(YM + row * ymp + lane * 16 + 8, y + 8); ld8f(Z + row * D + lane * 16, z); ld8f(Z + row * D + lane * 16 + 8, z + 8);
    float ss = 0.f;
#pragma unroll
    for (int e = 0; e < 16; ++e) { y[e] = y[e] * silu_g(z[e]); ss += y[e] * y[e]; }
    ss = wave_sum(ss); float rstd = 1.f / sqrtf(ss * (1.f / 1024.f) + RMS_EPS);
#pragma unroll
    for (int e = 0; e < 16; ++e) y[e] = y[e] * rstd * cnw[lane * 16 + e];
    st8f(YCD + row * KCD + lane * 16, y); st8f(YCD + row * KCD + lane * 16 + 8, y + 8);
    ld8f(HD + row * D + lane * 16, y); ld8f(HD + row * D + lane * 16 + 8, y + 8); ld8f(OP + row * D + lane * 16, z); ld8f(OP + row * D + lane * 16 + 8, z + 8);
    ss = 0.f;
#pragma unroll
    for (int e = 0; e < 16; ++e) ss += y[e] * y[e];
    ss += __shfl_xor(ss, 1); ss += __shfl_xor(ss, 2); ss += __shfl_xor(ss, 4); ss += __shfl_xor(ss, 8);
    rstd = 1.f / sqrtf(ss * (1.f / 256.f) + RMS_EPS);
#pragma unroll
    for (int e = 0; e < 16; ++e) y[e] = sigm_g(z[e]) * y[e] * rstd * dnw[lane * 16 + e];
    st8f(YCD + row * KCD + 1024 + lane * 16, y); st8f(YCD + row * KCD + 1024 + lane * 16 + 8, y + 8);
}

struct Args { const float* in[28]; float* out; unsigned char* ws; int ph_lo, ph_hi, li, pad; };
__global__ void __launch_bounds__(NWAVES * 64, 2) fwd_kernel(Args args) {
    extern __shared__ __attribute__((aligned(16))) unsigned char lds[];
    LAS unsigned char* L = (LAS unsigned char*)lds;
    volatile LAS unsigned* MISC = (volatile LAS unsigned*)(L + MISC_OFF);
    const int tid = threadIdx.x, lane = tid & 63, wave = __builtin_amdgcn_readfirstlane(tid >> 6);
    const int G = gridDim.x, bx = blockIdx.x; const int vcu = (G % 8 == 0) ? (bx % 8) * (G / 8) + bx / 8 : bx;
    const int gw = vcu * NWAVES + wave, NGW = G * NWAVES;
    unsigned char* ws = args.ws;
    gu32* ctl = (gu32*)(ws + WS_CTL);
    for (int u = tid; u < (LDS_BYTES - LDSCTL_OFF) / 4; u += NWAVES * 64) ((LAS unsigned*)(L + LDSCTL_OFF))[u] = 0u;
    __syncthreads();
    XcdBarrier bar; bar.bar = (unsigned*)(ctl + CW_BAR) + args.li * XCD_BAR_WORDS; bar.x = 0; bar.st = nullptr;
    if (MK_ONE_LAUNCH) bar = xcd_barrier_post((unsigned*)(ctl + CW_BAR) + args.li * XCD_BAR_WORDS, MISC + 8);
    const int lo = args.ph_lo, hi = args.ph_hi;
#define IN(k) (lo <= (k) && (k) < hi)
#define SEAM(k) do { if (MK_ONE_LAUNCH && IN(k) && IN((k) + 1)) xcd_barrier(bar); } while (0)
    float* out = args.out;
#define XIN (args.in[0])
#define W_ABIN ((bf16*)(ws + WS_W_ABIN))
#define W_ABOUT ((bf16*)(ws + WS_W_ABOUT))
#define W_GU0 ((bf16*)(ws + WS_W_GU0))
#define W_DN0 ((bf16*)(ws + WS_W_DN0))
#define W_CDIN ((bf16*)(ws + WS_W_CDIN))
#define W_CDOUT ((bf16*)(ws + WS_W_CDOUT))
#define W_GU1 ((bf16*)(ws + WS_W_GU1))
#define W_DN1 ((bf16*)(ws + WS_W_DN1))
#define XN ((bf16*)(ws + WS_XN))
#define OB ((bf16*)(ws + WS_OB))
#define QKV ((bf16*)(ws + WS_QKV))
#define ACT ((bf16*)(ws + WS_ACT))
#define ZB ((bf16*)(ws + WS_Z))
#define XBC ((bf16*)(ws + WS_XBC))
#define UB ((bf16*)(ws + WS_U))
#define VB ((bf16*)(ws + WS_V))
#define OPB ((bf16*)(ws + WS_O))
#define YCD ((bf16*)(ws + WS_YCD))
#define GT ((float*)((unsigned char*)args.out + DO_GATES))
#define HB ((bf16*)(ws + WS_HB))
#define WDQ ((float*)(ws + WS_WDQ))
    constexpr int CM_DN1 = 2 * NGU + 5696, WQ_DN1 = 2 * NGU + NZX;
#define PSUM ((float*)(ws + WS_RSS))
#define RED ((LAS float*)(L + RING_OFF + RING_BYTES + 8192))

    if (IN(0)) for (int rep = 0; rep < 1; ++rep) {
        LAS float* scr = (LAS float*)(L + RING_OFF + wave * 16384);
        constexpr int I0 = 16 * 96, I1 = 16 * 32, I2 = 16 * 176, I3 = 44 * 32, I4 = 16 * 184, I5 = 32 * 32;
        constexpr int NITEMS = I0 + I1 + I3 + I5;
        for (int it = gw; it < NITEMS; it += NGW) {
            int r = it;
            if (r < I0) { tr_item<0>(args.in[3], D, NQKV, W_ABIN, NQKV / 32, scr, r, lane); continue; } r -= I0;
            if (r < I1) { tr_item<0>(args.in[4], D, D, W_ABOUT, D / 32, scr, r, lane); continue; } r -= I1;

            if (r < I3) { tr_item<0>(args.in[26], FF, D, W_DN0, D / 32, scr, r, lane); continue; } r -= I3;

            if (r < I5) { tr_item<0>(args.in[24], KCD, D, W_CDOUT, D / 32, scr, r, lane); continue; } r -= I5;


        }
        for (int blk = gw; blk < 2 * 16 * 88; blk += NGW) {
            const int l = blk / (16 * 88), r2 = blk % (16 * 88), kb = r2 / 88, nb = r2 % 88; const float* wp = args.in[25] + (size_t)l * D * NGU + (size_t)(64 * kb) * NGU + 64 * nb + lane; float am = 0.f;
#pragma unroll 8
            for (int kk = 0; kk < 64; ++kk) am = fmaxf(am, fabsf(wp[(size_t)kk * NGU]));
            __hip_atomic_fetch_max((unsigned*)(ctl + CW_CMAX) + l * NGU + 64 * nb + lane, __float_as_uint(am), __ATOMIC_RELAXED, __HIP_MEMORY_SCOPE_AGENT); }
        for (int blk = gw; blk < 44 * 16; blk += NGW) {
            const int kb = blk / 16, nb = blk % 16; const float* wp = args.in[26] + (size_t)FF * D + (size_t)(64 * kb) * D + 64 * nb + lane; float am = 0.f;
#pragma unroll 1
            for (int g4 = 0; g4 < 4; ++g4) { float v[16];
#pragma unroll
                for (int j = 0; j < 16; ++j) v[j] = wp[(size_t)(16 * g4 + j) * D];
                wht16(v);
#pragma unroll
                for (int j = 0; j < 16; ++j) am = fmaxf(am, fabsf(v[j])); }
            __hip_atomic_fetch_max((unsigned*)(ctl + CW_CMAX) + CM_DN1 + 64 * nb + lane, __float_as_uint(am * 0.25f), __ATOMIC_RELAXED, __HIP_MEMORY_SCOPE_AGENT); }
        for (int blk = gw; blk < 16 * 89; blk += NGW) {
            const int kb = blk / 89, nb = blk % 89, col = 64 * nb + lane; float am = 0.f;
            if (col < NZX_SRC) { const float* wp = args.in[10] + (size_t)(64 * kb) * NZX_SRC + col;
#pragma unroll 8
                for (int kk = 0; kk < 64; ++kk) am = fmaxf(am, fabsf(wp[(size_t)kk * NZX_SRC]));
                __hip_atomic_fetch_max((unsigned*)(ctl + CW_CMAX) + 2 * NGU + col, __float_as_uint(am), __ATOMIC_RELAXED, __HIP_MEMORY_SCOPE_AGENT); } }
        for (int m = gw; m < M; m += NGW) rms_row_to_bf16(XIN + (size_t)m * D, args.in[1], XN + (size_t)m * D, lane);
    }
    SEAM(0);
    if (IN(1)) {
        pg8::Gemm g{XN, W_ABIN, M, NQKV, D, nullptr, nullptr}; pg8::StaticOrder S; S.init(M, NQKV, G, bx);
        pg8::EpiQKV E{QKV, NQKV, 0, 2, 6, 8, attn_body::C2};
        pg8::gemm_phase<pg8::EpiQKV, pg8::StaticOrder, true, true>(L + RING_OFF, g, S, E);
        if (PROBE_G) pg8::gemm_phase<pg8::EpiQKV, pg8::StaticOrder, true, true>(L + RING_OFF, g, S, E);
    }
    SEAM(1);
    if (IN(2)) for (int rep = 0; rep < (PROBE_T ? 2 : 1); ++rep) {
        bf16* Y = XN;
        { const attn_body::AttnTensors AT{(const attn_body::bf16*)QKV, (const attn_body::bf16*)QKV, (const attn_body::bf16*)QKV, (attn_body::bf16*)OB}; const attn_body::StaticOrder S((int)G, (int)blockIdx.x);
          attn_body::attn_phase<attn_body::StaticOrder>((char*)lds + RING_OFF, AT, S); }
        static_assert(mixa::LDS_NEED <= RING_BYTES, "mixer A LDS");
        int tid2 = tid, vcu2 = vcu; asm volatile("" : "+v"(tid2), "+s"(vcu2));
        for (int u = vcu2; u < NBATCH * 8; u += G) {
#pragma unroll 1
            for (int tb = 0; tb < 8; ++tb) mixa::unit(QKV, Y, u >> 3, u & 7, tb * 256, L + RING_OFF, tid2);
        }
    }
    SEAM(2);
    if (IN(3)) for (int rep = 0; rep < (PROBE_T ? 2 : 1); ++rep) {
        bf16* Y = XN;
        const float s1 = wave_sum(args.in[5][lane] * args.in[6][lane]), s2 = wave_sum(args.in[7][lane] * args.in[8][lane]);
        const float lam = expf(s1) - expf(s2) + 0.2f;
        for (int m = gw; m < M; m += NGW) attnB_post_row(OB, Y, args.in[9], lam, 0.8f, (size_t)m, lane);
        { LAS float* scr = (LAS float*)(L + RING_OFF + wave * 16384);
          for (int it = gw; it < 16 * 176; it += NGW) tr_item_i8<1>(args.in[25], D, NGU, (unsigned char*)W_GU0, NGU / 32, scr, it, lane, (const unsigned*)(ctl + CW_CMAX), WDQ);
          for (int it = gw; it < 16 * 176; it += NGW) tr_item_i8<1>(args.in[25] + (size_t)D * NGU, D, NGU, (unsigned char*)W_GU1, NGU / 32, scr, it, lane, (const unsigned*)(ctl + CW_CMAX) + NGU, WDQ + NGU);
          for (int it = gw; it < 16 * 184; it += NGW) tr_item_i8<2>(args.in[10], D, NZX_SRC, (unsigned char*)W_CDIN, NZX / 32, scr, it, lane, (const unsigned*)(ctl + CW_CMAX) + 2 * NGU, WDQ + 2 * NGU);
          for (int it = gw; it < 44 * 32; it += NGW) tr_item_i8rot(args.in[26] + (size_t)FF * D, FF, D, (unsigned char*)W_DN1, D / 32, scr, it, lane, (const unsigned*)(ctl + CW_CMAX) + CM_DN1, WDQ + WQ_DN1); }
    }
    SEAM(3);
    if (IN(4)) {
        pg8::Gemm g{XN, W_ABOUT, M, D, D, nullptr, nullptr}; pg8::StaticOrder S; S.init(M, D, G, bx);
        pg8::EpiResidBf<true, false, false> E{XIN, HB, D, nullptr, nullptr};
        pg8::gemm_phase<pg8::EpiResidBf<true, false, false>, pg8::StaticOrder, true, true>(L + RING_OFF, g, S, E);
    }
    SEAM(4);
    if (IN(5)) { for (int m = gw; m < M; m += NGW) rms_row_i8(HB + (size_t)m * D, args.in[2], (unsigned char*)XN + (size_t)m * D, PSUM + (size_t)m * 4, lane); }
    SEAM(5);
    if (IN(6)) {
        pg8::Gemm g{XN, W_GU0, M, NGU, D / 2, PSUM, WDQ};   pg8::StaticOrder S; S.init(M, NGU, G, bx);
        pg8::EpiSwiglu<false, 2> E{(unsigned char*)ACT, FF, 0.f};
        pg8::gemm_phase<pg8::EpiSwiglu<false, 2>, pg8::StaticOrder, true, true>(L + RING_OFF, g, S, E);
        if (PROBE_G) pg8::gemm_phase<pg8::EpiSwiglu<false, 2>, pg8::StaticOrder, true, true>(L + RING_OFF, g, S, E);
    }
    SEAM(6);
    if (IN(7)) {
        pg8::Gemm g{ACT, W_DN0, M, D, FF, nullptr, nullptr}; pg8::StaticOrder S; S.init(M, D, G, bx);
        pg8::EpiResidBf<false, false, false> E{nullptr, HB, D, nullptr, nullptr};
        pg8::gemm_phase<pg8::EpiResidBf<false, false, false>, pg8::StaticOrder, true, true>(L + RING_OFF, g, S, E);
    }
    SEAM(7);
    if (IN(8)) { for (int m = gw; m < M; m += NGW) rms_row_i8(HB + (size_t)m * D, args.in[1] + D, (unsigned char*)XN + (size_t)m * D, PSUM + (size_t)m * 4, lane); }
    SEAM(8);
    if (IN(9)) {
        pg8::Gemm g{XN, W_CDIN, M, NZX, D / 2, PSUM, WDQ + 2 * NGU};   pg8::StaticOrder S; S.init(M, NZX, G, bx);
        pg8::EpiZX<2> E{ZB, XBC, UB, VB, OPB, GT};
        pg8::gemm_phase<pg8::EpiZX<2>, pg8::StaticOrder, true, true>(L + RING_OFF, g, S, E);
        if (PROBE_G) pg8::gemm_phase<pg8::EpiZX<2>, pg8::StaticOrder, true, true>(L + RING_OFF, g, S, E);
    }
    SEAM(9);
    if (IN(10)) {
        for (int u = bx; u < NBATCH * 20; u += G) { const int bb = u / 20, cg = u % 20;
            if (cg < 12) conv_unit<0>(XBC, 1536, cg * 128, args.in[11], 1536, args.in[12], bb, tid, nullptr, nullptr, nullptr);
            else conv_unit<1>(UB, 1024, (cg - 12) * 128, args.in[17], 1024, args.in[18], bb, tid, args.in[19], args.in[20], XN); }
    }
    SEAM(10);
    if (IN(11)) {
        static_assert(mam::LDS_NEED <= LDSCTL_OFF && mls::LDS_NEED <= LDSCTL_OFF, "mixer LDS");
        for (int u = vcu; u < NBATCH * 8; u += G) mls::unit(UB, XN, VB, (bf16*)((unsigned char*)args.out + DO_CS) + (size_t)u * 32768, GT, args.in[21], args.in[22], u >> 3, (u >> 1) & 3, u & 1, L, tid);
        int tid2 = tid, vcu2 = vcu; asm volatile("" : "+v"(tid2), "+s"(vcu2));
        for (int u = vcu2; u < NBATCH * 8; u += G) mam::unit(XBC, GT, args.in[13], args.in[14], args.in[15], u >> 3, (u >> 2) & 1, u & 3, L, tid2);
    }
    SEAM(11);
    if (IN(12)) for (int rep = 0; rep < 1; ++rep) { for (int m = gw; m < M; m += NGW) gate_row(XBC, 1536, ZB, VB, OPB, YCD, args.in[16], args.in[23], (size_t)m, lane); }
    SEAM(12);
    if (IN(13)) {
        pg8::Gemm g{YCD, W_CDOUT, M, D, KCD, nullptr, nullptr}; pg8::StaticOrder S; S.init(M, D, G, bx);
        pg8::EpiResidBf<false, false, false> E{nullptr, HB, D, nullptr, nullptr};
        pg8::gemm_phase<pg8::EpiResidBf<false, false, false>, pg8::StaticOrder, true, true>(L + RING_OFF, g, S, E);
    }
    SEAM(13);
    if (IN(14)) { for (int m = gw; m < M; m += NGW) rms_row_i8(HB + (size_t)m * D, args.in[2] + D, (unsigned char*)XN + (size_t)m * D, PSUM + (size_t)m * 4, lane); }
    SEAM(14);
    if (IN(15)) {
        pg8::Gemm g{XN, W_GU1, M, NGU, D / 2, PSUM, WDQ + NGU};   pg8::StaticOrder S; S.init(M, NGU, G, bx);
        pg8::EpiSwiglu<false, 2> E{(unsigned char*)ACT, FF, 0.f};
        pg8::gemm_phase<pg8::EpiSwiglu<false, 2>, pg8::StaticOrder, true, true>(L + RING_OFF, g, S, E);
        if (PROBE_G) pg8::gemm_phase<pg8::EpiSwiglu<false, 2>, pg8::StaticOrder, true, true>(L + RING_OFF, g, S, E);
    }
    SEAM(15);
    if (IN(16)) {
        for (int m = gw; m < M; m += NGW) act_row_rot_i8(ACT + (size_t)m * FF, (unsigned char*)XN + (size_t)m * FF, PSUM + (size_t)m * 4, lane);
        if (MK_ONE_LAUNCH) xcd_barrier(bar);
        pg8::Gemm g{XN, W_DN1, M, D, FF / 2, PSUM, WDQ + WQ_DN1}; pg8::StaticOrder S; S.init(M, D, G, bx);
        pg8::EpiResidBf<false, false, false, true> E{nullptr, HB, D, nullptr, nullptr};
        pg8::gemm_phase<pg8::EpiResidBf<false, false, false, true>, pg8::StaticOrder, true, true>(L + RING_OFF, g, S, E);
    }
    SEAM(16);
    if (IN(17)) { int ln = threadIdx.x; asm volatile("" : "+v"(ln)); ln &= 63;
        for (int m = gw; m < M; m += NGW) final_row(HB + (size_t)m * D, args.in[27], out + (size_t)m * D, ln); }
#undef IN
#undef SEAM
#undef XIN
}

extern "C" void kernel_launch(void* const* d_in, const int* in_sizes, int n_in, void* d_out, int out_size, void* d_ws, size_t ws_size, hipStream_t stream) {
    static int grid = 0;
    if (grid == 0) {
        if (n_in != 28 || in_sizes[0] != M * D || out_size != M * D || ws_size < WS_END) { fprintf(stderr, "kernel_launch: unexpected shapes / workspace (%d inputs, ws %zu < %zu); nothing launched\n", n_in, ws_size, (size_t)WS_END); grid = -1; return; }
        int dev = 0, cus = 0;
        if (hipGetDevice(&dev) != hipSuccess || hipDeviceGetAttribute(&cus, hipDeviceAttributeMultiprocessorCount, dev) != hipSuccess) { grid = -1; return; }
        if (hipFuncSetAttribute((const void*)fwd_kernel, hipFuncAttributeMaxDynamicSharedMemorySize, LDS_BYTES) != hipSuccess) { grid = -1; return; }
        int per_cu = 0;
        if (hipOccupancyMaxActiveBlocksPerMultiprocessor(&per_cu, (const void*)fwd_kernel, NWAVES * 64, LDS_BYTES) != hipSuccess || per_cu < 1) fprintf(stderr, "kernel_launch: occupancy query reports %d\n", per_cu);
        (void)hipGetLastError();
        grid = cus;
    }
    if (grid < 0) return;
    if (hipMemsetAsync((char*)d_ws + WS_CTL, 0, CTL_ZERO_BYTES, stream) != hipSuccess) return;
    Args a{};
    for (int i = 0; i < 28; ++i) a.in[i] = (const float*)d_in[i];
    a.out = (float*)d_out; a.ws = (unsigned char*)d_ws;
#if MK_ONE_LAUNCH
    if (PROBE_HI > PROBE_LO) {
        a.ph_lo = 0; a.ph_hi = PROBE_HI; a.li = 0; hipLaunchKernelGGL(fwd_kernel, dim3(grid), dim3(NWAVES * 64), LDS_BYTES, stream, a);
        a.ph_lo = PROBE_LO; a.ph_hi = NPH; a.li = 1; hipLaunchKernelGGL(fwd_kernel, dim3(grid), dim3(NWAVES * 64), LDS_BYTES, stream, a);
        return;
    }
    a.ph_lo = 0; a.ph_hi = NPH;
    hipLaunchKernelGGL(fwd_kernel, dim3(grid), dim3(NWAVES * 64), LDS_BYTES, stream, a);
#else
    for (int p = 0; p < NPH; ++p) { a.ph_lo = p; a.ph_hi = p + 1; hipLaunchKernelGGL(fwd_kernel, dim3(grid), dim3(NWAVES * 64), LDS_BYTES, stream, a); }
#endif
}
```

```cpp
#include <hip/hip_runtime.h>
#include <cstdio>
#include <cstdint>
#ifndef MK_ONE_LAUNCH
#define MK_ONE_LAUNCH 1
#endif
#define PROBE_G 0
#define PROBE_T 0
#define PROBE_LO 0
#define PROBE_HI 0
namespace pg8 {
#define PG8_LAS __attribute__((address_space(3)))
typedef unsigned short bf16_t;
typedef short bf16x8 __attribute__((ext_vector_type(8)));
typedef float f32x4 __attribute__((ext_vector_type(4)));
typedef unsigned u32x4 __attribute__((ext_vector_type(4)));
constexpr int BM = 256, BK = 64, HALF = 128, HTB = HALF * BK * 2  , STAGE_BYTES = 8 * HTB, NXCD = 8, WGM = 4;

__host__ __device__ __forceinline__ int lds_byte(int r, int c) { const int st = (r >> 4) * 2 + (c >> 5), rr = r & 15, cc = c & 31, ob = rr * 64 + cc * 2; return st * 1024 + (ob ^ (((ob >> 9) & 1) << 5)); }
__host__ __device__ __forceinline__ void stage_rc(int b, int& R, int& C) { const int st = b / 1024, sb = b % 1024, swz = sb ^ (((sb >> 9) & 1) << 5); R = (st >> 1) * 16 + swz / 64; C = (st & 1) * 32 + (swz % 64) / 2; }
__host__ __device__ __forceinline__ int perm32(int rho) { const int n = rho >> 4, i = rho & 15; return 8 * (i >> 2) + 4 * n + (i & 3); }

struct Unit { int pm, pn; };
struct Gemm { const bf16_t* A; const bf16_t* Bt; int M, N, K; const float* ps; const float* wq; };

struct StaticOrder {
    int nM, nN, nwg, G, c;
    __host__ __device__ void init(int M, int N, int G_, int c_) { nM = M / BM; nN = N / BM; nwg = nM * nN; G = G_; c = c_; }
    __host__ __device__ bool next(int i, Unit& u) const {
        const long L = (long)i * G + c; if (L >= nwg) return false;
        int wgid = (int)L; { const int q = nwg / NXCD, r = nwg % NXCD, xcd = wgid % NXCD, off = wgid / NXCD; wgid = (xcd < r ? xcd * (q + 1) : r * (q + 1) + (xcd - r) * q) + off; }
        const int nig = WGM * nN, gid = wgid / nig, fm = gid * WGM, gsz = (nM - fm) < WGM ? (nM - fm) : WGM;
        u.pm = fm + ((wgid % nig) % gsz); u.pn = (wgid % nig) / gsz; return true;
    }
    __device__ __forceinline__ void a_ready(const Unit&) const {}
    __device__ __forceinline__ void done(const Unit&) const {}
};

__device__ __forceinline__ unsigned cvt_pk_bf16(float lo, float hi) { unsigned r; asm volatile("v_cvt_pk_bf16_f32 %0, %1, %2" : "=v"(r) : "v"(lo), "v"(hi)); return r; }
typedef float f32x2 __attribute__((ext_vector_type(2)));
typedef int i32x4 __attribute__((ext_vector_type(4)));
typedef int i32x8 __attribute__((ext_vector_type(8)));
__device__ __forceinline__ i32x8 cat8(bf16x8 a, bf16x8 b) { const i32x4 x = __builtin_bit_cast(i32x4, a), y = __builtin_bit_cast(i32x4, b); return __builtin_shufflevector(x, y, 0, 1, 2, 3, 4, 5, 6, 7); }
__device__ __forceinline__ float clamp8(float v) { return __builtin_fminf(__builtin_fmaxf(v, -448.f), 448.f); }
__device__ __forceinline__ unsigned pk4_fp8(float a, float b, float c, float d) { int w = 0; w = __builtin_amdgcn_cvt_pk_fp8_f32(clamp8(a), clamp8(b), w, false); w = __builtin_amdgcn_cvt_pk_fp8_f32(clamp8(c), clamp8(d), w, true); return (unsigned)w; }
constexpr float ACT8_SC = 8.f, W8_SC = 64.f;
__device__ __forceinline__ float silu_f(float x) { return x * __builtin_amdgcn_rcpf(1.f + __expf(-x)); }
__device__ __forceinline__ float row_rstd(const PG8_LAS f32x4* rst, int rl) { const f32x4 p = rst[rl]; return 1.f / sqrtf(((p[0] + p[1]) + (p[2] + p[3])) * (1.f / 1024.f) + 1e-6f); }
struct EpiQKV {
    static constexpr bool PERM = true, AFTER_DRAIN = false, RSTD = false, FP8 = false, I8 = false;
    bf16_t* O; int ldc; int sa_lo, sa_hi, sc_lo, sc_hi; float scale;
    __device__ __forceinline__ void operator()(const f32x4 (&acc)[2][2][4][2], const Unit& u, int wr, int wc, int fr, int fq) const {
        const int row0 = u.pm * BM + wr * 64 + fr, col0 = u.pn * BM + wc * 32 + 8 * fq;
        const float sc = ((u.pn >= sc_lo && u.pn < sc_hi) || (u.pn >= sa_lo && u.pn < sa_hi)) ? scale : 1.f;
#pragma unroll
        for (int ai = 0; ai < 2; ++ai)
#pragma unroll
            for (int m = 0; m < 4; ++m) { bf16_t* rowp = O + (size_t)(row0 + ai * HALF + m * 16) * ldc + col0;
#pragma unroll
                for (int bj = 0; bj < 2; ++bj) { const f32x4 v0 = acc[ai][bj][m][0] * sc, v1 = acc[ai][bj][m][1] * sc;
                    u32x4 w; w.x = cvt_pk_bf16(v0[0], v0[1]); w.y = cvt_pk_bf16(v0[2], v0[3]); w.z = cvt_pk_bf16(v1[0], v1[1]); w.w = cvt_pk_bf16(v1[2], v1[3]);
                    *(u32x4*)(rowp + bj * HALF) = w; } }
    }
};
template <int MODE> struct EpiZX {
    static constexpr bool PERM = true, AFTER_DRAIN = false, RSTD = true, FP8 = false, I8 = (MODE == 2);
    bf16_t *Z, *XBC, *U, *V, *O; float* G;
    static __device__ __forceinline__ f32x4 accf(const f32x4& a) { if constexpr (MODE == 2) return __builtin_convertvector(__builtin_bit_cast(i32x4, a), f32x4); else return a; }
    __device__ __forceinline__ void operator()(const f32x4 (&acc)[2][2][4][2], const Unit& u, int wr, int wc, int fr, int fq, const PG8_LAS f32x4* rst, const PG8_LAS f32x4* wqt) const {
        const int row0 = u.pm * BM + wr * 64 + fr; const int pn = u.pn;
        f32x4 wq[2][2];
#pragma unroll
        for (int bj = 0; bj < 2; ++bj)
#pragma unroll
            for (int n = 0; n < 2; ++n) { if constexpr (MODE == 2) wq[bj][n] = wqt[32 * bj + 8 * wc + 2 * fq + n]; else wq[bj][n] = (f32x4){1.f, 1.f, 1.f, 1.f}; }

        if (pn == 22) {
            if (wc == 0) {
#pragma unroll
                for (int ai = 0; ai < 2; ++ai)
#pragma unroll
                    for (int m = 0; m < 4; ++m) { float* gp = G + (size_t)(row0 + ai * HALF + m * 16) * 32 + 8 * fq; const int rl = ai * HALF + wr * 64 + m * 16 + fr; const float rs = (MODE == 2) ? rst[rl][0] : row_rstd(rst, rl);
                        *(f32x4*)gp = accf(acc[ai][0][m][0]) * (wq[0][0] * rs); *(f32x4*)(gp + 4) = accf(acc[ai][0][m][1]) * (wq[0][1] * rs); }
            }
            return;
        }
        bf16_t* base; int ldc, colt;
        if (pn < 4) { base = Z; ldc = 1024; colt = pn * 256; }
        else if (pn < 10) { base = XBC; ldc = 1536; colt = (pn - 4) * 256; }
        else if (pn < 14) { base = U; ldc = 1024; colt = (pn - 10) * 256; }
        else if (pn < 18) { base = V; ldc = 1024; colt = (pn - 14) * 256; }
        else { base = O; ldc = 1024; colt = (pn - 18) * 256; }
        const int col0 = colt + wc * 32 + 8 * fq;
#pragma unroll
        for (int ai = 0; ai < 2; ++ai)
#pragma unroll
            for (int m = 0; m < 4; ++m) { bf16_t* rowp = base + (size_t)(row0 + ai * HALF + m * 16) * ldc + col0; const int rl = ai * HALF + wr * 64 + m * 16 + fr; const float rs = (MODE == 2) ? rst[rl][0] : row_rstd(rst, rl);
#pragma unroll
                for (int bj = 0; bj < 2; ++bj) { const f32x4 v0 = accf(acc[ai][bj][m][0]) * (wq[bj][0] * rs), v1 = accf(acc[ai][bj][m][1]) * (wq[bj][1] * rs);
                    u32x4 w; w.x = cvt_pk_bf16(v0[0], v0[1]); w.y = cvt_pk_bf16(v0[2], v0[3]); w.z = cvt_pk_bf16(v1[0], v1[1]); w.w = cvt_pk_bf16(v1[2], v1[3]);
                    *(u32x4*)(rowp + bj * HALF) = w; } }
    }
};
template <bool O8, int MODE> struct EpiSwiglu {
    static constexpr bool PERM = true, AFTER_DRAIN = false, RSTD = true, FP8 = false, I8 = (MODE == 2);
    unsigned char* O; int ldc; float wdq;
    __device__ __forceinline__ void operator()(const f32x4 (&acc)[2][2][4][2], const Unit& u, int wr, int wc, int fr, int fq, const PG8_LAS f32x4* rst, const PG8_LAS f32x4* wqt) const {
        const int row0 = u.pm * BM + wr * 64 + fr, col0 = u.pn * HALF + wc * 32 + 8 * fq;
        f32x4 wg0, wg1, wu0, wu1;
        if constexpr (MODE == 2) { const int q = 8 * wc + 2 * fq; wg0 = wqt[q]; wg1 = wqt[q + 1]; wu0 = wqt[32 + q]; wu1 = wqt[32 + q + 1]; }
#pragma unroll
        for (int ai = 0; ai < 2; ++ai)
#pragma unroll
            for (int m = 0; m < 4; ++m) {
                const int rl = ai * HALF + wr * 64 + m * 16 + fr;
                f32x4 g0, g1, u0, u1;
                if constexpr (MODE == 2) { const float rs = rst[rl][0];
                    g0 = __builtin_convertvector(__builtin_bit_cast(i32x4, acc[ai][0][m][0]), f32x4) * (wg0 * rs); g1 = __builtin_convertvector(__builtin_bit_cast(i32x4, acc[ai][0][m][1]), f32x4) * (wg1 * rs);
                    u0 = __builtin_convertvector(__builtin_bit_cast(i32x4, acc[ai][1][m][0]), f32x4) * (wu0 * rs); u1 = __builtin_convertvector(__builtin_bit_cast(i32x4, acc[ai][1][m][1]), f32x4) * (wu1 * rs); }
                else { const float rs = row_rstd(rst, rl); g0 = acc[ai][0][m][0] * rs; g1 = acc[ai][0][m][1] * rs; u0 = acc[ai][1][m][0] * rs; u1 = acc[ai][1][m][1] * rs; }
                float r[8];
#pragma unroll
                for (int j = 0; j < 4; ++j) { r[j] = silu_f(g0[j]) * u0[j]; r[4 + j] = silu_f(g1[j]) * u1[j]; }
                if constexpr (O8) { typedef unsigned u32x2 __attribute__((ext_vector_type(2)));
                    u32x2 w; w.x = pk4_fp8(r[0] * ACT8_SC, r[1] * ACT8_SC, r[2] * ACT8_SC, r[3] * ACT8_SC); w.y = pk4_fp8(r[4] * ACT8_SC, r[5] * ACT8_SC, r[6] * ACT8_SC, r[7] * ACT8_SC);
                    *(u32x2*)(O + (size_t)(row0 + ai * HALF + m * 16) * ldc + col0) = w; }
                else { u32x4 w; w.x = cvt_pk_bf16(r[0], r[1]); w.y = cvt_pk_bf16(r[2], r[3]); w.z = cvt_pk_bf16(r[4], r[5]); w.w = cvt_pk_bf16(r[6], r[7]);
                    *(u32x4*)((bf16_t*)O + (size_t)(row0 + ai * HALF + m * 16) * ldc + col0) = w; } }
    }
};
template <bool SRC_F32, bool PART, bool F8, bool Q8 = false> struct EpiResidBf {
    static constexpr bool PERM = true, AFTER_DRAIN = false, RSTD = Q8, FP8 = F8, I8 = Q8;
    const float* srcf; bf16_t* H; int ldc; float* ps; PG8_LAS float* red;
    __device__ __forceinline__ void operator()(const f32x4 (&acc)[2][2][4][2], const Unit& u, int wr, int wc, int fr, int fq, const PG8_LAS f32x4* rst = nullptr, const PG8_LAS f32x4* wqt = nullptr) const {
        const int row0 = u.pm * BM + wr * 64 + fr, col0 = u.pn * BM + wc * 32 + 8 * fq;
        f32x4 wq[2][2];
        if constexpr (Q8) {
#pragma unroll
            for (int bj = 0; bj < 2; ++bj)
#pragma unroll
                for (int n = 0; n < 2; ++n) wq[bj][n] = wqt[32 * bj + 8 * wc + 2 * fq + n]; }
#pragma unroll
        for (int ai = 0; ai < 2; ++ai)
#pragma unroll
            for (int m = 0; m < 4; ++m) { const size_t off = (size_t)(row0 + ai * HALF + m * 16) * ldc + col0; float ss = 0.f;
#pragma unroll
                for (int bj = 0; bj < 2; ++bj) { f32x4 s0, s1;
                    if (SRC_F32) { s0 = *(const f32x4*)(srcf + off + bj * HALF); s1 = *(const f32x4*)(srcf + off + bj * HALF + 4); }
                    else { const u32x4 hv = *(const u32x4*)(H + off + bj * HALF);
                        s0 = (f32x4){__uint_as_float(hv.x << 16), __uint_as_float(hv.x & 0xffff0000u), __uint_as_float(hv.y << 16), __uint_as_float(hv.y & 0xffff0000u)};
                        s1 = (f32x4){__uint_as_float(hv.z << 16), __uint_as_float(hv.z & 0xffff0000u), __uint_as_float(hv.w << 16), __uint_as_float(hv.w & 0xffff0000u)}; }
                    constexpr float dsc = F8 ? 1.f / (ACT8_SC * W8_SC) : 1.f;
                    f32x4 v0, v1;
                    if constexpr (Q8) { const float rs = rst[ai * HALF + wr * 64 + m * 16 + fr][0];
                        v0 = s0 + __builtin_convertvector(__builtin_bit_cast(i32x4, acc[ai][bj][m][0]), f32x4) * (wq[bj][0] * rs); v1 = s1 + __builtin_convertvector(__builtin_bit_cast(i32x4, acc[ai][bj][m][1]), f32x4) * (wq[bj][1] * rs); }
                    else { v0 = s0 + acc[ai][bj][m][0] * dsc; v1 = s1 + acc[ai][bj][m][1] * dsc; }
                    if (PART) ss += ((v0[0] * v0[0] + v0[1] * v0[1]) + (v0[2] * v0[2] + v0[3] * v0[3])) + ((v1[0] * v1[0] + v1[1] * v1[1]) + (v1[2] * v1[2] + v1[3] * v1[3]));
                    u32x4 w; w.x = cvt_pk_bf16(v0[0], v0[1]); w.y = cvt_pk_bf16(v0[2], v0[3]); w.z = cvt_pk_bf16(v1[0], v1[1]); w.w = cvt_pk_bf16(v1[2], v1[3]);
                    *(u32x4*)(H + off + bj * HALF) = w; }
                if constexpr (PART) { ss += __shfl_xor(ss, 16); ss += __shfl_xor(ss, 32); if (fq == 0) red[(ai * HALF + wr * 64 + m * 16 + fr) * 4 + wc] = ss; } }
        if constexpr (PART) {
            asm volatile("s_waitcnt lgkmcnt(0)" ::: "memory"); __builtin_amdgcn_s_barrier(); asm volatile("" ::: "memory");
            const int t = threadIdx.x;
            if (t < 256) { const f32x4 r = *(const PG8_LAS f32x4*)(red + t * 4); ps[((size_t)u.pm * BM + t) * 4 + u.pn] = (r[0] + r[1]) + (r[2] + r[3]); }
        }
    }
};

template <class Epi, class Sched, bool ALIGN_EPI = false, bool SP2 = false>
__device__ __forceinline__ void gemm_phase(PG8_LAS unsigned char* lds, const Gemm g, const Sched& S, const Epi& E) {
    const int tid = threadIdx.x, wid = __builtin_amdgcn_readfirstlane(tid >> 6), lane = tid & 63, wr = wid >> 2, wc = wid & 3, fr = lane & 15, fq = lane >> 4;
    const int K = g.K, nt = K / BK;
    unsigned voffA[2], voffB[2];
#pragma unroll
    for (int i = 0; i < 2; ++i) { int R, C; stage_rc(tid * 16 + i * 8192, R, C); const int Rb = Epi::PERM ? ((R & ~31) + perm32(R & 31)) : R;
        voffA[i] = (unsigned)(R * K + C) * 2u; voffB[i] = (unsigned)(Rb * K + C) * 2u; }
    int one8 = 0x7f7f7f7f; asm volatile("" : "+v"(one8));
    const size_t kstep = (size_t)(BK * 2);
    const size_t hstep = (size_t)HALF * K * 2;
    const size_t tstep = 2 * hstep;
    const unsigned ldsw = (unsigned)wid * 1024u;
    const int aoff = lds_byte(wr * 64 + fr, fq * 8), boff = lds_byte(wc * 32 + fr, fq * 8);
#define PG8_SA(b, h) (((b) * 2 + (h)) * HTB)
#define PG8_SB(b, h) ((4 + (b) * 2 + (h)) * HTB)
#define PG8_STAGE(bufoff, gbase, voff) do { _Pragma("unroll") for (int _i = 0; _i < 2; ++_i) \
        __builtin_amdgcn_global_load_lds((const unsigned*)((const char*)(gbase) + (voff)[_i]), (PG8_LAS unsigned*)(lds + (bufoff) + ldsw + _i * 8192), 16, 0, 0); } while (0)
#define PG8_LDA(dst, b, h) do { _Pragma("unroll") for (int m = 0; m < 4; ++m) _Pragma("unroll") for (int k = 0; k < 2; ++k) dst[m][k] = *(const PG8_LAS bf16x8*)(lds + PG8_SA(b, h) + aoff + m * 2048 + k * 1024); } while (0)
#define PG8_LDB(dst, b, h) do { _Pragma("unroll") for (int n = 0; n < 2; ++n) _Pragma("unroll") for (int k = 0; k < 2; ++k) dst[n][k] = *(const PG8_LAS bf16x8*)(lds + PG8_SB(b, h) + boff + n * 2048 + k * 1024); } while (0)
#define PG8_MMA(ai, bj, At, Bt) do { __builtin_amdgcn_s_setprio(1); \
        if constexpr (Epi::FP8) { _Pragma("unroll") for (int m = 0; m < 4; ++m) _Pragma("unroll") for (int n = 0; n < 2; ++n) \
            { const i32x8 b8 = cat8(Bt[n][0], Bt[n][1]), a8 = cat8(At[m][0], At[m][1]);     \
              asm volatile("v_mfma_scale_f32_16x16x128_f8f6f4 %0, %1, %2, %0, %3, %3 op_sel_hi:[0,0,0]" : "+v"(acc[ai][bj][m][n]) : "v"(b8), "v"(a8), "v"(one8)); } } \
        else if constexpr (Epi::I8) { _Pragma("unroll") for (int m = 0; m < 4; ++m) _Pragma("unroll") for (int n = 0; n < 2; ++n) _Pragma("unroll") for (int k = 0; k < 2; ++k)     \
            acc[ai][bj][m][n] = __builtin_bit_cast(f32x4, __builtin_amdgcn_mfma_i32_16x16x64_i8(__builtin_bit_cast(i32x4, Bt[n][k]), __builtin_bit_cast(i32x4, At[m][k]), __builtin_bit_cast(i32x4, acc[ai][bj][m][n]), 0, 0, 0)); } \
        else { _Pragma("unroll") for (int m = 0; m < 4; ++m) _Pragma("unroll") for (int n = 0; n < 2; ++n) _Pragma("unroll") for (int k = 0; k < 2; ++k) \
            acc[ai][bj][m][n] = __builtin_amdgcn_mfma_f32_16x16x32_bf16(Bt[n][k], At[m][k], acc[ai][bj][m][n], 0, 0, 0); } \
        __builtin_amdgcn_s_setprio(0); } while (0)
#define PG8_WAIT_V(n) asm volatile("s_waitcnt vmcnt(" #n ")" ::: "memory")
#define PG8_WAIT_L(n) asm volatile("s_waitcnt lgkmcnt(" #n ")" ::: "memory")
#define PG8_BAR __builtin_amdgcn_s_barrier()
#define PG8_SCHED __builtin_amdgcn_sched_barrier(0)
    Unit cur, nxt; int ui = 0;
    if (!S.next(0, cur)) return;
    f32x4 acc[2][2][4][2];
#pragma unroll
    for (int a = 0; a < 2; ++a)
#pragma unroll
        for (int b = 0; b < 2; ++b)
#pragma unroll
            for (int m = 0; m < 4; ++m)
#pragma unroll
                for (int n = 0; n < 2; ++n) acc[a][b][m][n] = (f32x4){0.f, 0.f, 0.f, 0.f};
    bf16x8 At[4][2], B0[2][2], B1[2][2];
    const char* cA = (const char*)g.A + (size_t)cur.pm * tstep; const char* cB = (const char*)g.Bt + (size_t)cur.pn * tstep;
    S.a_ready(cur);
    if constexpr (SP2) {
        PG8_STAGE(PG8_SB(0, 0), cB, voffB); PG8_STAGE(PG8_SB(0, 1), cB + hstep, voffB); PG8_STAGE(PG8_SA(0, 0), cA, voffA); PG8_STAGE(PG8_SA(0, 1), cA + hstep, voffA);
        if (wr == 1) PG8_BAR;
        PG8_WAIT_V(2); PG8_BAR;
        PG8_STAGE(PG8_SB(1, 0), cB + kstep, voffB); PG8_STAGE(PG8_SA(1, 0), cA + kstep, voffA); PG8_STAGE(PG8_SB(1, 1), cB + hstep + kstep, voffB);
        PG8_WAIT_V(6); PG8_BAR;
    } else {
        PG8_STAGE(PG8_SB(0, 0), cB, voffB); PG8_STAGE(PG8_SA(0, 0), cA, voffA); PG8_STAGE(PG8_SB(0, 1), cB + hstep, voffB); PG8_STAGE(PG8_SA(0, 1), cA + hstep, voffA);
        if (wr == 1) PG8_BAR;
        PG8_WAIT_V(4); PG8_BAR;
        PG8_STAGE(PG8_SB(1, 0), cB + kstep, voffB); PG8_STAGE(PG8_SA(1, 0), cA + kstep, voffA); PG8_STAGE(PG8_SB(1, 1), cB + hstep + kstep, voffB);
        PG8_WAIT_V(6); PG8_BAR;
    }
    for (;;) {
        const bool has_next = S.next(ui + 1, nxt);
        const char* nA = has_next ? (const char*)g.A + (size_t)nxt.pm * tstep : cA; const char* nB = has_next ? (const char*)g.Bt + (size_t)nxt.pn * tstep : cB;
        if constexpr (Epi::RSTD) { if (wid < 4)
            __builtin_amdgcn_global_load_lds((const unsigned*)(g.ps + ((size_t)cur.pm * BM + wid * 64 + lane) * 4), (PG8_LAS unsigned*)(lds + STAGE_BYTES + (ui & 1) * 4096 + wid * 1024), 16, 0, 0); }
        if constexpr (Epi::I8) { if (wid == 4)
            __builtin_amdgcn_global_load_lds((const unsigned*)(g.wq + (size_t)cur.pn * BM + lane * 4), (PG8_LAS unsigned*)(lds + STAGE_BYTES + 12288 + (ui & 1) * 1024), 16, 0, 0); }
        for (int t = 0; t < nt; t += 2) {
            const bool last = (t == nt - 2);
            const char* a1 = cA + (size_t)(t + 1) * kstep;
            const char* a2 = last ? nA : cA + (size_t)(t + 2) * kstep; const char* b2 = last ? nB : cB + (size_t)(t + 2) * kstep;
            const char* a3 = a2 + kstep; const char* b3 = b2 + kstep;
            if (last && has_next) S.a_ready(nxt);
            if constexpr (SP2) {
            PG8_LDB(B0, 0, 0); PG8_LDB(B1, 0, 1); PG8_SCHED; PG8_LDA(At, 0, 0); PG8_STAGE(PG8_SA(1, 1), a1 + hstep, voffA);
            PG8_WAIT_V(8); PG8_WAIT_L(0); PG8_BAR; PG8_MMA(0, 0, At, B0); PG8_MMA(0, 1, At, B1); PG8_BAR; PG8_SCHED;
            PG8_LDA(At, 0, 1); PG8_STAGE(PG8_SB(0, 0), b2, voffB); PG8_STAGE(PG8_SB(0, 1), b2 + hstep, voffB); PG8_STAGE(PG8_SA(0, 0), a2, voffA);
            PG8_WAIT_V(8); PG8_WAIT_L(0); PG8_BAR; PG8_MMA(1, 0, At, B0); PG8_MMA(1, 1, At, B1); PG8_BAR; PG8_SCHED;
            PG8_LDB(B0, 1, 0); PG8_LDB(B1, 1, 1); PG8_SCHED; PG8_LDA(At, 1, 0); PG8_STAGE(PG8_SA(0, 1), a2 + hstep, voffA);
            PG8_WAIT_V(8); PG8_WAIT_L(0); PG8_BAR; PG8_MMA(0, 0, At, B0); PG8_MMA(0, 1, At, B1); PG8_BAR; PG8_SCHED;
            PG8_LDA(At, 1, 1); PG8_STAGE(PG8_SB(1, 0), b3, voffB); PG8_STAGE(PG8_SB(1, 1), b3 + hstep, voffB); PG8_STAGE(PG8_SA(1, 0), a3, voffA);
            PG8_WAIT_V(8); PG8_WAIT_L(0); PG8_BAR; PG8_MMA(1, 0, At, B0); PG8_MMA(1, 1, At, B1); PG8_BAR; PG8_SCHED;
            } else {
            PG8_LDB(B0, 0, 0); PG8_SCHED; PG8_LDA(At, 0, 0); PG8_STAGE(PG8_SA(1, 1), a1 + hstep, voffA);
            PG8_WAIT_L(8); PG8_BAR; PG8_WAIT_L(0); PG8_MMA(0, 0, At, B0); PG8_BAR; PG8_SCHED;
            PG8_LDB(B1, 0, 1); PG8_STAGE(PG8_SB(0, 0), b2, voffB);
            PG8_BAR; PG8_WAIT_L(0); PG8_MMA(0, 1, At, B1); PG8_BAR;
            PG8_LDA(At, 0, 1); PG8_STAGE(PG8_SA(0, 0), a2, voffA);
            PG8_BAR; PG8_WAIT_L(0); PG8_MMA(1, 0, At, B0); PG8_BAR; PG8_SCHED;
            PG8_STAGE(PG8_SB(0, 1), b2 + hstep, voffB);
            PG8_WAIT_V(6); PG8_BAR; PG8_MMA(1, 1, At, B1); PG8_BAR;
            PG8_LDB(B0, 1, 0); PG8_SCHED; PG8_LDA(At, 1, 0); PG8_STAGE(PG8_SA(0, 1), a2 + hstep, voffA);
            PG8_WAIT_L(8); PG8_BAR; PG8_WAIT_L(0); PG8_MMA(0, 0, At, B0); PG8_BAR; PG8_SCHED;
            PG8_LDB(B1, 1, 1); PG8_STAGE(PG8_SB(1, 0), b3, voffB);
            PG8_BAR; PG8_WAIT_L(0); PG8_MMA(0, 1, At, B1); PG8_BAR;
            PG8_LDA(At, 1, 1); PG8_STAGE(PG8_SA(1, 0), a3, voffA);
            PG8_BAR; PG8_WAIT_L(0); PG8_MMA(1, 0, At, B0); PG8_BAR; PG8_SCHED;
            PG8_STAGE(PG8_SB(1, 1), b3 + hstep, voffB);
            PG8_WAIT_V(6); PG8_BAR; PG8_MMA(1, 1, At, B1); PG8_BAR;
            }
        }
        if constexpr (ALIGN_EPI) { if (wr == 0) PG8_BAR; }
        if constexpr (!Epi::AFTER_DRAIN) { if constexpr (Epi::RSTD) E(acc, cur, wr, wc, fr, fq, (const PG8_LAS f32x4*)(lds + STAGE_BYTES + (ui & 1) * 4096), (const PG8_LAS f32x4*)(lds + STAGE_BYTES + 12288 + (ui & 1) * 1024)); else E(acc, cur, wr, wc, fr, fq); S.done(cur); }
        if (!has_next) break;
#pragma unroll
        for (int a = 0; a < 2; ++a)
#pragma unroll
            for (int b = 0; b < 2; ++b)
#pragma unroll
                for (int m = 0; m < 4; ++m)
#pragma unroll
                    for (int n = 0; n < 2; ++n) acc[a][b][m][n] = (f32x4){0.f, 0.f, 0.f, 0.f};
        cur = nxt; cA = nA; cB = nB; ++ui;
        if constexpr (ALIGN_EPI) { if (wr == 1) PG8_BAR; }
    }
    PG8_WAIT_V(0);
    if constexpr (!ALIGN_EPI) { if (wr == 0) PG8_BAR; }
    PG8_BAR;
    if constexpr (Epi::AFTER_DRAIN) { E.fused(acc, cur, wr, wc, fr, fq, lds, wid, lane); S.done(cur); }
#undef PG8_SA
#undef PG8_SB
#undef PG8_STAGE
#undef PG8_LDA
#undef PG8_LDB
#undef PG8_MMA
#undef PG8_WAIT_V
#undef PG8_WAIT_L
#undef PG8_BAR
#undef PG8_SCHED
}
}
#include <hip/hip_bf16.h>
#include <cmath>
namespace attn_body {
using bf16=__hip_bfloat16;
using bf16x8=__attribute__((ext_vector_type(8)))short;
using s16x4=__attribute__((ext_vector_type(4)))short;
using f32x16=__attribute__((ext_vector_type(16)))float;
using u32x4=__attribute__((ext_vector_type(4)))unsigned;
constexpr int BATCH=32,NHEAD=16,SEQ=2048,D=64,DM=3072,DMO=1024;
constexpr int NW=8,QBLK=32,QB=QBLK*NW,KVBLK=64,NQB=SEQ/QB;
constexpr int ATTN_PITCH=DM, ATTN_UNIT_ROWS=QB;
__device__ __forceinline__ int crow(int r,int hi){return (r&3)+8*(r>>2)+4*hi;}
#define SBAR() __builtin_amdgcn_sched_barrier(0)
__device__ __forceinline__ void cmask(f32x16&p0,f32x16&p1,int jb,int qrel,int hi){
  const float NEG=-INFINITY; int kb=64*jb+4*hi;
  #pragma unroll
  for(int r=0;r<16;++r){int kv=kb+(r&3)+8*(r>>2); if(kv>qrel)p0[r]=NEG; if(kv+32>qrel)p1[r]=NEG;}
}

constexpr int NSLOT=3, SLOTB=8192;
constexpr int LDS_K=0, LDS_V=NSLOT*SLOTB, LDS_WS=2*NSLOT*SLOTB, LDS_OST=LDS_WS+NW*64*4, LDS_BYTES=LDS_OST+NW*4096;
constexpr float C2=0.125f*1.4426950408889634f;
__device__ __forceinline__ void glds16(const void*gsrc,unsigned lds_dst){unsigned keep;
  asm volatile("s_mov_b32 %0, m0\n\ts_mov_b32 m0, %2\n\ts_nop 0\n\tglobal_load_lds_dwordx4 %1, off\n\ts_mov_b32 m0, %0":"=&s"(keep):"v"(gsrc),"s"(lds_dst):"memory");}
__device__ __forceinline__ float max3f(float a,float b,float c){float r;asm("v_max3_f32 %0, %1, %2, %3":"=v"(r):"v"(a),"v"(b),"v"(c));return r;}
__device__ __forceinline__ float max2f(float a,float b){float r;asm("v_max_f32_e32 %0, %1, %2":"=v"(r):"v"(a),"v"(b));return r;}
__device__ __forceinline__ float fadd_s(float a,float b){float r;asm("v_add_f32_e32 %0, %1, %2":"=v"(r):"v"(a),"v"(b));return r;}
__device__ __forceinline__ float fsub_s(float a,float b){float r;asm("v_sub_f32_e32 %0, %1, %2":"=v"(r):"v"(a),"v"(b));return r;}
typedef float f32x2_t __attribute__((ext_vector_type(2))); typedef __bf16 bf16x2_t __attribute__((ext_vector_type(2)));
__device__ __forceinline__ unsigned cvtpk_s(float lo,float hi){f32x2_t v={lo,hi};bf16x2_t b=__builtin_convertvector(v,bf16x2_t);return __builtin_bit_cast(unsigned,b);}
#define WAIT_BAR(N) asm volatile("s_waitcnt vmcnt(" #N ") lgkmcnt(0)\n\ts_barrier":::"memory")

__device__ __forceinline__ void qkt(f32x16&p0,f32x16&p1,const char*Kslot,const bf16x8*qr,const f32x16&negm,int r32,int hi){
  const char*kb=Kslot+hi*1024+r32*16;
  #pragma unroll
  for(int d0=0;d0<4;++d0){
    const bf16x8 b0=*reinterpret_cast<const bf16x8*>(kb+d0*2048);
    const bf16x8 b1=*reinterpret_cast<const bf16x8*>(kb+d0*2048+512);
    if(d0==0){p0=__builtin_amdgcn_mfma_f32_32x32x16_bf16(b0,qr[0],negm,0,0,0);p1=__builtin_amdgcn_mfma_f32_32x32x16_bf16(b1,qr[0],negm,0,0,0);}
    else{p0=__builtin_amdgcn_mfma_f32_32x32x16_bf16(b0,qr[d0],p0,0,0,0);p1=__builtin_amdgcn_mfma_f32_32x32x16_bf16(b1,qr[d0],p1,0,0,0);}}
}
typedef __attribute__((address_space(3))) const char* lds_cptr;
typedef short v4i16_t __attribute__((ext_vector_type(4)));
__device__ __forceinline__ void kload8(bf16x8*kf,lds_cptr kp){
  kf[0]=*(const __attribute__((address_space(3))) bf16x8*)(kp);      kf[1]=*(const __attribute__((address_space(3))) bf16x8*)(kp+512);
  kf[2]=*(const __attribute__((address_space(3))) bf16x8*)(kp+2048); kf[3]=*(const __attribute__((address_space(3))) bf16x8*)(kp+2560);
  kf[4]=*(const __attribute__((address_space(3))) bf16x8*)(kp+4096); kf[5]=*(const __attribute__((address_space(3))) bf16x8*)(kp+4608);
  kf[6]=*(const __attribute__((address_space(3))) bf16x8*)(kp+6144); kf[7]=*(const __attribute__((address_space(3))) bf16x8*)(kp+6656);
}
__device__ __forceinline__ void kload2(bf16x8*kf,lds_cptr kp,int j){ kf[2*j]=*(const __attribute__((address_space(3))) bf16x8*)(kp+j*2048); kf[2*j+1]=*(const __attribute__((address_space(3))) bf16x8*)(kp+j*2048+512); }
__device__ __forceinline__ s16x4 vtr(lds_cptr p){ return __builtin_bit_cast(s16x4,__builtin_amdgcn_ds_read_tr16_b64_v4i16((__attribute__((address_space(3))) v4i16_t*)p)); }
__device__ __forceinline__ float rowmax(const f32x16&p0,const f32x16&p1){
  float a=max3f(p0[0],p0[1],p1[0]),b=max3f(p0[2],p0[3],p1[1]);a=max3f(a,p1[2],p1[3]);
  #pragma unroll
  for(int r=4;r<16;r+=4){a=max3f(a,p0[r],p0[r+1]);b=max3f(b,p0[r+2],p0[r+3]);a=max3f(a,p1[r],p1[r+1]);b=max3f(b,p1[r+2],p1[r+3]);}
  const float m=max2f(a,b);
  auto rr=__builtin_amdgcn_permlane32_swap(__float_as_uint(m),__float_as_uint(m),false,false);
  return max2f(__uint_as_float(rr[0]),__uint_as_float(rr[1]));
}
__device__ __forceinline__ void pv(f32x16*o,int vb,bf16x8 pa0,bf16x8 pa1,bf16x8 pa2,bf16x8 pa3){
  #pragma unroll
  for(int d0=0;d0<2;++d0){s16x4 lo[4],hi[4];
    #pragma unroll
    for(int ks=0;ks<4;++ks){
      asm volatile("ds_read_b64_tr_b16 %0,%1 offset:%c2":"=&v"(lo[ks]):"v"(vb),"i"(d0*4096+ks*1024):"memory");
      asm volatile("ds_read_b64_tr_b16 %0,%1 offset:%c2":"=&v"(hi[ks]):"v"(vb),"i"(d0*4096+ks*1024+512):"memory");}
    asm volatile("s_waitcnt lgkmcnt(0)":::"memory");SBAR();
    #define PK(k) (bf16x8){lo[k][0],lo[k][1],lo[k][2],lo[k][3],hi[k][0],hi[k][1],hi[k][2],hi[k][3]}
    o[d0]=__builtin_amdgcn_mfma_f32_32x32x16_bf16(pa0,PK(0),o[d0],0,0,0);
    o[d0]=__builtin_amdgcn_mfma_f32_32x32x16_bf16(pa1,PK(1),o[d0],0,0,0);
    o[d0]=__builtin_amdgcn_mfma_f32_32x32x16_bf16(pa2,PK(2),o[d0],0,0,0);
    o[d0]=__builtin_amdgcn_mfma_f32_32x32x16_bf16(pa3,PK(3),o[d0],0,0,0);
    #undef PK
  }
}

#ifndef ATTN_STORE16
#define ATTN_STORE16(p,v) (*(u32x4*)(p)=(v))
#endif
template<int THRL> __device__ __forceinline__ void attn_unit(int b,int h,int qb,const bf16*Q,const bf16*__restrict__ K,const bf16*__restrict__ V,bf16*O,char*shm){
  const int tid=threadIdx.x,lane=tid&63,r32=lane&31,hi=lane>>5; const int wid=__builtin_amdgcn_readfirstlane(tid>>6);
  const long rowbase=(long)b*SEQ; const int q0=qb*QB;
  const bf16*Qw=Q+(rowbase+q0+wid*QBLK)*DM+1536+(h>>1)*64;
  const bf16*Kh=K+rowbase*DM+2048+(h>>1)*64,*Vh=V+rowbase*DM+2560+(h>>2)*128+(h&1)*64;
  const unsigned lds0=(unsigned)(uintptr_t)shm;
  float*wsf=(float*)(shm+LDS_WS)+wid*64;
  const bf16*ksrc=Kh+(long)lane*DM+wid*8;
  const bf16*vsrc=Vh+(long)(16*(wid&3)+(lane>>2))*DM+(wid>>2)*32+(lane&3)*8;
  const unsigned kdst=lds0+LDS_K+wid*1024, vdst=lds0+LDS_V+wid*1024;
  #define DMA_K(t,slot) glds16(ksrc+(long)(t)*KVBLK*DM,(unsigned)__builtin_amdgcn_readfirstlane(kdst+(slot)))
  #define DMA_V(t,slot) glds16(vsrc+(long)(t)*KVBLK*DM,(unsigned)__builtin_amdgcn_readfirstlane(vdst+(slot)))
  const int vb0=(int)(lds0+LDS_V)+((lane>>4)&1)*32+(lane&3)*8+(4*hi+((lane&15)>>2))*64;
  const char*Kbase=shm+LDS_K; bf16x8 kf[8];
  const lds_cptr shm3=(lds_cptr)shm; const lds_cptr kp0=shm3+LDS_K+hi*1024+r32*16; const lds_cptr vp0=shm3+LDS_V+((lane>>4)&1)*32+(lane&3)*8+(4*hi+((lane&15)>>2))*64;
  const int NT=(q0+QB)/KVBLK;
  DMA_K(0,0);DMA_V(0,0);DMA_K(1,SLOTB);
  bf16x8 qr[4];
  #pragma unroll
  for(int d0=0;d0<4;++d0)qr[d0]=*reinterpret_cast<const bf16x8*>(&Qw[(long)r32*DM+d0*16+hi*8]);
  float mhat=0.f,l_reg=0.f;f32x16 o[2];o[0]=f32x16{};o[1]=f32x16{};f32x16 negm=f32x16{};asm volatile("":"+v"(negm));
  const int qrel=wid*QBLK+r32;
  #define CMASK(P0,P1,t) do{int jb_=(t)-(NT-4); if(jb_>=0)cmask(P0,P1,jb_,qrel,hi);}while(0)
  bool resc=false;
  #define START(P0,P1) do{ const float rm=rowmax(P0,P1); resc=false; \
    { const float dl=rm; mhat=fadd_s(mhat,dl); \
      _Pragma("unroll") for(int r=0;r<16;++r){P0[r]=fsub_s(P0[r],dl);P1[r]=fsub_s(P1[r],dl);} \
      _Pragma("unroll") for(int r=0;r<16;++r)negm[r]=-mhat; asm volatile("":"+v"(negm)); } \
    _Pragma("unroll") for(int r=0;r<16;++r)P0[r]=__builtin_amdgcn_exp2f(P0[r]); }while(0)
  #define RESC() do{ if(resc){ asm volatile("s_waitcnt lgkmcnt(0)":::"memory"); \
      _Pragma("unroll") for(int d_=0;d_<2;++d_) _Pragma("unroll") for(int r=0;r<16;++r)o[d_][r]*=wsf[crow(r,hi)]; } }while(0)
  f32x16 pA0,pA1,pB0,pB1;
  int sl_prev=0,sl_cur=0,sl_next=SLOTB;
  #define ROT() do{sl_prev=sl_cur;sl_cur=sl_next;sl_next=(sl_next==(NSLOT-1)*SLOTB)?0:sl_next+SLOTB;}while(0)
  DMA_K(2,2*SLOTB);
  WAIT_BAR(3);
  qkt(pA0,pA1,Kbase,qr,negm,r32,hi);asm volatile("s_nop 15\n\ts_nop 7":"+v"(pA0),"+v"(pA1));CMASK(pA0,pA1,0);
  START(pA0,pA1);
  _Pragma("unroll") for(int r=0;r<16;++r)pA1[r]=__builtin_amdgcn_exp2f(pA1[r]);
  WAIT_BAR(0);
  DMA_K(3,0);DMA_V(1,SLOTB);
  ROT();
  kload8(kf,kp0+sl_cur);
  WAIT_BAR(2);
  s16x4 vlo[8],vhi[8]; u32x4 pw0,pw1,pw2,pw3;
  #define PKW(P,B) cvtpk_s(P[B],P[B+1])
  #define PAF(k) __builtin_bit_cast(bf16x8,pw##k)
  #define VFR(i) (bf16x8){vlo[i][0],vlo[i][1],vlo[i][2],vlo[i][3],vhi[i][0],vhi[i][1],vhi[i][2],vhi[i][3]}
  #define PIN(x) asm volatile("":"+v"(x))
  #define MX3(a,b,c) __builtin_fmaxf(__builtin_fmaxf((a),(b)),(c))
  #define GAPA(MF,A0,A1,A2,A3,W0,W1,PW) do{ MF; sacc+=A0; sacc+=A1; sacc+=A2; sacc+=A3; PIN(sacc); W0; W1; PIN(PW); SBAR(); }while(0)
  #define EX(v) __builtin_amdgcn_exp2f(v)
  #define GAPB(MF,X,B) do{ MF; X[B]=EX(X[B]); X[B+1]=EX(X[B+1]); X[B+2]=EX(X[B+2]); X[B+3]=EX(X[B+3]); PIN(X); SBAR(); }while(0)
  #define VRD(i) do{ vlo[i]=vtr(vp_+(((i)>>2)*4096+((i)&3)*1024)); vhi[i]=vtr(vp_+(((i)>>2)*4096+((i)&3)*1024+512)); }while(0)
  #define KRD(G,j) do{ if(G){ kload2(kf,kp0+sl_next,j); SBAR(); } }while(0)
  #define STEP(C0,C1,P0,P1,t,GK,GV,GL) do{ SBAR(); \
    const lds_cptr vp_=vp0+sl_prev; \
    VRD(0); SBAR(); float sacc=(P0[0]+P0[1]); \
    GAPA(C0=__builtin_amdgcn_mfma_f32_32x32x16_bf16(kf[0],qr[0],negm,0,0,0), P0[2],P0[3],P0[4],P0[5],     pw0[0]=PKW(P0,0), pw0[1]=PKW(P0,2), pw0); \
    VRD(4); SBAR(); GAPA(C1=__builtin_amdgcn_mfma_f32_32x32x16_bf16(kf[1],qr[0],negm,0,0,0), P0[6],P0[7],P0[8],P0[9],     pw0[2]=PKW(P0,4), pw0[3]=PKW(P0,6), pw0); \
    VRD(1); SBAR(); GAPA(C0=__builtin_amdgcn_mfma_f32_32x32x16_bf16(kf[2],qr[1],C0,0,0,0),   P0[10],P0[11],P0[12],P0[13], pw1[0]=PKW(P0,8), pw1[1]=PKW(P0,10), pw1); \
    VRD(5); SBAR(); GAPA(C1=__builtin_amdgcn_mfma_f32_32x32x16_bf16(kf[3],qr[1],C1,0,0,0),   P0[14],P0[15],P1[0],P1[1],   pw1[2]=PKW(P0,12),pw1[3]=PKW(P0,14), pw1); \
    VRD(2); SBAR(); GAPA(C0=__builtin_amdgcn_mfma_f32_32x32x16_bf16(kf[4],qr[2],C0,0,0,0),   P1[2],P1[3],P1[4],P1[5],     pw2[0]=PKW(P1,0), pw2[1]=PKW(P1,2), pw2); \
    VRD(6); SBAR(); GAPA(C1=__builtin_amdgcn_mfma_f32_32x32x16_bf16(kf[5],qr[2],C1,0,0,0),   P1[6],P1[7],P1[8],P1[9],     pw2[2]=PKW(P1,4), pw2[3]=PKW(P1,6), pw2); \
    VRD(3); SBAR(); GAPA(C0=__builtin_amdgcn_mfma_f32_32x32x16_bf16(kf[6],qr[3],C0,0,0,0),   P1[10],P1[11],P1[12],P1[13], pw3[0]=PKW(P1,8), pw3[1]=PKW(P1,10), pw3); \
    VRD(7); SBAR(); GAPA(C1=__builtin_amdgcn_mfma_f32_32x32x16_bf16(kf[7],qr[3],C1,0,0,0),   P1[14],P1[15],0.f,0.f,       pw3[2]=PKW(P1,12),pw3[3]=PKW(P1,14), pw3); \
    l_reg+=sacc; \
    if(GK){DMA_K((t)+3,sl_cur);} if(GV){DMA_V((t)+1,sl_next);} \
    CMASK(C0,C1,t); \
    { float a=MX3(C0[0],C0[1],C1[0]),b=MX3(C0[2],C0[3],C1[1]); a=MX3(a,C1[2],C1[3]); \
      _Pragma("unroll") for(int r=4;r<16;r+=4){a=MX3(a,C0[r],C0[r+1]);b=MX3(b,C0[r+2],C0[r+3]);a=MX3(a,C1[r],C1[r+1]);b=MX3(b,C1[r+2],C1[r+3]);} \
      float rm=__builtin_fmaxf(a,b); { auto rr=__builtin_amdgcn_permlane32_swap(__float_as_uint(rm),__float_as_uint(rm),false,false); rm=__builtin_fmaxf(__uint_as_float(rr[0]),__uint_as_float(rr[1])); } \
      resc=false; \
      if(__builtin_expect(__any(rm>(float)THRL),0)){ const float dl=__builtin_fmaxf(rm,0.f); mhat+=dl; \
        _Pragma("unroll") for(int r=0;r<16;++r){C0[r]-=dl;C1[r]-=dl;} \
        _Pragma("unroll") for(int r=0;r<16;++r)negm[r]=-mhat; asm volatile("":"+v"(negm)); \
        const float f=__builtin_amdgcn_exp2f(-dl); l_reg*=f; if(hi==0)wsf[r32]=f; resc=true; } } \
    SBAR(); \
    GAPB(o[0]=__builtin_amdgcn_mfma_f32_32x32x16_bf16(PAF(0),VFR(0),o[0],0,0,0), C0,0); \
    GAPB(o[1]=__builtin_amdgcn_mfma_f32_32x32x16_bf16(PAF(0),VFR(4),o[1],0,0,0), C0,4); \
    KRD(GL,0); GAPB(o[0]=__builtin_amdgcn_mfma_f32_32x32x16_bf16(PAF(1),VFR(1),o[0],0,0,0), C0,8); \
    KRD(GL,1); GAPB(o[1]=__builtin_amdgcn_mfma_f32_32x32x16_bf16(PAF(1),VFR(5),o[1],0,0,0), C0,12); \
    KRD(GL,2); GAPB(o[0]=__builtin_amdgcn_mfma_f32_32x32x16_bf16(PAF(2),VFR(2),o[0],0,0,0), C1,0); \
    KRD(GL,3); GAPB(o[1]=__builtin_amdgcn_mfma_f32_32x32x16_bf16(PAF(2),VFR(6),o[1],0,0,0), C1,4); \
    GAPB(o[0]=__builtin_amdgcn_mfma_f32_32x32x16_bf16(PAF(3),VFR(3),o[0],0,0,0), C1,8); \
    GAPB(o[1]=__builtin_amdgcn_mfma_f32_32x32x16_bf16(PAF(3),VFR(7),o[1],0,0,0), C1,12); \
    }while(0)
  int t=1;
  #undef CMASK
  #define CMASK(P0,P1,t) do{}while(0)
  for(;t+5<NT;t+=2){
    STEP(pB0,pB1,pA0,pA1,t,true,true,true);     WAIT_BAR(2); RESC(); ROT();
    STEP(pA0,pA1,pB0,pB1,t+1,true,true,true);   WAIT_BAR(2); RESC(); ROT();
  }
  #undef CMASK
  #define CMASK(P0,P1,t) do{int jb_=(t)-(NT-4); if(jb_>=0)cmask(P0,P1,jb_,qrel,hi);}while(0)
  #define ENDW(tt) do{ if((tt)+3<NT){WAIT_BAR(2);} else if((tt)+2<NT){WAIT_BAR(1);} else {WAIT_BAR(0);} }while(0)
  for(;t+1<NT;t+=2){
    STEP(pB0,pB1,pA0,pA1,t,(t+3<NT),(t+1<NT),(t+1<NT));       ENDW(t);   RESC(); ROT();
    STEP(pA0,pA1,pB0,pB1,t+1,(t+4<NT),(t+2<NT),(t+2<NT));     ENDW(t+1); RESC(); ROT();
  }
  STEP(pB0,pB1,pA0,pA1,NT-1,false,false,false); RESC();
  { float sacc=pB0[0]+pB0[1]; _Pragma("unroll") for(int r=2;r<16;++r)sacc+=pB0[r]; _Pragma("unroll") for(int r=0;r<16;++r)sacc+=pB1[r]; l_reg+=sacc;
    pw0=(u32x4){PKW(pB0,0),PKW(pB0,2),PKW(pB0,4),PKW(pB0,6)};pw1=(u32x4){PKW(pB0,8),PKW(pB0,10),PKW(pB0,12),PKW(pB0,14)};pw2=(u32x4){PKW(pB1,0),PKW(pB1,2),PKW(pB1,4),PKW(pB1,6)};pw3=(u32x4){PKW(pB1,8),PKW(pB1,10),PKW(pB1,12),PKW(pB1,14)};
    SBAR(); pv(o,vb0+sl_cur,PAF(0),PAF(1),PAF(2),PAF(3)); }
  #undef PKW
  #undef PAF
  #undef VFR
  #undef PIN
  #undef MX3
  #undef GAPA
  #undef GAPB
  #undef EX
  #undef VRD
  #undef KRD
  #undef STEP
  #undef ENDW
  {auto rr=__builtin_amdgcn_permlane32_swap(__float_as_uint(l_reg),__float_as_uint(l_reg),false,false);l_reg=__uint_as_float(rr[0])+__uint_as_float(rr[1]);}
  if(hi==0)wsf[32+r32]=l_reg;asm volatile("s_waitcnt lgkmcnt(0)":::"memory");
  float rli[16];
  #pragma unroll
  for(int r=0;r<16;++r)rli[r]=__builtin_amdgcn_rcpf(wsf[32+crow(r,hi)]);
  bf16*Ow=O+(rowbase+q0+wid*QBLK)*DMO+h*D;
  { bf16*stg=(bf16*)(shm+LDS_OST)+wid*2048;
    #pragma unroll
    for(int r=0;r<16;++r){const int orow=crow(r,hi);
      #pragma unroll
      for(int d0=0;d0<2;++d0)stg[orow*64+d0*32+r32]=__float2bfloat16(o[d0][r]*rli[r]);}
    asm volatile("s_waitcnt lgkmcnt(0)":::"memory");
    #pragma unroll
    for(int i=0;i<4;++i){const int row=i*8+(lane>>3),ch=lane&7; const u32x4 v=*(const u32x4*)(stg+row*64+ch*8); ATTN_STORE16(Ow+(long)row*DMO+ch*8,v);} }
  asm volatile("s_waitcnt lgkmcnt(0)\n\ts_barrier":::"memory");
  #undef DMA_K
  #undef DMA_V
  #undef CMASK
  #undef START
  #undef RESC
  #undef ROT
}
constexpr int ATTN_LDS_BYTES=LDS_BYTES;
struct AttnTensors { const bf16* Q; const bf16* K; const bf16* V; bf16* O; };
struct AttnUnit { int bh; int qb; };
struct StaticOrder {
  int vcu;
  __device__ __forceinline__ explicit StaticOrder(int grid,int block):vcu((block%8)*(grid/8)+block/8){}
  __device__ __forceinline__ bool next(int i,AttnUnit&u)const{ if(i>=16)return false; const int j=i&7; u.bh=vcu*2+(i>>3); u.qb=(j&1)?7-(j>>1):(j>>1); return true; }
  __device__ __forceinline__ void a_ready(const AttnUnit&)const{}
  __device__ __forceinline__ void done(const AttnUnit&)const{}
};
template<class Sched,int THRL=8> __device__ __forceinline__ void attn_phase(char*lds,const AttnTensors&T,const Sched&S){
  AttnUnit u;
  for(int i=0;S.next(i,u);++i){ S.a_ready(u); attn_unit<THRL>(u.bh/NHEAD,u.bh%NHEAD,u.qb,T.Q,T.K,T.V,T.O,lds); S.done(u); }
}
#undef SBAR
#undef WAIT_BAR
}
namespace mixa {
using bf16x8 = __attribute__((ext_vector_type(8))) short;
using s16x4 = __attribute__((ext_vector_type(4))) short;
using f32x16 = __attribute__((ext_vector_type(16))) float;
using f32x4 = __attribute__((ext_vector_type(4))) float;
using u32x4 = __attribute__((ext_vector_type(4))) unsigned;
typedef short v4i16_t __attribute__((ext_vector_type(4)));
#define MA_LAS __attribute__((address_space(3)))
typedef unsigned short bf16;
constexpr int PQ = 3072, TT = 2048, PY = 1024;
constexpr int XO = 0, XM = 65536, XL = XM + 1024, WV = XL + 1024, WSZ = 4096 + 256;
constexpr int LDS_NEED = WV + 8 * WSZ;
__device__ __forceinline__ int crow(int r, int hi) { return (r & 3) + 8 * (r >> 2) + 4 * hi; }
__device__ __forceinline__ unsigned cvtpk(float lo, float hi) { typedef float f2 __attribute__((ext_vector_type(2))); typedef __bf16 b2 __attribute__((ext_vector_type(2))); f2 v = {lo, hi}; b2 b = __builtin_convertvector(v, b2); return __builtin_bit_cast(unsigned, b); }
template <int BR> __device__ __forceinline__ int qloc(int w, int i) {
    if (BR == 0) return 32 * w + i;
    if (BR == 1) return (w & 3) + 4 * (32 * (w >> 2) + i);
    return (2 * w + (i >> 4)) + 16 * (i & 15);
}
struct State { f32x16 o[2]; float m, l; };
template <int BR> __device__ __forceinline__ void xchg_write(const State& S, MA_LAS unsigned char* L, int w, int r32, int hi) {
    MA_LAS float* xo = (MA_LAS float*)(L + XO);
#pragma unroll
    for (int r = 0; r < 16; ++r) { const int ql = qloc<BR>(w, crow(r, hi)); xo[ql * 64 + r32] = S.o[0][r]; xo[ql * 64 + 32 + r32] = S.o[1][r]; }
    const float lt = S.l + __shfl_xor(S.l, 32);
    if (hi == 0) { const int ql = qloc<BR>(w, r32); ((MA_LAS float*)(L + XM))[ql] = S.m; ((MA_LAS float*)(L + XL))[ql] = lt; }
}
template <int BR> __device__ __forceinline__ void xchg_read(State& S, MA_LAS unsigned char* L, int w, int r32, int hi) {
    const MA_LAS float* xo = (const MA_LAS float*)(L + XO);
#pragma unroll
    for (int r = 0; r < 16; ++r) { const int ql = qloc<BR>(w, crow(r, hi)); S.o[0][r] = xo[ql * 64 + r32]; S.o[1][r] = xo[ql * 64 + 32 + r32]; }
    const int ql = qloc<BR>(w, r32);
    S.m = ((const MA_LAS float*)(L + XM))[ql]; const float lt = ((const MA_LAS float*)(L + XL))[ql]; S.l = (hi == 0) ? lt : 0.f;
}
template <int BR> __device__ __forceinline__ void branch(State& S, const bf16* Qb, int t0, MA_LAS unsigned char* L, int w, int lane) {
    constexpr int STRIDE = (BR == 0) ? 1 : (BR == 1) ? 4 : 16;
    const int r32 = lane & 31, hi = lane >> 5;
    const bf16* Kb = Qb + 512; const bf16* Vb = Qb + 1024;
    MA_LAS unsigned char* img = L + WV + w * WSZ; MA_LAS float* SC = (MA_LAS float*)(img + 4096);
    const int qi = (BR == 0) ? t0 + 32 * w + r32 : (BR == 1) ? (t0 >> 2) + 32 * (w >> 2) + r32 : (t0 >> 4) + (r32 & 15);
    const int qc = (BR == 2) ? (r32 >> 4) : 0;
    bf16x8 qf[4];
    { const bf16* qp = Qb + (size_t)(t0 + qloc<BR>(w, r32)) * PQ + 8 * hi;
#pragma unroll
      for (int d0 = 0; d0 < 4; ++d0) qf[d0] = *(const bf16x8*)(qp + 16 * d0); }
    const int nt2 = ((t0 >> 4) + 16 + 31) >> 5;
    const int ntile = (BR == 2) ? 2 * nt2 : 5;
    const int kbase = (BR == 0) ? t0 + 32 * w - 128 : (BR == 1) ? (t0 >> 2) + 32 * (w >> 2) - 128 : 0;
    const int res01 = (BR == 1) ? (w & 3) : 0;
    int n = 0;
    if (BR != 2) { while (n < ntile && kbase + 32 * n + 31 < 0) ++n; }
#define MA_TILE(nn, cls_, k0_, res_) const int cls_ = (BR == 2) ? ((nn) >= nt2 ? 1 : 0) : 0; const int k0_ = (BR == 2) ? 32 * ((nn) - cls_ * nt2) : kbase + 32 * (nn); const int res_ = (BR == 2) ? 2 * w + cls_ : res01
#define MA_LOADS(kf_, vr_, k0_, res_) do { \
        int kj_ = k0_ + r32; kj_ = kj_ < 0 ? 0 : kj_; const bf16* kp_ = Kb + (size_t)(res_ + STRIDE * kj_) * PQ + 8 * hi; \
        _Pragma("unroll") for (int d0 = 0; d0 < 4; ++d0) kf_[d0] = *(const bf16x8*)(kp_ + 16 * d0); \
        int vj_ = k0_ + (lane >> 1); vj_ = vj_ < 0 ? 0 : vj_; const bf16* vp_ = Vb + (size_t)(res_ + STRIDE * vj_) * PQ + 32 * (lane & 1); \
        _Pragma("unroll") for (int c = 0; c < 4; ++c) vr_[c] = *(const u32x4*)(vp_ + 8 * c); } while (0)
    bf16x8 kfn[4]; u32x4 vrn[4];
    if (n < ntile) { MA_TILE(n, c0, k00, r00); MA_LOADS(kfn, vrn, k00, r00); }
    const int trb = ((lane >> 4) & 1) * 32 + (lane & 3) * 8 + (4 * hi + ((lane & 15) >> 2)) * 64;
    for (; n < ntile; ++n) {
        MA_TILE(n, cls, k0, res); (void)res;
        bf16x8 kf[4]; u32x4 vr[4];
#pragma unroll
        for (int c = 0; c < 4; ++c) { kf[c] = kfn[c]; vr[c] = vrn[c]; }
        asm volatile("" ::: "memory");
#pragma unroll
        for (int c = 0; c < 4; ++c) *(MA_LAS u32x4*)(img + (lane & 1) * 2048 + (lane >> 1) * 64 + c * 16) = vr[c];
        if (n + 1 < ntile) { MA_TILE(n + 1, c1, k01, r01); (void)c1; MA_LOADS(kfn, vrn, k01, r01); }
        f32x16 s = {};
#pragma unroll
        for (int d0 = 0; d0 < 4; ++d0) s = __builtin_amdgcn_mfma_f32_32x32x16_bf16(kf[d0], qf[d0], s, 0, 0, 0);
        const int dbase = k0 + 4 * hi - qi; const int lo = (-qi > -128) ? -qi : -128; const bool tok = (BR != 2) || (qc == cls);
        float tm = -INFINITY;
#pragma unroll
        for (int r = 0; r < 16; ++r) { const int d = dbase + (r & 3) + 8 * (r >> 2); s[r] = (tok && d <= 0 && d >= lo) ? s[r] : -INFINITY; tm = fmaxf(tm, s[r]); }
        tm = fmaxf(tm, __shfl_xor(tm, 32));
        const float mn = fmaxf(S.m, tm), sc = __builtin_amdgcn_exp2f(S.m - mn);
        float ps = 0.f;
#pragma unroll
        for (int r = 0; r < 16; ++r) { s[r] = __builtin_amdgcn_exp2f(s[r] - mn); ps += s[r]; }
        S.l = S.l * sc + ps; S.m = mn;
        if (__any(sc != 1.f)) {
            if (hi == 0) SC[r32] = sc;
            asm volatile("s_waitcnt lgkmcnt(0)" ::: "memory");
#pragma unroll
            for (int j = 0; j < 4; ++j) { const f32x4 f = *(const MA_LAS f32x4*)(SC + 8 * j + 4 * hi);
#pragma unroll
                for (int e = 0; e < 4; ++e) { S.o[0][4 * j + e] *= f[e]; S.o[1][4 * j + e] *= f[e]; } }
        }
        u32x4 p0, p1;
        p0[0] = cvtpk(s[0], s[1]); p0[1] = cvtpk(s[2], s[3]); p0[2] = cvtpk(s[4], s[5]); p0[3] = cvtpk(s[6], s[7]);
        p1[0] = cvtpk(s[8], s[9]); p1[1] = cvtpk(s[10], s[11]); p1[2] = cvtpk(s[12], s[13]); p1[3] = cvtpk(s[14], s[15]);
        const bf16x8 pa0 = __builtin_bit_cast(bf16x8, p0), pa1 = __builtin_bit_cast(bf16x8, p1);
        asm volatile("s_waitcnt lgkmcnt(0)" ::: "memory");
#pragma unroll
        for (int dh = 0; dh < 2; ++dh) {
#pragma unroll
            for (int ks = 0; ks < 2; ++ks) {
                const s16x4 vlo = __builtin_bit_cast(s16x4, __builtin_amdgcn_ds_read_tr16_b64_v4i16((MA_LAS v4i16_t*)(img + dh * 2048 + ks * 1024 + trb)));
                const s16x4 vhi = __builtin_bit_cast(s16x4, __builtin_amdgcn_ds_read_tr16_b64_v4i16((MA_LAS v4i16_t*)(img + dh * 2048 + ks * 1024 + 512 + trb)));
                const bf16x8 vf = (bf16x8){vlo[0], vlo[1], vlo[2], vlo[3], vhi[0], vhi[1], vhi[2], vhi[3]};
                S.o[dh] = __builtin_amdgcn_mfma_f32_32x32x16_bf16(ks == 0 ? pa0 : pa1, vf, S.o[dh], 0, 0, 0);
            }
        }
        asm volatile("s_waitcnt lgkmcnt(0)" ::: "memory");
    }
#undef MA_TILE
#undef MA_LOADS
}
__device__ __forceinline__ void unit(const bf16* QKV, bf16* Y, int b, int h, int t0, MA_LAS unsigned char* L, int tid) {
    const int lane = tid & 63, r32 = lane & 31, hi = lane >> 5; const int w = __builtin_amdgcn_readfirstlane(tid >> 6);
    const bf16* Qb = QKV + (size_t)b * TT * PQ + h * 64;
    State S; S.o[0] = f32x16{}; S.o[1] = f32x16{}; S.m = -1e30f; S.l = 0.f;
    branch<0>(S, Qb, t0, L, w, lane);
    xchg_write<0>(S, L, w, r32, hi); __syncthreads(); xchg_read<1>(S, L, w, r32, hi); __syncthreads();
    branch<1>(S, Qb, t0, L, w, lane);
    xchg_write<1>(S, L, w, r32, hi); __syncthreads(); xchg_read<2>(S, L, w, r32, hi); __syncthreads();
    branch<2>(S, Qb, t0, L, w, lane);
    { MA_LAS unsigned char* img = L + WV + w * WSZ; MA_LAS float* SC = (MA_LAS float*)(img + 4096);
      const float lt = S.l + __shfl_xor(S.l, 32);
      if (hi == 0) SC[r32] = 1.f / lt;
      asm volatile("s_waitcnt lgkmcnt(0)" ::: "memory");
      MA_LAS float* xo = (MA_LAS float*)(L + XO);
#pragma unroll
      for (int r = 0; r < 16; ++r) { const float f = SC[crow(r, hi)]; const int ql = qloc<2>(w, crow(r, hi)); xo[ql * 64 + r32] = S.o[0][r] * f; xo[ql * 64 + 32 + r32] = S.o[1][r] * f; } }
    __syncthreads();
    { const int row = tid >> 1, hf = tid & 1; const MA_LAS float* xr = (const MA_LAS float*)(L + XO) + row * 64 + 32 * hf;
      bf16* yp = Y + ((size_t)b * TT + t0 + row) * PY + h * 64 + 32 * hf;
#pragma unroll
      for (int c = 0; c < 4; ++c) { const f32x4 a = *(const MA_LAS f32x4*)(xr + 8 * c), bq = *(const MA_LAS f32x4*)(xr + 8 * c + 4);
          u32x4 o; o[0] = cvtpk(a[0], a[1]); o[1] = cvtpk(a[2], a[3]); o[2] = cvtpk(bq[0], bq[1]); o[3] = cvtpk(bq[2], bq[3]); *(u32x4*)(yp + 8 * c) = o; } }
    __syncthreads();
}
#undef MA_LAS
}
constexpr int NBATCH = 32, T = 2048, D = 1024, M = NBATCH * T, FF = 2816;
constexpr int NQKV = 3072, NGU = 2 * FF, NZX = 5888, NZX_SRC = 5656, KCD = 2048;
constexpr float RMS_EPS = 1e-6f;
constexpr int NWAVES = 8;
constexpr int NPH = 18;
constexpr size_t MiB = 1u << 20;
constexpr size_t WS_CTL = 0, CTL_ZERO_BYTES = 192 * 1024;
constexpr size_t WS_WDQ = 192 * 1024;
constexpr size_t DO_GATES = 0;
constexpr size_t DO_CS = 16 * MiB;
constexpr size_t WS_W_ABIN = 1 * MiB, WS_W_ABOUT = 7 * MiB, WS_W_GU0 = 9 * MiB, WS_W_DN0 = 20 * MiB, WS_W_CDIN = 26 * MiB, WS_W_CDOUT = 38 * MiB, WS_W_GU1 = 42 * MiB, WS_W_DN1 = 53 * MiB;
constexpr size_t WS_XN = 59 * MiB;
constexpr size_t WS_OB = 187 * MiB;
constexpr size_t WS_R = 315 * MiB;
constexpr size_t WS_QKV = WS_R, WS_ACT = WS_R, WS_U = WS_OB, WS_Z = WS_R, WS_XBC = WS_R + 128 * MiB, WS_V = WS_XBC + 192 * MiB, WS_O = WS_V + 128 * MiB, WS_YCD = WS_XN;
constexpr size_t WS_HB = WS_O + 128 * MiB;
constexpr size_t WS_RSS = WS_HB + 128 * MiB;
constexpr size_t WS_END = WS_RSS + 4 * MiB;
static_assert(WS_W_DN1 + (size_t)D * FF * 2 <= WS_XN && WS_W_CDIN + (size_t)NZX * D * 2 <= WS_W_CDOUT && WS_W_DN0 + (size_t)D * FF * 2 <= WS_W_CDIN, "weights map");
static_assert(WS_QKV + (size_t)M * NQKV * 2 <= WS_HB && WS_ACT + (size_t)M * FF * 2 <= WS_HB && WS_YCD + (size_t)M * KCD * 2 <= WS_R && WS_U + (size_t)M * D * 2 <= WS_R && WS_END <= 1024 * MiB, "activation map");
constexpr int CW_TMO = 0, CW_CODE = 1, CW_WMAX = 64, CW_BAR = 4096, CW_CMAX = 16384  ;
constexpr int RING_OFF = 0, RING_BYTES = 131072;
constexpr int LDSCTL_OFF = 147456 - 512, MISC_OFF = LDSCTL_OFF + 320;
constexpr int LDS_BYTES = 147456;
#define GAS __attribute__((address_space(1)))
#define LAS __attribute__((address_space(3)))
typedef unsigned short bf16;
typedef unsigned v4u __attribute__((ext_vector_type(4)));
typedef float f32x4 __attribute__((ext_vector_type(4)));
typedef short bf16x8 __attribute__((ext_vector_type(8)));
typedef GAS unsigned gu32;
typedef GAS unsigned long long gu64;
#define RLX_AGENT __ATOMIC_RELAXED, __HIP_MEMORY_SCOPE_AGENT
#define LDS_WAIT() asm volatile("s_waitcnt lgkmcnt(0)" ::: "memory")
#define VM_WAIT() asm volatile("s_waitcnt vmcnt(0)" ::: "memory")
__device__ __forceinline__ unsigned long long rt() { return __builtin_amdgcn_s_memrealtime(); }
__device__ __forceinline__ unsigned f2bf(float f) { unsigned u = __builtin_bit_cast(unsigned, f); return (u + 0x7fffu + ((u >> 16) & 1u)) >> 16; }
__device__ __forceinline__ unsigned pk2(float lo, float hi) { return f2bf(lo) | (f2bf(hi) << 16); }

#define XB_TMO      128
#define XB_XCNT(j)  (256  + 64 * (j))
#define XB_XSUB(j)  (1280 + 64 * (j))
#define XB_XGEN(j)  (2304 + 64 * (j))
#define XB_TOP      3328
#define XB_TOPGEN   3392
#define XCD_BAR_WORDS 3456
#define XB_SPIN_CAP (1u << 18)

__device__ __forceinline__ unsigned xb_ld(unsigned* p)              { return __hip_atomic_load(p, __ATOMIC_RELAXED, __HIP_MEMORY_SCOPE_AGENT); }
__device__ __forceinline__ unsigned xb_add(unsigned* p, unsigned v) { return __hip_atomic_fetch_add(p, v, __ATOMIC_RELAXED, __HIP_MEMORY_SCOPE_AGENT); }
__device__ __forceinline__ unsigned xb_xcc_id() { return (unsigned)__builtin_amdgcn_s_getreg((3 << 11) | 20) & 0xFu; }
#define XB_SPIN(cond, bar) do { unsigned _sp = 0; while (cond) { __builtin_amdgcn_s_sleep(1); \
    if ((++_sp & 255u) == 0u) { if (xb_ld(&(bar)[XB_TMO])) break; if (_sp > XB_SPIN_CAP) { atomicAdd(&(bar)[XB_TMO], 1u); break; } } } } while (0)

struct XcdBarrier {
    unsigned* bar; unsigned x;
    volatile LAS unsigned* st;
};

__device__ __forceinline__ XcdBarrier xcd_barrier_post(unsigned* bar, volatile LAS unsigned* st) {
    XcdBarrier b; b.bar = bar; b.x = xb_xcc_id(); b.st = st;
    if (threadIdx.x == 0) (void)xb_add(&bar[XB_XCNT(b.x)], 1u);
    return b;
}
__device__ __forceinline__ void xcd_barrier_complete(unsigned* bar, unsigned x, unsigned& nloc, unsigned& nx) {
    const unsigned G = gridDim.x * gridDim.y * gridDim.z;
    unsigned sum, cnt, mine, sp = 0u;
    for (;;) {
        sum = 0u; cnt = 0u; mine = 0u;
#pragma unroll
        for (unsigned j = 0; j < 16; ++j) { const unsigned c = xb_ld(&bar[XB_XCNT(j)]); sum += c; cnt += (c > 0u) ? 1u : 0u; mine = (j == x) ? c : mine; }
        if (sum == G) break;
        __builtin_amdgcn_s_sleep(1);
        if ((++sp & 255u) == 0u) { if (xb_ld(&bar[XB_TMO])) break; if (sp > XB_SPIN_CAP) { atomicAdd(&bar[XB_TMO], 1u); break; } }
    }
    nloc = mine > 0u ? mine : 1u; nx = cnt > 0u ? cnt : 1u;
}

__device__ __forceinline__ void xcd_barrier(const XcdBarrier& b) {
    asm volatile("s_waitcnt vmcnt(0)" ::: "memory");
    __syncthreads();
    if (threadIdx.x == 0) {
        unsigned* bar = b.bar;
        __builtin_amdgcn_s_waitcnt(0);
        unsigned nloc = b.st[0], nx = b.st[1];
        if (nloc == 0u) { xcd_barrier_complete(bar, b.x, nloc, nx); b.st[0] = nloc; b.st[1] = nx; }
        const unsigned old = xb_add(&bar[XB_XSUB(b.x)], 1u);
        const unsigned gen = old / nloc;
        if (old + 1u == (gen + 1u) * nloc) {
            __builtin_amdgcn_fence(__ATOMIC_RELEASE, "agent");
            asm volatile("s_waitcnt vmcnt(0)" ::: "memory");
            const unsigned og = xb_add(&bar[XB_TOP], 1u);
            const unsigned tg = og / nx;
            if (og + 1u == (tg + 1u) * nx) xb_add(&bar[XB_TOPGEN], 1u);
            else XB_SPIN(xb_ld(&bar[XB_TOPGEN]) == tg, bar);
            __builtin_amdgcn_fence(__ATOMIC_ACQUIRE, "agent");
            xb_add(&bar[XB_XGEN(b.x)], 1u);
            asm volatile("s_waitcnt vmcnt(0)" ::: "memory");
        } else {
            XB_SPIN(xb_ld(&bar[XB_XGEN(b.x)]) == gen, bar);
            __builtin_amdgcn_fence(__ATOMIC_ACQUIRE, "agent");
            asm volatile("s_waitcnt vmcnt(0)" ::: "memory");
        }
    }
    __syncthreads();
}
static_assert((CW_BAR + 2 * XCD_BAR_WORDS) * 4 <= (int)CTL_ZERO_BYTES, "CTL words inside the memset region");
typedef unsigned long long u64;
__device__ __forceinline__ float wave_sum(float v) {
#pragma unroll
    for (int o = 1; o < 64; o <<= 1) v += __shfl_xor(v, o);
    return v;
}
__device__ __forceinline__ float silu_g(float x) { return x * __builtin_amdgcn_rcpf(1.f + __expf(-x)); }
__device__ __forceinline__ float sigm_g(float x) { return __builtin_amdgcn_rcpf(1.f + __expf(-x)); }
__device__ __forceinline__ float bf2f(bf16 v) { return __uint_as_float((unsigned)v << 16); }
__device__ __forceinline__ void ld8f(const bf16* p, float* f) {
    const v4u v = *(const v4u*)p;
    f[0] = __uint_as_float(v.x << 16); f[1] = __uint_as_float(v.x & 0xffff0000u); f[2] = __uint_as_float(v.y << 16); f[3] = __uint_as_float(v.y & 0xffff0000u);
    f[4] = __uint_as_float(v.z << 16); f[5] = __uint_as_float(v.z & 0xffff0000u); f[6] = __uint_as_float(v.w << 16); f[7] = __uint_as_float(v.w & 0xffff0000u);
}
__device__ __forceinline__ void st8f(bf16* p, const float* f) { v4u o; o.x = pk2(f[0], f[1]); o.y = pk2(f[2], f[3]); o.z = pk2(f[4], f[5]); o.w = pk2(f[6], f[7]); *(v4u*)p = o; }

__device__ __forceinline__ int map_gu(int n) { const int p = n >> 8, r = n & 255; return r < 128 ? 128 * p + r : FF + 128 * p + (r - 128); }
__device__ __forceinline__ int map_cdin(int n) {
    if (n < 2560) return n; if (n < 3584) return 2576 + (n - 2560); if (n < 4608) return 3600 + (n - 3584); if (n < 5632) return 4624 + (n - 4608);
    const int j = n - 5632; if (j < 16) return 2560 + j; if (j < 24) return 5648 + (j - 16); return -1;
}
template <int MAP> __device__ __forceinline__ void tr_item(const float* W, int K, int Nsrc, bf16* WT, int nblk, LAS float* scr, int item, int lane, const float* nw = nullptr) {
    const int kb = item / nblk, nb = item % nblk, k0 = 64 * kb, n0 = 32 * nb;
    const int nd = n0 + (lane & 31); const int sc = (MAP == 0) ? nd : (MAP == 1) ? map_gu(nd) : map_cdin(nd);
#pragma unroll 8
    for (int i = 0; i < 32; ++i) { const int kk = 2 * i + (lane >> 5); scr[kk * 33 + (lane & 31)] = (sc >= 0) ? W[(size_t)(k0 + kk) * Nsrc + sc] * (nw ? nw[k0 + kk] : 1.f) : 0.f; }
    LDS_WAIT(); asm volatile("" ::: "memory");
    const int c = lane & 7;
#pragma unroll
    for (int j = 0; j < 4; ++j) { const int n = (lane >> 3) + 8 * j; const LAS float* s = scr + (8 * c) * 33 + n;
        v4u o; o.x = pk2(s[0 * 33], s[1 * 33]); o.y = pk2(s[2 * 33], s[3 * 33]); o.z = pk2(s[4 * 33], s[5 * 33]); o.w = pk2(s[6 * 33], s[7 * 33]);
        *(GAS v4u*)(WT + (size_t)(n0 + n) * K + k0 + 8 * c) = o; }
    LDS_WAIT(); asm volatile("" ::: "memory");
}
__device__ __forceinline__ void tr_item8(const float* W, int K, int Nsrc, unsigned char* WT, int nblk, LAS float* scr, int item, int lane, float sc) {
    const int kb = item / nblk, nb = item % nblk, k0 = 64 * kb, n0 = 32 * nb; const int nd = n0 + (lane & 31);
#pragma unroll 8
    for (int i = 0; i < 32; ++i) { const int kk = 2 * i + (lane >> 5); scr[kk * 33 + (lane & 31)] = W[(size_t)(k0 + kk) * Nsrc + nd] * sc; }
    LDS_WAIT(); asm volatile("" ::: "memory");
    const int c = lane & 7;
#pragma unroll
    for (int j = 0; j < 4; ++j) { const int n = (lane >> 3) + 8 * j; const LAS float* s = scr + (8 * c) * 33 + n;
        const u64 o = (u64)pg8::pk4_fp8(s[0 * 33], s[1 * 33], s[2 * 33], s[3 * 33]) | ((u64)pg8::pk4_fp8(s[4 * 33], s[5 * 33], s[6 * 33], s[7 * 33]) << 32);
        *(GAS u64*)(WT + (size_t)(n0 + n) * K + k0 + 8 * c) = o; }
    LDS_WAIT(); asm volatile("" ::: "memory");
}
__device__ __forceinline__ unsigned pk4_i8(float a, float b, float c, float d) {
    const int x = __float2int_rn(a), y = __float2int_rn(b), z = __float2int_rn(c), w = __float2int_rn(d);
    return (unsigned)(x & 255) | ((unsigned)(y & 255) << 8) | ((unsigned)(z & 255) << 16) | ((unsigned)w << 24);
}
template <int MAP> __device__ __forceinline__ void tr_item_i8(const float* W, int K, int Nsrc, unsigned char* WT, int nblk, LAS float* scr, int item, int lane, const unsigned* cmax, float* wdq) {
    const int kb = item / nblk, nb = item % nblk, k0 = 64 * kb, n0 = 32 * nb; const int nd = n0 + (lane & 31); const int scn = (MAP == 0) ? nd : (MAP == 1) ? map_gu(nd) : map_cdin(nd);
    const float cm = fmaxf(__uint_as_float(cmax[scn >= 0 ? scn : 0]), 1e-30f), sc = 127.f / cm;
    if (kb == 0 && lane < 32) wdq[nd] = (scn >= 0) ? cm * (1.f / 127.f) : 0.f;
#pragma unroll 8
    for (int i = 0; i < 32; ++i) { const int kk = 2 * i + (lane >> 5); scr[kk * 33 + (lane & 31)] = (scn >= 0) ? W[(size_t)(k0 + kk) * Nsrc + scn] * sc : 0.f; }
    LDS_WAIT(); asm volatile("" ::: "memory");
    const int c = lane & 7;
#pragma unroll
    for (int j = 0; j < 4; ++j) { const int n = (lane >> 3) + 8 * j; const LAS float* s = scr + (8 * c) * 33 + n;
        const u64 o = (u64)pk4_i8(s[0 * 33], s[1 * 33], s[2 * 33], s[3 * 33]) | ((u64)pk4_i8(s[4 * 33], s[5 * 33], s[6 * 33], s[7 * 33]) << 32);
        *(GAS u64*)(WT + (size_t)(n0 + n) * K + k0 + 8 * c) = o; }
    LDS_WAIT(); asm volatile("" ::: "memory");
}
__device__ __forceinline__ void wht16(float* v) {
#pragma unroll
    for (int h = 1; h < 16; h <<= 1)
#pragma unroll
        for (int i = 0; i < 16; ++i) if ((i & h) == 0) { const float a = v[i], b = v[i + h]; v[i] = a + b; v[i + h] = a - b; }
}
__device__ __forceinline__ void tr_item_i8rot(const float* W, int K, int Nsrc, unsigned char* WT, int nblk, LAS float* scr, int item, int lane, const unsigned* cmax, float* wdq) {
    const int kb = item / nblk, nb = item % nblk, k0 = 64 * kb, n0 = 32 * nb; const int nd = n0 + (lane & 31);
    const float cm = fmaxf(__uint_as_float(cmax[nd]), 1e-30f), sc = 0.25f * 127.f / cm;
    if (kb == 0 && lane < 32) wdq[nd] = cm * (1.f / 127.f);
#pragma unroll 8
    for (int i = 0; i < 32; ++i) { const int kk = 2 * i + (lane >> 5); scr[kk * 33 + (lane & 31)] = W[(size_t)(k0 + kk) * Nsrc + nd]; }
    LDS_WAIT(); asm volatile("" ::: "memory");
#pragma unroll 1
    for (int g2 = 0; g2 < 2; ++g2) { const int grp = (lane >> 5) + 2 * g2; LAS float* s = scr + (16 * grp) * 33 + (lane & 31); float v[16];
#pragma unroll
        for (int j = 0; j < 16; ++j) v[j] = s[j * 33];
        wht16(v);
#pragma unroll
        for (int j = 0; j < 16; ++j) s[j * 33] = v[j] * sc; }
    LDS_WAIT(); asm volatile("" ::: "memory");
    const int c = lane & 7;
#pragma unroll
    for (int j = 0; j < 4; ++j) { const int n = (lane >> 3) + 8 * j; const LAS float* s = scr + (8 * c) * 33 + n;
        const u64 o = (u64)pk4_i8(s[0 * 33], s[1 * 33], s[2 * 33], s[3 * 33]) | ((u64)pk4_i8(s[4 * 33], s[5 * 33], s[6 * 33], s[7 * 33]) << 32);
        *(GAS u64*)(WT + (size_t)(n0 + n) * K + k0 + 8 * c) = o; }
    LDS_WAIT(); asm volatile("" ::: "memory");
}
__device__ __forceinline__ void act_row_rot_i8(const bf16* arow, unsigned char* orow, float* dq, int lane) {
    float v[3][16]; float am = 0.f;
#pragma unroll
    for (int i = 0; i < 3; ++i) { const int blk = lane + 64 * i;
        if (blk < FF / 16) { ld8f(arow + blk * 16, v[i]); ld8f(arow + blk * 16 + 8, v[i] + 8); wht16(v[i]);
#pragma unroll
            for (int e = 0; e < 16; ++e) { v[i][e] *= 0.25f; am = fmaxf(am, fabsf(v[i][e])); } } }
#pragma unroll
    for (int o = 1; o < 64; o <<= 1) am = fmaxf(am, __shfl_xor(am, o));
    am = fmaxf(am, 1e-20f); const float sc = 127.f / am;
#pragma unroll
    for (int i = 0; i < 3; ++i) { const int blk = lane + 64 * i;
        if (blk < FF / 16) { v4u q; q.x = pk4_i8(v[i][0] * sc, v[i][1] * sc, v[i][2] * sc, v[i][3] * sc); q.y = pk4_i8(v[i][4] * sc, v[i][5] * sc, v[i][6] * sc, v[i][7] * sc);
            q.z = pk4_i8(v[i][8] * sc, v[i][9] * sc, v[i][10] * sc, v[i][11] * sc); q.w = pk4_i8(v[i][12] * sc, v[i][13] * sc, v[i][14] * sc, v[i][15] * sc);
            *(v4u*)(orow + blk * 16) = q; } }
    if (lane == 0) dq[0] = am * (1.f / 127.f);
}
__device__ __forceinline__ void rms_row_i8(const bf16* hrow, const float* w, unsigned char* orow, float* dq, int lane) {
    float h[16]; ld8f(hrow + lane * 16, h); ld8f(hrow + lane * 16 + 8, h + 8);
    float s = 0.f;
#pragma unroll
    for (int e = 0; e < 16; ++e) s += h[e] * h[e];
    const float rstd = 1.f / sqrtf(wave_sum(s) * (1.f / D) + RMS_EPS);
    float am = 0.f;
#pragma unroll
    for (int j = 0; j < 4; ++j) { const f32x4 g = *(const f32x4*)(w + lane * 16 + 4 * j); h[4 * j] *= rstd * g.x; h[4 * j + 1] *= rstd * g.y; h[4 * j + 2] *= rstd * g.z; h[4 * j + 3] *= rstd * g.w;
        am = fmaxf(fmaxf(am, fmaxf(fabsf(h[4 * j]), fabsf(h[4 * j + 1]))), fmaxf(fabsf(h[4 * j + 2]), fabsf(h[4 * j + 3]))); }
#pragma unroll
    for (int o = 1; o < 64; o <<= 1) am = fmaxf(am, __shfl_xor(am, o));
    am = fmaxf(am, 1e-20f); const float sc = 127.f / am;
    v4u q; q.x = pk4_i8(h[0] * sc, h[1] * sc, h[2] * sc, h[3] * sc); q.y = pk4_i8(h[4] * sc, h[5] * sc, h[6] * sc, h[7] * sc); q.z = pk4_i8(h[8] * sc, h[9] * sc, h[10] * sc, h[11] * sc); q.w = pk4_i8(h[12] * sc, h[13] * sc, h[14] * sc, h[15] * sc);
    *(v4u*)(orow + lane * 16) = q;
    if (lane == 0) dq[0] = am * (1.f / 127.f);
}
__device__ __forceinline__ void rms_row_to_bf16(const float* xrow, const float* w, bf16* orow, int lane) {
    const f32x4* xr = (const f32x4*)xrow + lane; const f32x4* wr = (const f32x4*)w + lane;
    f32x4 v[4]; float s = 0.f;
#pragma unroll
    for (int j = 0; j < 4; ++j) { v[j] = xr[64 * j]; s += (v[j].x * v[j].x + v[j].y * v[j].y) + (v[j].z * v[j].z + v[j].w * v[j].w); }
    const float rstd = 1.f / sqrtf(wave_sum(s) * (1.f / D) + RMS_EPS);
    u64* o8 = (u64*)orow + lane;
#pragma unroll
    for (int j = 0; j < 4; ++j) { const f32x4 g = wr[64 * j]; o8[64 * j] = (u64)pk2(v[j].x * rstd * g.x, v[j].y * rstd * g.y) | ((u64)pk2(v[j].z * rstd * g.z, v[j].w * rstd * g.w) << 32); }
}
__device__ __forceinline__ void rms_row_bf16(const bf16* hrow, const float* w, bf16* orow, int lane) {
    float h[16]; ld8f(hrow + lane * 16, h); ld8f(hrow + lane * 16 + 8, h + 8);
    float s = 0.f;
#pragma unroll
    for (int e = 0; e < 16; ++e) s += h[e] * h[e];
    const float rstd = 1.f / sqrtf(wave_sum(s) * (1.f / D) + RMS_EPS);
#pragma unroll
    for (int j = 0; j < 4; ++j) { const f32x4 g = *(const f32x4*)(w + lane * 16 + 4 * j); h[4 * j] *= rstd * g.x; h[4 * j + 1] *= rstd * g.y; h[4 * j + 2] *= rstd * g.z; h[4 * j + 3] *= rstd * g.w; }
    st8f(orow + lane * 16, h); st8f(orow + lane * 16 + 8, h + 8);
}
__device__ __forceinline__ void final_row(const bf16* hrow, const float* w, float* orow, int lane) {
    float h[16]; ld8f(hrow + lane * 16, h); ld8f(hrow + lane * 16 + 8, h + 8);
    float s = 0.f;
#pragma unroll
    for (int e = 0; e < 16; ++e) s += h[e] * h[e];
    const float rstd = 1.f / sqrtf(wave_sum(s) * (1.f / D) + RMS_EPS);
#pragma unroll
    for (int j = 0; j < 4; ++j) { const f32x4 g = *(const f32x4*)(w + lane * 16 + 4 * j); *(f32x4*)(orow + lane * 16 + 4 * j) = (f32x4){h[4 * j] * rstd * g.x, h[4 * j + 1] * rstd * g.y, h[4 * j + 2] * rstd * g.z, h[4 * j + 3] * rstd * g.w}; }
}
__device__ __forceinline__ void rms_row_inplace_f32(float* xrow, const float* w, int lane) {
    f32x4* xr = (f32x4*)xrow + lane; const f32x4* wr = (const f32x4*)w + lane;
    f32x4 v[4]; float s = 0.f;
#pragma unroll
    for (int j = 0; j < 4; ++j) { v[j] = xr[64 * j]; s += (v[j].x * v[j].x + v[j].y * v[j].y) + (v[j].z * v[j].z + v[j].w * v[j].w); }
    const float rstd = 1.f / sqrtf(wave_sum(s) * (1.f / D) + RMS_EPS);
#pragma unroll
    for (int j = 0; j < 4; ++j) { const f32x4 g = wr[64 * j]; xr[64 * j] = v[j] * rstd * g; }
}

__device__ __forceinline__ void attnA_naive_item(const bf16* QKV, bf16* Y, int b, int h, int tb, int lane) {
    const int t = tb * 64 + lane; const size_t row = (size_t)b * T + t;
    float q[64], o[64];
#pragma unroll
    for (int c = 0; c < 8; ++c) ld8f(QKV + row * NQKV + h * 64 + 8 * c, q + 8 * c);
#pragma unroll
    for (int e = 0; e < 64; ++e) { q[e] *= 0.125f; o[e] = 0.f; }
    float m = -1e30f, l = 0.f;
#define A_KEY(tk, cw) do { const bf16* kr = QKV + ((size_t)b * T + (tk)) * NQKV + 512 + h * 64; float s = 0.f; \
    _Pragma("unroll") for (int c = 0; c < 8; ++c) { float kf[8]; ld8f(kr + 8 * c, kf); _Pragma("unroll") for (int e = 0; e < 8; ++e) s += q[8 * c + e] * kf[e]; } \
    const float mn = fmaxf(m, s); const float sc = __expf(m - mn); const float p = (cw) * __expf(s - mn); l = l * sc + p; m = mn; \
    const bf16* vr = kr + 512; \
    _Pragma("unroll") for (int c = 0; c < 8; ++c) { float vf[8]; ld8f(vr + 8 * c, vf); _Pragma("unroll") for (int e = 0; e < 8; ++e) o[8 * c + e] = o[8 * c + e] * sc + p * vf[e]; } } while (0)
    for (int d = 0; d <= 128 && d <= t; ++d) { const float cw = 1.f + ((d & 3) == 0 ? 1.f : 0.f) + ((d & 15) == 0 ? 1.f : 0.f); A_KEY(t - d, cw); }
    for (int d = 132; d <= 512 && d <= t; d += 4) { const float cw = 1.f + ((d & 15) == 0 ? 1.f : 0.f); A_KEY(t - d, cw); }
    for (int d = 528; d <= t; d += 16) { A_KEY(t - d, 1.f); }
#undef A_KEY
    const float il = 1.f / l;
#pragma unroll
    for (int e = 0; e < 64; ++e) o[e] *= il;
#pragma unroll
    for (int c = 0; c < 8; ++c) st8f(Y + row * D + h * 64 + 8 * c, o + 8 * c);
}
__device__ __forceinline__ void attnB_naive_item(const bf16* QKV, bf16* OB, int b, int hv, int tb, int lane, float qscale) {
    const int h = hv >> 2, c2 = (hv >> 1) & 1, vh = hv & 1;
    const bf16* Qp = QKV + 1536 + h * 128 + c2 * 64; const bf16* Kp = QKV + 2048 + h * 128 + c2 * 64; const bf16* Vp = QKV + 2560 + h * 128 + vh * 64;
    const int t = tb * 64 + lane; const size_t row = (size_t)b * T + t;
    float q[64], o[64];
#pragma unroll
    for (int c = 0; c < 8; ++c) ld8f(Qp + row * NQKV + 8 * c, q + 8 * c);
#pragma unroll
    for (int e = 0; e < 64; ++e) { q[e] *= qscale; o[e] = 0.f; }
    float m = -1e30f, l = 0.f;
    const int nk = tb * 64 + 64;
    for (int kk = 0; kk < nk; ++kk) {
        const bf16* kr = Kp + ((size_t)b * T + kk) * NQKV; float s = 0.f;
#pragma unroll
        for (int c = 0; c < 8; ++c) { float kf[8]; ld8f(kr + 8 * c, kf);
#pragma unroll
            for (int e = 0; e < 8; ++e) s += q[8 * c + e] * kf[e]; }
        const bool valid = kk <= t; const float sv = valid ? s : -1e30f;
        const float mn = fmaxf(m, sv); const float sc = __expf(m - mn); const float p = valid ? __expf(sv - mn) : 0.f; l = l * sc + p; m = mn;
        const bf16* vr = Vp + ((size_t)b * T + kk) * NQKV;
#pragma unroll
        for (int c = 0; c < 8; ++c) { float vf[8]; ld8f(vr + 8 * c, vf);
#pragma unroll
            for (int e = 0; e < 8; ++e) o[8 * c + e] = o[8 * c + e] * sc + p * vf[e]; }
    }
    const float il = 1.f / l;
#pragma unroll
    for (int e = 0; e < 64; ++e) o[e] *= il;
#pragma unroll
    for (int c = 0; c < 8; ++c) st8f(OB + row * D + hv * 64 + 8 * c, o + 8 * c);
}
__device__ __forceinline__ void attnB_post_row(const bf16* OB, bf16* Y, const float* subw, float lam, float outscale, size_t row, int lane) {
    const int h = lane >> 4, sub = lane & 15, vh = sub >> 3, d0 = (sub & 7) * 8;
    float a[8], b[8], r[8];
    ld8f(OB + row * D + ((h * 2 + 0) * 2 + vh) * 64 + d0, a); ld8f(OB + row * D + ((h * 2 + 1) * 2 + vh) * 64 + d0, b);
    float ss = 0.f;
#pragma unroll
    for (int e = 0; e < 8; ++e) { r[e] = a[e] - lam * b[e]; ss += r[e] * r[e]; }
    ss += __shfl_xor(ss, 1); ss += __shfl_xor(ss, 2); ss += __shfl_xor(ss, 4); ss += __shfl_xor(ss, 8);
    const float rstd = 1.f / sqrtf(ss * (1.f / 128.f) + RMS_EPS);
    const int dv = vh * 64 + d0;
#pragma unroll
    for (int e = 0; e < 8; ++e) r[e] = r[e] * rstd * subw[dv + e] * outscale;
    st8f(Y + row * D + 512 + h * 128 + dv, r);
}
template <int MODE> __device__ __forceinline__ void conv_unit(bf16* X, int pitch, int c0, const float* cw, int cwp, const float* cb, int b, int tid, const float* wq, const float* wk, bf16* KB) {
    const int oct = tid & 15, seg = tid >> 4, ch = c0 + 8 * oct;
    float w0[8], w1[8], w2[8], w3[8], bs[8], h0[8], h1[8], h2[8];
#pragma unroll
    for (int e = 0; e < 8; ++e) { w0[e] = cw[ch + e]; w1[e] = cw[cwp + ch + e]; w2[e] = cw[2 * cwp + ch + e]; w3[e] = cw[3 * cwp + ch + e]; bs[e] = cb[ch + e]; }
    bf16* base = X + ((size_t)b * T + seg * 64) * pitch + ch;
    if (seg == 0) {
#pragma unroll
        for (int e = 0; e < 8; ++e) { h0[e] = 0.f; h1[e] = 0.f; h2[e] = 0.f; }
    } else { ld8f(base - 3 * (size_t)pitch, h0); ld8f(base - 2 * (size_t)pitch, h1); ld8f(base - (size_t)pitch, h2); }
    float wqv[2][4][4], wkv[2][4][4];
    if (MODE == 1) {
#pragma unroll
        for (int a = 0; a < 2; ++a)
#pragma unroll
            for (int j = 0; j < 4; ++j)
#pragma unroll
                for (int i = 0; i < 4; ++i) { const int nb = (ch >> 2) + a; wqv[a][j][i] = wq[(nb * 4 + j) * 4 + i]; wkv[a][j][i] = wk[(nb * 4 + j) * 4 + i] * 0.0625f; }
    }
    __syncthreads();
#pragma unroll 4
    for (int s = 0; s < 64; ++s) {
        float raw[8], o[8];
        ld8f(base + (size_t)s * pitch, raw);
#pragma unroll
        for (int e = 0; e < 8; ++e) { const float v = w0[e] * h0[e] + w1[e] * h1[e] + w2[e] * h2[e] + w3[e] * raw[e] + bs[e]; o[e] = silu_g(v); h0[e] = h1[e]; h1[e] = h2[e]; h2[e] = raw[e]; }
        if (MODE == 0) st8f(base + (size_t)s * pitch, o);
        else {
            float q[8], k[8];
#pragma unroll
            for (int a = 0; a < 2; ++a)
#pragma unroll
                for (int i = 0; i < 4; ++i) { float qa = 0.f, ka = 0.f;
#pragma unroll
                    for (int j = 0; j < 4; ++j) { qa += o[4 * a + j] * wqv[a][j][i]; ka += o[4 * a + j] * wkv[a][j][i]; }
                    q[4 * a + i] = qa; k[4 * a + i] = ka; }
            st8f(base + (size_t)s * pitch, q); st8f(KB + ((size_t)b * T + seg * 64 + s) * D + ch, k);
        }
    }
    __syncthreads();
}
namespace mam {
using bf16x8 = __attribute__((ext_vector_type(8))) short;
using s16x4 = __attribute__((ext_vector_type(4))) short;
using f32x16 = __attribute__((ext_vector_type(16))) float;
using f32x4 = __attribute__((ext_vector_type(4))) float;
using u32x4 = __attribute__((ext_vector_type(4))) unsigned;
using u32x2 = __attribute__((ext_vector_type(2))) unsigned;
typedef short v4i16_t __attribute__((ext_vector_type(4)));
#define MM_LAS __attribute__((address_space(3)))
typedef unsigned short bf16;
constexpr int PXBC = 1536, TT = 2048;
constexpr int PB = 272, PX = 144, PS = 272;
constexpr int LB = 0, LC = LB + 128 * PB, LX = LC + 128 * PB, LS = LX + 2 * 128 * PX, LV = LS + 2 * 64 * PS, VSZ = 5 * 512;
constexpr int LDS_NEED = LV + 2 * VSZ;
__device__ __forceinline__ int crow(int r, int hi) { return (r & 3) + 8 * (r >> 2) + 4 * hi; }
__device__ __forceinline__ unsigned cvtpk(float lo, float hi) { typedef float f2 __attribute__((ext_vector_type(2))); typedef __bf16 b2 __attribute__((ext_vector_type(2))); f2 v = {lo, hi}; b2 b = __builtin_convertvector(v, b2); return __builtin_bit_cast(unsigned, b); }
__device__ __forceinline__ bf16x8 trfrag(const MM_LAS unsigned char* p, int rowpitch8) {
    const s16x4 lo = __builtin_bit_cast(s16x4, __builtin_amdgcn_ds_read_tr16_b64_v4i16((MM_LAS v4i16_t*)p));
    const s16x4 hi = __builtin_bit_cast(s16x4, __builtin_amdgcn_ds_read_tr16_b64_v4i16((MM_LAS v4i16_t*)(p + rowpitch8)));
    return (bf16x8){lo[0], lo[1], lo[2], lo[3], hi[0], hi[1], hi[2], hi[3]};
}
__device__ __forceinline__ void unit(bf16* XBC, const float* GT, const float* dtb, const float* alog, const float* dsk, int b, int g, int hp, MM_LAS unsigned char* L, int tid) {
    const int lane = tid & 63, r32 = lane & 31, hi = lane >> 5; const int w = __builtin_amdgcn_readfirstlane(tid >> 6);
    const int hh = w >> 2, it = hh ? 3 - (w & 3) : (w & 3), head = g * 8 + 2 * hp + hh;
    const float a_neg = -expf(alog[head]), dskh = dsk[head];
    const int q4 = (lane & 15) >> 2, p4 = lane & 3, blk = (lane >> 4) & 1;
    MM_LAS float* V = (MM_LAS float*)(L + LV + hh * VSZ);
    f32x16 st[2]; st[0] = f32x16{}; st[1] = f32x16{};
    for (int i = tid; i < 2 * 64 * PS / 4; i += 512) ((MM_LAS unsigned*)(L + LS))[i] = 0u;
    const unsigned sgo = (unsigned)(tid >> 4) * (PXBC * 2) + (unsigned)(tid & 15) * 16;
    const unsigned slo = (unsigned)(tid >> 4) * PB + (unsigned)(tid & 15) * 16;
    const unsigned sxo = (unsigned)((tid & 15) >> 3) * 128 * PX + (unsigned)(tid >> 4) * PX + (unsigned)(tid & 7) * 16;
    u32x4 tb[4], tc[4], tx[4];
    { const unsigned char* g0 = (const unsigned char*)(XBC + (size_t)b * TT * PXBC);
#pragma unroll
      for (int q = 0; q < 4; ++q) { tb[q] = *(const u32x4*)(g0 + (size_t)q * (32 * PXBC * 2) + (1024 + g * 128) * 2 + sgo); tc[q] = *(const u32x4*)(g0 + (size_t)q * (32 * PXBC * 2) + (1280 + g * 128) * 2 + sgo);
          tx[q] = *(const u32x4*)(g0 + (size_t)q * (32 * PXBC * 2) + ((g * 8 + 2 * hp) * 64) * 2 + sgo); } }
    for (int c = 0; c < 16; ++c) {
        const size_t row0 = (size_t)b * TT + c * 128;
        __syncthreads();
#pragma unroll
        for (int q = 0; q < 4; ++q) { *(MM_LAS u32x4*)(L + LB + q * (32 * PB) + slo) = tb[q]; *(MM_LAS u32x4*)(L + LC + q * (32 * PB) + slo) = tc[q]; *(MM_LAS u32x4*)(L + LX + q * (32 * PX) + sxo) = tx[q]; }
        if ((w & 3) == 0) {
            const float x0 = GT[(row0 + 2 * lane) * 32 + head] + dtb[head], x1 = GT[(row0 + 2 * lane + 1) * 32 + head] + dtb[head];
            const float dt0 = x0 > 20.f ? x0 : log1pf(expf(x0)), dt1 = x1 > 20.f ? x1 : log1pf(expf(x1));
            const float v0 = dt0 * a_neg, v1 = dt1 * a_neg, ps = v0 + v1; float inc = ps;
#pragma unroll
            for (int o = 1; o < 64; o <<= 1) { const float t = __shfl_up(inc, o); if (lane >= o) inc += t; }
            const float ac0 = inc - ps + v0, ac1 = inc, aend = __shfl(inc, 63);
            V[2 * lane] = dt0; V[2 * lane + 1] = dt1; V[128 + 2 * lane] = ac0 * 1.4426950408889634f; V[128 + 2 * lane + 1] = ac1 * 1.4426950408889634f;
            V[256 + 2 * lane] = dt0 * expf(aend - ac0); V[256 + 2 * lane + 1] = dt1 * expf(aend - ac1); V[384 + 2 * lane] = expf(ac0); V[384 + 2 * lane + 1] = expf(ac1);
            if (lane == 0) V[512] = expf(aend);
        }
        __syncthreads();
        if (c < 15) { const unsigned char* g0 = (const unsigned char*)(XBC + (row0 + 128) * PXBC);
#pragma unroll
            for (int q = 0; q < 4; ++q) { tb[q] = *(const u32x4*)(g0 + (size_t)q * (32 * PXBC * 2) + (1024 + g * 128) * 2 + sgo); tc[q] = *(const u32x4*)(g0 + (size_t)q * (32 * PXBC * 2) + (1280 + g * 128) * 2 + sgo);
                tx[q] = *(const u32x4*)(g0 + (size_t)q * (32 * PXBC * 2) + ((g * 8 + 2 * hp) * 64) * 2 + sgo); } }
        const MM_LAS unsigned char* cfp = L + LC + (32 * it + r32) * PB + 8 * hi * 2;
#define MM_CF(kn) (*(const MM_LAS bf16x8*)(cfp + 32 * (kn)))
        f32x16 yd[2]; yd[0] = f32x16{}; yd[1] = f32x16{};
#pragma unroll
        for (int pt = 0; pt < 2; ++pt)
#pragma unroll
            for (int kn = 0; kn < 8; ++kn) { const bf16x8 sf = *(const MM_LAS bf16x8*)(L + LS + hh * 64 * PS + (32 * pt + r32) * PS + (16 * kn + 8 * hi) * 2);
                yd[pt] = __builtin_amdgcn_mfma_f32_32x32x16_bf16(MM_CF(kn), sf, yd[pt], 0, 0, 0); }
#pragma unroll
        for (int jj = 0; jj < 4; ++jj) { const f32x4 ea = *(const MM_LAS f32x4*)(V + 384 + 32 * it + 8 * jj + 4 * hi);
#pragma unroll
            for (int e = 0; e < 4; ++e) { yd[0][4 * jj + e] *= ea[e]; yd[1][4 * jj + e] *= ea[e]; } }
        const float a2l = V[128 + 32 * it + r32];
        const MM_LAS unsigned char* xbase = L + LX + hh * 128 * PX + (4 * hi + q4) * PX + blk * 32 + 8 * p4;
        for (int j = 0; j <= it; ++j) {
            f32x16 X = {};
            unsigned cfo = (unsigned)((32 * it + r32) * PB + 16 * hi); asm volatile("" : "+v"(cfo));
#pragma unroll
            for (int kn = 0; kn < 8; ++kn) { const bf16x8 bfr = *(const MM_LAS bf16x8*)(L + LB + (32 * j + r32) * PB + (16 * kn + 8 * hi) * 2);
                X = __builtin_amdgcn_mfma_f32_32x32x16_bf16(bfr, *(const MM_LAS bf16x8*)(L + LC + cfo + 32 * kn), X, 0, 0, 0); }
#pragma unroll
            for (int jj = 0; jj < 4; ++jj) { const f32x4 a2s = *(const MM_LAS f32x4*)(V + 128 + 32 * j + 8 * jj + 4 * hi), dts = *(const MM_LAS f32x4*)(V + 32 * j + 8 * jj + 4 * hi);
#pragma unroll
                for (int e = 0; e < 4; ++e) { const int r = 4 * jj + e; const bool ok = (j < it) || (8 * jj + 4 * hi + e <= r32);
                    X[r] = ok ? X[r] * __builtin_amdgcn_exp2f(a2l - a2s[e]) * dts[e] : 0.f; } }
            u32x4 p0, p1;
            p0[0] = cvtpk(X[0], X[1]); p0[1] = cvtpk(X[2], X[3]); p0[2] = cvtpk(X[4], X[5]); p0[3] = cvtpk(X[6], X[7]);
            p1[0] = cvtpk(X[8], X[9]); p1[1] = cvtpk(X[10], X[11]); p1[2] = cvtpk(X[12], X[13]); p1[3] = cvtpk(X[14], X[15]);
            const bf16x8 pa0 = __builtin_bit_cast(bf16x8, p0), pa1 = __builtin_bit_cast(bf16x8, p1);
#pragma unroll
            for (int pt = 0; pt < 2; ++pt)
#pragma unroll
                for (int ks = 0; ks < 2; ++ks) { const bf16x8 xf = trfrag(xbase + (32 * j + 16 * ks) * PX + pt * 64, 8 * PX);
                    yd[pt] = __builtin_amdgcn_mfma_f32_32x32x16_bf16(ks == 0 ? pa0 : pa1, xf, yd[pt], 0, 0, 0); }
        }
        { const float eend = V[512];
#pragma unroll
          for (int r = 0; r < 16; ++r) { st[0][r] *= eend; st[1][r] *= eend; } }
        const MM_LAS unsigned char* bbase = L + LB + (4 * hi + q4) * PB + (32 * it + 16 * blk) * 2 + 8 * p4;
#pragma unroll
        for (int ks = 0; ks < 8; ++ks) {
            const bf16x8 bt = trfrag(bbase + 16 * ks * PB, 8 * PB);
            const f32x4 c0 = *(const MM_LAS f32x4*)(V + 256 + 16 * ks + 4 * hi), c1 = *(const MM_LAS f32x4*)(V + 256 + 16 * ks + 8 + 4 * hi);
            float f[8];
#pragma unroll
            for (int e = 0; e < 4; ++e) { f[e] = __uint_as_float((unsigned)(unsigned short)bt[e] << 16) * c0[e]; f[4 + e] = __uint_as_float((unsigned)(unsigned short)bt[4 + e] << 16) * c1[e]; }
            u32x4 pk; pk[0] = cvtpk(f[0], f[1]); pk[1] = cvtpk(f[2], f[3]); pk[2] = cvtpk(f[4], f[5]); pk[3] = cvtpk(f[6], f[7]);
            const bf16x8 af = __builtin_bit_cast(bf16x8, pk);
#pragma unroll
            for (int pt = 0; pt < 2; ++pt) { const bf16x8 xf = trfrag(xbase + 16 * ks * PX + pt * 64, 8 * PX); st[pt] = __builtin_amdgcn_mfma_f32_32x32x16_bf16(af, xf, st[pt], 0, 0, 0); }
        }
#pragma unroll
        for (int r = 0; r < 16; ++r) { const int l = 32 * it + crow(r, hi);
#pragma unroll
            for (int pt = 0; pt < 2; ++pt) { const float xv = __uint_as_float((unsigned)*(const MM_LAS unsigned short*)(L + LX + hh * 128 * PX + l * PX + (32 * pt + r32) * 2) << 16);
                const float y = yd[pt][r] + dskh * xv;
                XBC[(row0 + l) * PXBC + head * 64 + 32 * pt + r32] = (bf16)(cvtpk(y, 0.f) & 0xffffu); } }
        __syncthreads();
#pragma unroll
        for (int pt = 0; pt < 2; ++pt) {
#pragma unroll
            for (int jj = 0; jj < 4; ++jj) { u32x2 o; o[0] = cvtpk(st[pt][4 * jj], st[pt][4 * jj + 1]); o[1] = cvtpk(st[pt][4 * jj + 2], st[pt][4 * jj + 3]);
                *(MM_LAS u32x2*)(L + LS + hh * 64 * PS + (32 * pt + r32) * PS + (32 * it + 8 * jj + 4 * hi) * 2) = o; }
        }
    }
    __syncthreads();
}
#undef MM_CF
#undef MM_LAS
}
namespace mls {
using bf16x8 = __attribute__((ext_vector_type(8))) short;
using s16x4 = __attribute__((ext_vector_type(4))) short;
using f32x16 = __attribute__((ext_vector_type(16))) float;
using f32x4 = __attribute__((ext_vector_type(4))) float;
using u32x4 = __attribute__((ext_vector_type(4))) unsigned;
using u32x2 = __attribute__((ext_vector_type(2))) unsigned;
typedef short v4i16_t __attribute__((ext_vector_type(4)));
#define ML_LAS __attribute__((address_space(3)))
typedef unsigned short bf16;
constexpr int PD = 1024, TT = 2048;
constexpr int PK = 528, PV = 272;
constexpr int LK = 0, LVV = LK + 128 * PK, LG = LVV + 128 * PV, GSZ = 5 * 512, LN = LG + 2 * GSZ, LW = LN + 1024, LDS_NEED = LW + 8 * 256;
constexpr float LOG2E = 1.4426950408889634f;
__device__ __forceinline__ int crow(int r, int hi) { return (r & 3) + 8 * (r >> 2) + 4 * hi; }
__device__ __forceinline__ unsigned cvtpk(float lo, float hi) { typedef float f2 __attribute__((ext_vector_type(2))); typedef __bf16 b2 __attribute__((ext_vector_type(2))); f2 v = {lo, hi}; b2 b = __builtin_convertvector(v, b2); return __builtin_bit_cast(unsigned, b); }
__device__ __forceinline__ float bfx(short v) { return __uint_as_float((unsigned)(unsigned short)v << 16); }
__device__ __forceinline__ bf16x8 trfrag(const ML_LAS unsigned char* p, int rowpitch8) {
    const s16x4 lo = __builtin_bit_cast(s16x4, __builtin_amdgcn_ds_read_tr16_b64_v4i16((ML_LAS v4i16_t*)p));
    const s16x4 hi = __builtin_bit_cast(s16x4, __builtin_amdgcn_ds_read_tr16_b64_v4i16((ML_LAS v4i16_t*)(p + rowpitch8)));
    return (bf16x8){lo[0], lo[1], lo[2], lo[3], hi[0], hi[1], hi[2], hi[3]};
}
__device__ __forceinline__ void gate_vectors(ML_LAS float* gv, const float* GT, size_t row0, int h, float ibh, float fbh, float m_in, int lane) {
    const float* gb = GT + row0 * 32 + h; const unsigned go = (unsigned)lane * 64u;
    const float xi0 = gb[go + 16] + ibh, xi1 = gb[go + 48] + ibh;
    const float xf0 = gb[go + 20] + fbh, xf1 = gb[go + 52] + fbh;
    const float lf0 = xf0 > 0.f ? -log1pf(expf(-xf0)) : xf0 - log1pf(expf(xf0)), lf1 = xf1 > 0.f ? -log1pf(expf(-xf1)) : xf1 - log1pf(expf(xf1));
    const float ps = lf0 + lf1; float inc = ps;
#pragma unroll
    for (int o = 1; o < 64; o <<= 1) { const float t = __shfl_up(inc, o); if (lane >= o) inc += t; }
    const float bc0 = inc - ps + lf0, bc1 = inc, g0 = xi0 - bc0, g1 = xi1 - bc1;
    float pmx = fmaxf(g0, g1);
#pragma unroll
    for (int o = 1; o < 64; o <<= 1) { const float t = __shfl_up(pmx, o); if (lane >= o) pmx = fmaxf(pmx, t); }
    float pex = __shfl_up(pmx, 1); if (lane == 0) pex = -INFINITY;
    const float gtot0 = __shfl(inc, 63), pm127 = __shfl(pmx, 63), mm0 = fmaxf(m_in, pm127);
    gv[2 * lane] = g0 * LOG2E; gv[2 * lane + 1] = g1 * LOG2E; gv[128 + 2 * lane] = fmaxf(pex, g0); gv[128 + 2 * lane + 1] = pmx; gv[256 + 2 * lane] = bc0; gv[256 + 2 * lane + 1] = bc1;
    gv[384 + 2 * lane] = expf(g0 - mm0); gv[384 + 2 * lane + 1] = expf(g1 - mm0);
    if (lane == 0) { gv[512] = gtot0; gv[513] = pm127; }
}
__device__ __forceinline__ void unit(const bf16* Qg, const bf16* Kg, bf16* Vg, bf16* CS, const float* GT, const float* ib, const float* fb, int b, int h, int vh, ML_LAS unsigned char* L, int tid) {
    const int lane = tid & 63, r32 = lane & 31, hi = lane >> 5; const int w = __builtin_amdgcn_readfirstlane(tid >> 6);
    const int q4 = (lane & 15) >> 2, p4 = lane & 3, blk = (lane >> 4) & 1;
    ML_LAS float* NV = (ML_LAS float*)(L + LN); ML_LAS float* WS = (ML_LAS float*)(L + LW + w * 256);
    float m_in = 0.f;
    if (tid < 256) NV[tid] = 0.f;
    if (w < 4) {
        const int lt = w, l = 32 * lt + r32;
        const float ibh = ib[h], fbh = fb[h];
        if (w == 0) gate_vectors((ML_LAS float*)(L + LG), GT, (size_t)b * TT, h, ibh, fbh, 0.f, lane);
        for (int c = 0; c < 16; ++c) {
            const size_t row0 = (size_t)b * TT + c * 128;
            ML_LAS float* G2 = (ML_LAS float*)(L + LG + (c & 1) * GSZ); ML_LAS float* PM = G2 + 128; ML_LAS float* BC = G2 + 256; ML_LAS float* SCL = G2 + 512;
            __syncthreads();
            const bf16* qp = Qg + (row0 + l) * PD + h * 256 + 8 * hi;
            f32x16 num[4]; num[0] = f32x16{}; num[1] = f32x16{}; num[2] = f32x16{}; num[3] = f32x16{};
            float qn = 0.f;
            if (c > 0) {
                const bf16* cp = CS + (size_t)r32 * 256 + 8 * hi;
#pragma unroll 4
                for (int kk = 0; kk < 16; ++kk) {
                    const bf16x8 q8 = *(const bf16x8*)(qp + 16 * kk);
                    const f32x4 n0 = *(const ML_LAS f32x4*)(NV + 16 * kk + 8 * hi), n1 = *(const ML_LAS f32x4*)(NV + 16 * kk + 8 * hi + 4);
#pragma unroll
                    for (int e = 0; e < 4; ++e) { qn += bfx(q8[e]) * n0[e]; qn += bfx(q8[4 + e]) * n1[e]; }
#pragma unroll
                    for (int vt = 0; vt < 4; ++vt) { const bf16x8 cs = *(const bf16x8*)(cp + (size_t)vt * 32 * 256 + 16 * kk); num[vt] = __builtin_amdgcn_mfma_f32_32x32x16_bf16(q8, cs, num[vt], 0, 0, 0); }
                }
                qn += __shfl_xor(qn, 32);
            }
            asm volatile("" ::: "memory");
            bf16x8 qf[16];
#pragma unroll
            for (int kk = 0; kk < 16; ++kk) qf[kk] = *(const bf16x8*)(qp + 16 * kk);
            __syncthreads();
            const float gtot = SCL[0], mm = fmaxf(m_in, SCL[1]);
            const float ml = fmaxf(PM[l], m_in), ei = expf(m_in - ml), ml2 = ml * LOG2E;
            if (hi == 0) WS[r32] = ei;
            asm volatile("s_waitcnt lgkmcnt(0)" ::: "memory");
#pragma unroll
            for (int jj = 0; jj < 4; ++jj) { const f32x4 f = *(const ML_LAS f32x4*)(WS + 8 * jj + 4 * hi);
#pragma unroll
                for (int e = 0; e < 4; ++e) { num[0][4 * jj + e] *= f[e]; num[1][4 * jj + e] *= f[e]; num[2][4 * jj + e] *= f[e]; num[3][4 * jj + e] *= f[e]; } }
            float dsum = 0.f;
            const ML_LAS unsigned char* vbase = L + LVV + (4 * hi + q4) * PV + blk * 32 + 8 * p4;
            for (int j = 0; j <= lt; ++j) {
                f32x16 S = {};
#pragma unroll
                for (int kk = 0; kk < 16; ++kk) { const bf16x8 kf = *(const ML_LAS bf16x8*)(L + LK + (32 * j + r32) * PK + (16 * kk + 8 * hi) * 2);
                    S = __builtin_amdgcn_mfma_f32_32x32x16_bf16(kf, qf[kk], S, 0, 0, 0);
                    if ((kk & 3) == 3) asm volatile("" ::: "memory"); }
#pragma unroll
                for (int jj = 0; jj < 4; ++jj) { const f32x4 g2 = *(const ML_LAS f32x4*)(G2 + 32 * j + 8 * jj + 4 * hi);
#pragma unroll
                    for (int e = 0; e < 4; ++e) { const int r = 4 * jj + e; const bool ok = (j < lt) || (8 * jj + 4 * hi + e <= r32);
                        S[r] = ok ? S[r] * __builtin_amdgcn_exp2f(g2[e] - ml2) : 0.f; dsum += S[r]; } }
                u32x4 p0, p1;
                p0[0] = cvtpk(S[0], S[1]); p0[1] = cvtpk(S[2], S[3]); p0[2] = cvtpk(S[4], S[5]); p0[3] = cvtpk(S[6], S[7]);
                p1[0] = cvtpk(S[8], S[9]); p1[1] = cvtpk(S[10], S[11]); p1[2] = cvtpk(S[12], S[13]); p1[3] = cvtpk(S[14], S[15]);
                const bf16x8 pa0 = __builtin_bit_cast(bf16x8, p0), pa1 = __builtin_bit_cast(bf16x8, p1);
#pragma unroll
                for (int vt = 0; vt < 4; ++vt)
#pragma unroll
                    for (int ks = 0; ks < 2; ++ks) { const bf16x8 vf = trfrag(vbase + (32 * j + 16 * ks) * PV + vt * 64, 8 * PV);
                        num[vt] = __builtin_amdgcn_mfma_f32_32x32x16_bf16(ks == 0 ? pa0 : pa1, vf, num[vt], 0, 0, 0); }
            }
            { const float dtot = dsum + __shfl_xor(dsum, 32); const float den = dtot + ei * qn; const float mo = BC[l] + ml;
              const float dn = fmaxf(fabsf(den), expf(-mo));
              if (hi == 0) WS[32 + r32] = 1.f / dn; }
            asm volatile("s_waitcnt lgkmcnt(0)" ::: "memory");
#pragma unroll
            for (int jj = 0; jj < 4; ++jj) { const f32x4 f = *(const ML_LAS f32x4*)(WS + 32 + 8 * jj + 4 * hi);
#pragma unroll
                for (int e = 0; e < 4; ++e) { const int r = 4 * jj + e; bf16* ob = Vg + (row0 + 32 * lt) * PD + h * 256 + vh * 128; const unsigned oo = (unsigned)(8 * jj + 4 * hi + e) * PD + (unsigned)r32;
#pragma unroll
                    for (int vt = 0; vt < 4; ++vt) ob[oo + 32 * vt] = (bf16)(cvtpk(num[vt][r] * f[e], 0.f) & 0xffffu); } }
            m_in = gtot + mm;
            if (w == 0 && c < 15) gate_vectors((ML_LAS float*)(L + LG + ((c + 1) & 1) * GSZ), GT, row0 + 128, h, ibh, fbh, m_in, lane);
            __syncthreads();
        }
    } else {
        const int sw = w - 4, t2 = tid - 256;
        f32x16 acc[2][4];
#pragma unroll
        for (int kt = 0; kt < 2; ++kt)
#pragma unroll
            for (int vt = 0; vt < 4; ++vt) acc[kt][vt] = f32x16{};
        float nreg[2] = {0.f, 0.f};
        for (int c = 0; c < 16; ++c) {
            const size_t row0 = (size_t)b * TT + c * 128;
            ML_LAS float* CF = (ML_LAS float*)(L + LG + (c & 1) * GSZ) + 384; ML_LAS float* SCL = CF + 128;
            __syncthreads();
            {
              const unsigned char* kb = (const unsigned char*)(Kg + row0 * PD + h * 256); const unsigned char* vb = (const unsigned char*)(Vg + row0 * PD + h * 256 + vh * 128);
              const unsigned kvo = (unsigned)(t2 >> 5) * (PD * 2) + (unsigned)(t2 & 31) * 16, vvo = (unsigned)(t2 >> 4) * (PD * 2) + (unsigned)(t2 & 15) * 16;
              const unsigned klo = (unsigned)(t2 >> 5) * PK + (unsigned)(t2 & 31) * 16, vlo = (unsigned)(t2 >> 4) * PV + (unsigned)(t2 & 15) * 16;
              u32x4 t[12];
#pragma unroll
              for (int q = 0; q < 12; ++q) t[q] = *(const u32x4*)(kb + (size_t)q * (8 * PD * 2) + kvo);
#pragma unroll
              for (int q = 0; q < 12; ++q) *(ML_LAS u32x4*)(L + LK + q * (8 * PK) + klo) = t[q];
#pragma unroll
              for (int q = 0; q < 4; ++q) t[q] = *(const u32x4*)(kb + (size_t)(12 + q) * (8 * PD * 2) + kvo);
#pragma unroll
              for (int q = 0; q < 8; ++q) t[4 + q] = *(const u32x4*)(vb + (size_t)q * (16 * PD * 2) + vvo);
#pragma unroll
              for (int q = 0; q < 4; ++q) *(ML_LAS u32x4*)(L + LK + (12 + q) * (8 * PK) + klo) = t[q];
#pragma unroll
              for (int q = 0; q < 8; ++q) *(ML_LAS u32x4*)(L + LVV + q * (16 * PV) + vlo) = t[4 + q]; }
            __syncthreads();
            const float gtot = SCL[0], mm = fmaxf(m_in, SCL[1]), d_old = expf(m_in - mm);
#pragma unroll
            for (int kt = 0; kt < 2; ++kt)
#pragma unroll
                for (int vt = 0; vt < 4; ++vt)
#pragma unroll
                    for (int r = 0; r < 16; ++r) acc[kt][vt][r] *= d_old;
            const ML_LAS unsigned char* kbase = L + LK + (4 * hi + q4) * PK + (64 * sw + 16 * blk) * 2 + 8 * p4;
            const ML_LAS unsigned char* vb4 = L + LVV + (4 * hi + q4) * PV + blk * 32 + 8 * p4;
            float nacc[2] = {0.f, 0.f};
#pragma unroll 2
            for (int ks = 0; ks < 8; ++ks) {
                const f32x4 c0 = *(const ML_LAS f32x4*)(CF + 16 * ks + 4 * hi), c1 = *(const ML_LAS f32x4*)(CF + 16 * ks + 8 + 4 * hi);
                bf16x8 af[2];
#pragma unroll
                for (int kt = 0; kt < 2; ++kt) { const bf16x8 ktf = trfrag(kbase + 16 * ks * PK + kt * 64, 8 * PK);
                    float f[8];
#pragma unroll
                    for (int e = 0; e < 4; ++e) { f[e] = bfx(ktf[e]) * c0[e]; f[4 + e] = bfx(ktf[4 + e]) * c1[e]; }
                    nacc[kt] += ((f[0] + f[1]) + (f[2] + f[3])) + ((f[4] + f[5]) + (f[6] + f[7]));
                    u32x4 pk; pk[0] = cvtpk(f[0], f[1]); pk[1] = cvtpk(f[2], f[3]); pk[2] = cvtpk(f[4], f[5]); pk[3] = cvtpk(f[6], f[7]);
                    af[kt] = __builtin_bit_cast(bf16x8, pk); }
#pragma unroll
                for (int vt = 0; vt < 4; ++vt) { const bf16x8 vf = trfrag(vb4 + 16 * ks * PV + vt * 64, 8 * PV);
                    acc[0][vt] = __builtin_amdgcn_mfma_f32_32x32x16_bf16(af[0], vf, acc[0][vt], 0, 0, 0); acc[1][vt] = __builtin_amdgcn_mfma_f32_32x32x16_bf16(af[1], vf, acc[1][vt], 0, 0, 0); }
            }
            nacc[0] += __shfl_xor(nacc[0], 32); nacc[1] += __shfl_xor(nacc[1], 32);
            nreg[0] = d_old * nreg[0] + nacc[0]; nreg[1] = d_old * nreg[1] + nacc[1];
            __syncthreads();
#pragma unroll
            for (int kt = 0; kt < 2; ++kt)
#pragma unroll
                for (int vt = 0; vt < 4; ++vt)
#pragma unroll
                    for (int jj = 0; jj < 4; ++jj) { u32x2 o; o[0] = cvtpk(acc[kt][vt][4 * jj], acc[kt][vt][4 * jj + 1]); o[1] = cvtpk(acc[kt][vt][4 * jj + 2], acc[kt][vt][4 * jj + 3]);
                        *(u32x2*)(CS + (size_t)(32 * vt + r32) * 256 + 64 * sw + 32 * kt + 8 * jj + 4 * hi) = o; }
            if (hi == 0) { NV[64 * sw + r32] = nreg[0]; NV[64 * sw + 32 + r32] = nreg[1]; }
            m_in = gtot + mm;
        }
    }
    __syncthreads();
}
#undef ML_LAS
}
__device__ __forceinline__ void mamba_naive_unit(LAS unsigned char* L, const bf16* XBC, const float* GT, bf16* YM, const float* cw, const float* cb, const float* dtb, const float* alog, const float* dsk, int b, int g, int tid) {
    LAS float* BC = (LAS float*)L;
    LAS float* DT = (LAS float*)(L + 8192);
    const int hl = tid >> 6, p = tid & 63, head = g * 8 + hl, colx = head * 64 + p;
    const float w0 = cw[colx], w1 = cw[1536 + colx], w2 = cw[2 * 1536 + colx], w3 = cw[3 * 1536 + colx], bb = cb[colx];
    float h0 = 0.f, h1 = 0.f, h2 = 0.f;
    const int colbc = 1024 + ((tid & 255) < 128 ? g * 128 + (tid & 255) : 256 + g * 128 + ((tid & 255) - 128));
    const float v0 = cw[colbc], v1 = cw[1536 + colbc], v2 = cw[2 * 1536 + colbc], v3 = cw[3 * 1536 + colbc], vb = cb[colbc];
    float g0 = 0.f, g1 = 0.f, g2 = 0.f;
    const float dskh = dsk[head];
    float S[128];
#pragma unroll
    for (int n = 0; n < 128; ++n) S[n] = 0.f;
    for (int t0 = 0; t0 < T; t0 += 8) {
        if (tid < 256) {
#pragma unroll
            for (int s = 0; s < 8; ++s) { const float raw = bf2f(XBC[((size_t)b * T + t0 + s) * 1536 + colbc]); const float v = v0 * g0 + v1 * g1 + v2 * g2 + v3 * raw + vb; g0 = g1; g1 = g2; g2 = raw; BC[s * 256 + tid] = silu_g(v); }
        } else if (tid < 320) {
            const int s = (tid - 256) >> 3, hh = (tid - 256) & 7, hd2 = g * 8 + hh;
            const float x = GT[((size_t)b * T + t0 + s) * 32 + hd2] + dtb[hd2]; const float dt = x > 20.f ? x : log1pf(expf(x));
            DT[s * 8 + hh] = dt; DT[64 + s * 8 + hh] = expf(-dt * expf(alog[hd2]));
        }
        __syncthreads();
#pragma unroll 1
        for (int s = 0; s < 8; ++s) {
            const size_t row = (size_t)b * T + t0 + s;
            const float raw = bf2f(XBC[row * 1536 + colx]); const float v = w0 * h0 + w1 * h1 + w2 * h2 + w3 * raw + bb; h0 = h1; h1 = h2; h2 = raw;
            const float xv = silu_g(v), dt = DT[s * 8 + hl], dA = DT[64 + s * 8 + hl], coef = dt * xv;
            float acc = 0.f;
#pragma unroll
            for (int n4 = 0; n4 < 32; ++n4) { const f32x4 Bv = *(const LAS f32x4*)(BC + s * 256 + 4 * n4), Cv = *(const LAS f32x4*)(BC + s * 256 + 128 + 4 * n4);
#pragma unroll
                for (int j = 0; j < 4; ++j) { S[4 * n4 + j] = dA * S[4 * n4 + j] + coef * Bv[j]; acc += Cv[j] * S[4 * n4 + j]; } }
            YM[row * D + colx] = (bf16)f2bf(acc + dskh * xv);
        }
        __syncthreads();
    }
}
__device__ __forceinline__ void mlstm_naive_unit(LAS unsigned char* L, const bf16* U, bf16* V, const float* GT, const float* cw, const float* cb, const float* wq, const float* wk, const float* ib, const float* fb, int b, int h, int vh, int tid) {
    LAS float* UC = (LAS float*)L;
    LAS float* Q8 = (LAS float*)(L + 8192);
    LAS float* K8 = (LAS float*)(L + 8192 + 8704);
    LAS float* IF = (LAS float*)(L + 8192 + 2 * 8704);
    const int vl = tid >> 2, kq = tid & 3, colv = h * 256 + vh * 128 + vl;
    const int ju = tid & 255, colu = h * 256 + ju;
    const float w0 = cw[colu], w1 = cw[1024 + colu], w2 = cw[2048 + colu], w3 = cw[3072 + colu], bu = cb[colu];
    float h0 = 0.f, h1 = 0.f, h2 = 0.f;
    float wqv[4], wkv[4];
    { const int nblk = h * 64 + (ju >> 2), i = ju & 3;
#pragma unroll
      for (int jj = 0; jj < 4; ++jj) { wqv[jj] = wq[(nblk * 4 + jj) * 4 + i]; wkv[jj] = wk[(nblk * 4 + jj) * 4 + i] * 0.0625f; } }
    float C[64], N[64];
#pragma unroll
    for (int j = 0; j < 64; ++j) { C[j] = 0.f; N[j] = 0.f; }
    const float ibh = ib[h], fbh = fb[h];
    for (int t0 = 0; t0 < T; t0 += 8) {
        if (tid < 256) {
#pragma unroll
            for (int s = 0; s < 8; ++s) { const float raw = bf2f(U[((size_t)b * T + t0 + s) * D + colu]); const float v = w0 * h0 + w1 * h1 + w2 * h2 + w3 * raw + bu; h0 = h1; h1 = h2; h2 = raw; UC[s * 256 + tid] = silu_g(v); }
        } else if (tid < 264) {
            const int s = tid - 256; const size_t row = (size_t)b * T + t0 + s;
            IF[2 * s] = expf(GT[row * 32 + 16 + h] + ibh); IF[2 * s + 1] = sigm_g(GT[row * 32 + 20 + h] + fbh);
        }
        __syncthreads();
        if (tid < 256) {
#pragma unroll
            for (int s = 0; s < 8; ++s) { const f32x4 u4 = *(const LAS f32x4*)(UC + s * 256 + (tid & ~3));
                const float qv = u4[0] * wqv[0] + u4[1] * wqv[1] + u4[2] * wqv[2] + u4[3] * wqv[3], kv = u4[0] * wkv[0] + u4[1] * wkv[1] + u4[2] * wkv[2] + u4[3] * wkv[3];
                Q8[s * 272 + (tid >> 6) * 68 + (tid & 63)] = qv; K8[s * 272 + (tid >> 6) * 68 + (tid & 63)] = kv; }
        }
        __syncthreads();
#pragma unroll 1
        for (int s = 0; s < 8; ++s) {
            const size_t row = (size_t)b * T + t0 + s;
            const float vt = bf2f(V[row * D + colv]), ig = IF[2 * s], f = IF[2 * s + 1], iv = ig * vt;
            float num = 0.f, den = 0.f;
#pragma unroll
            for (int j4 = 0; j4 < 16; ++j4) { const f32x4 kv = *(const LAS f32x4*)(K8 + s * 272 + kq * 68 + 4 * j4), qv = *(const LAS f32x4*)(Q8 + s * 272 + kq * 68 + 4 * j4);
#pragma unroll
                for (int j = 0; j < 4; ++j) { C[4 * j4 + j] = f * C[4 * j4 + j] + iv * kv[j]; N[4 * j4 + j] = f * N[4 * j4 + j] + ig * kv[j]; num += C[4 * j4 + j] * qv[j]; den += N[4 * j4 + j] * qv[j]; } }
            num += __shfl_xor(num, 1); num += __shfl_xor(num, 2); den += __shfl_xor(den, 1); den += __shfl_xor(den, 2);
            const float hv = num / fmaxf(fabsf(den), 1.f);
            if (kq == 0) V[row * D + colv] = (bf16)f2bf(hv);
        }
        __syncthreads();
    }
}
__device__ __forceinline__ void gate_row(const bf16* YM, int ymp, const bf16* Z, const bf16* HD, const bf16* OP, unsigned char* YCD8, float* dq, const float* cnw, const float* dnw, size_t row, int lane) {
    float y[16], z[16], y2[16];
    ld8f(YM + row * ymp + lane * 16, y); ld8f(YM + row * ymp + lane * 16 + 8, y + 8); ld8f(Z + row * D + lane * 16, z); ld8f(Z + row * D + lane * 16 + 8, z + 8);
    float ss = 0.f;
#pragma unroll
    for (int e = 0; e < 16; ++e) { y[e] = y[e] * silu_g(z[e]); ss += y[e] * y[e]; }
    ss = wave_sum(ss); float rstd = 1.f / sqrtf(ss * (1.f / 1024.f) + RMS_EPS);
#pragma unroll
    for (int e = 0; e < 16; ++e) y[e] = y[e] * rstd * cnw[lane * 16 + e];
    ld8f(HD + row * D + lane * 16, y2); ld8f(HD + row * D + lane * 16 + 8, y2 + 8); ld8f(OP + row * D + lane * 16, z); ld8f(OP + row * D + lane * 16 + 8, z + 8);
    ss = 0.f;
#pragma unroll
    for (int e = 0; e < 16; ++e) ss += y2[e] * y2[e];
    ss += __shfl_xor(ss, 1); ss += __shfl_xor(ss, 2); ss += __shfl_xor(ss, 4); ss += __shfl_xor(ss, 8);
    rstd = 1.f / sqrtf(ss * (1.f / 256.f) + RMS_EPS);
#pragma unroll
    for (int e = 0; e < 16; ++e) y2[e] = sigm_g(z[e]) * y2[e] * rstd * dnw[lane * 16 + e];
    wht16(y); wht16(y2);
    float am = 0.f;
#pragma unroll
    for (int e = 0; e < 16; ++e) { y[e] *= 0.25f; y2[e] *= 0.25f; am = fmaxf(am, fmaxf(fabsf(y[e]), fabsf(y2[e]))); }
#pragma unroll
    for (int o = 1; o < 64; o <<= 1) am = fmaxf(am, __shfl_xor(am, o));
    am = fmaxf(am, 1e-20f); const float sc = 127.f / am;
    v4u q; q.x = pk4_i8(y[0] * sc, y[1] * sc, y[2] * sc, y[3] * sc); q.y = pk4_i8(y[4] * sc, y[5] * sc, y[6] * sc, y[7] * sc); q.z = pk4_i8(y[8] * sc, y[9] * sc, y[10] * sc, y[11] * sc); q.w = pk4_i8(y[12] * sc, y[13] * sc, y[14] * sc, y[15] * sc);
    *(v4u*)(YCD8 + row * KCD + lane * 16) = q;
    q.x = pk4_i8(y2[0] * sc, y2[1] * sc, y2[2] * sc, y2[3] * sc); q.y = pk4_i8(y2[4] * sc, y2[5] * sc, y2[6] * sc, y2[7] * sc); q.z = pk4_i8(y2[8] * sc, y2[9] * sc, y2[10] * sc, y2[11] * sc); q.w = pk4_i8(y2[12] * sc, y2[13] * sc, y2[14] * sc, y2[15] * sc);
    *(v4u*)(YCD8 + row * KCD + 1024 + lane * 16) = q;
    if (lane == 0) dq[0] = am * (1.f / 127.f);
}

struct Args { const float* in[28]; float* out; unsigned char* ws; int ph_lo, ph_hi, li, pad; };
__global__ void __launch_bounds__(NWAVES * 64, 2) fwd_kernel(Args args) {
    extern __shared__ __attribute__((aligned(16))) unsigned char lds[];
    LAS unsigned char* L = (LAS unsigned char*)lds;
    volatile LAS unsigned* MISC = (volatile LAS unsigned*)(L + MISC_OFF);
    const int tid = threadIdx.x, lane = tid & 63, wave = __builtin_amdgcn_readfirstlane(tid >> 6);
    const int G = gridDim.x, bx = blockIdx.x; const int vcu = (G % 8 == 0) ? (bx % 8) * (G / 8) + bx / 8 : bx;
    const int gw = vcu * NWAVES + wave, NGW = G * NWAVES;
    unsigned char* ws = args.ws;
    gu32* ctl = (gu32*)(ws + WS_CTL);
    for (int u = tid; u < (LDS_BYTES - LDSCTL_OFF) / 4; u += NWAVES * 64) ((LAS unsigned*)(L + LDSCTL_OFF))[u] = 0u;
    __syncthreads();
    XcdBarrier bar; bar.bar = (unsigned*)(ctl + CW_BAR) + args.li * XCD_BAR_WORDS; bar.x = 0; bar.st = nullptr;
    if (MK_ONE_LAUNCH) bar = xcd_barrier_post((unsigned*)(ctl + CW_BAR) + args.li * XCD_BAR_WORDS, MISC + 8);
    const int lo = args.ph_lo, hi = args.ph_hi;
#define IN(k) (lo <= (k) && (k) < hi)
#define SEAM(k) do { if (MK_ONE_LAUNCH && IN(k) && IN((k) + 1)) xcd_barrier(bar); } while (0)
    float* out = args.out;
#define XIN (args.in[0])
#define W_ABIN ((bf16*)(ws + WS_W_ABIN))
#define W_ABOUT ((bf16*)(ws + WS_W_ABOUT))
#define W_GU0 ((bf16*)(ws + WS_W_GU0))
#define W_DN0 ((bf16*)(ws + WS_W_DN0))
#define W_CDIN ((bf16*)(ws + WS_W_CDIN))
#define W_CDOUT ((bf16*)(ws + WS_W_CDOUT))
#define W_GU1 ((bf16*)(ws + WS_W_GU1))
#define W_DN1 ((bf16*)(ws + WS_W_DN1))
#define XN ((bf16*)(ws + WS_XN))
#define OB ((bf16*)(ws + WS_OB))
#define QKV ((bf16*)(ws + WS_QKV))
#define ACT ((bf16*)(ws + WS_ACT))
#define ZB ((bf16*)(ws + WS_Z))
#define XBC ((bf16*)(ws + WS_XBC))
#define UB ((bf16*)(ws + WS_U))
#define VB ((bf16*)(ws + WS_V))
#define OPB ((bf16*)(ws + WS_O))
#define YCD ((bf16*)(ws + WS_YCD))
#define GT ((float*)((unsigned char*)args.out + DO_GATES))
#define HB ((bf16*)(ws + WS_HB))
#define WDQ ((float*)(ws + WS_WDQ))
    constexpr int CM_CDO = 2 * NGU + 5696, WQ_CDO = 2 * NGU + NZX;
#define PSUM ((float*)(ws + WS_RSS))
#define RED ((LAS float*)(L + RING_OFF + RING_BYTES + 8192))

    if (IN(0)) for (int rep = 0; rep < 1; ++rep) {
        LAS float* scr = (LAS float*)(L + RING_OFF + wave * 16384);
        constexpr int I0 = 16 * 96, I1 = 16 * 32, I2 = 16 * 176, I3 = 44 * 32, I4 = 16 * 184, I5 = 32 * 32;
        constexpr int NITEMS = I0 + I1 + 2 * I3;
        for (int it = gw; it < NITEMS; it += NGW) {
            int r = it;
            if (r < I0) { tr_item<0>(args.in[3], D, NQKV, W_ABIN, NQKV / 32, scr, r, lane); continue; } r -= I0;
            if (r < I1) { tr_item<0>(args.in[4], D, D, W_ABOUT, D / 32, scr, r, lane); continue; } r -= I1;

            if (r < I3) { tr_item<0>(args.in[26], FF, D, W_DN0, D / 32, scr, r, lane); continue; } r -= I3;


            tr_item<0>(args.in[26] + (size_t)FF * D, FF, D, W_DN1, D / 32, scr, r, lane);
        }
        for (int blk = gw; blk < 2 * 16 * 88; blk += NGW) {
            const int l = blk / (16 * 88), r2 = blk % (16 * 88), kb = r2 / 88, nb = r2 % 88; const float* wp = args.in[25] + (size_t)l * D * NGU + (size_t)(64 * kb) * NGU + 64 * nb + lane; float am = 0.f;
#pragma unroll 8
            for (int kk = 0; kk < 64; ++kk) am = fmaxf(am, fabsf(wp[(size_t)kk * NGU]));
            __hip_atomic_fetch_max((unsigned*)(ctl + CW_CMAX) + l * NGU + 64 * nb + lane, __float_as_uint(am), __ATOMIC_RELAXED, __HIP_MEMORY_SCOPE_AGENT); }
        for (int blk = gw; blk < 32 * 16; blk += NGW) {
            const int kb = blk / 16, nb = blk % 16; const float* wp = args.in[24] + (size_t)(64 * kb) * D + 64 * nb + lane; float am = 0.f;
#pragma unroll 1
            for (int g4 = 0; g4 < 4; ++g4) { float v[16];
#pragma unroll
                for (int j = 0; j < 16; ++j) v[j] = wp[(size_t)(16 * g4 + j) * D];
                wht16(v);
#pragma unroll
                for (int j = 0; j < 16; ++j) am = fmaxf(am, fabsf(v[j])); }
            __hip_atomic_fetch_max((unsigned*)(ctl + CW_CMAX) + CM_CDO + 64 * nb + lane, __float_as_uint(am * 0.25f), __ATOMIC_RELAXED, __HIP_MEMORY_SCOPE_AGENT); }
        for (int blk = gw; blk < 16 * 89; blk += NGW) {
            const int kb = blk / 89, nb = blk % 89, col = 64 * nb + lane; float am = 0.f;
            if (col < NZX_SRC) { const float* wp = args.in[10] + (size_t)(64 * kb) * NZX_SRC + col;
#pragma unroll 8
                for (int kk = 0; kk < 64; ++kk) am = fmaxf(am, fabsf(wp[(size_t)kk * NZX_SRC]));
                __hip_atomic_fetch_max((unsigned*)(ctl + CW_CMAX) + 2 * NGU + col, __float_as_uint(am), __ATOMIC_RELAXED, __HIP_MEMORY_SCOPE_AGENT); } }
        for (int m = gw; m < M; m += NGW) rms_row_to_bf16(XIN + (size_t)m * D, args.in[1], XN + (size_t)m * D, lane);
    }
    SEAM(0);
    if (IN(1)) {
        pg8::Gemm g{XN, W_ABIN, M, NQKV, D, nullptr, nullptr}; pg8::StaticOrder S; S.init(M, NQKV, G, bx);
        pg8::EpiQKV E{QKV, NQKV, 0, 2, 6, 8, attn_body::C2};
        pg8::gemm_phase<pg8::EpiQKV, pg8::StaticOrder, true, true>(L + RING_OFF, g, S, E);
        if (PROBE_G) pg8::gemm_phase<pg8::EpiQKV, pg8::StaticOrder, true, true>(L + RING_OFF, g, S, E);
    }
    SEAM(1);
    if (IN(2)) for (int rep = 0; rep < (PROBE_T ? 2 : 1); ++rep) {
        bf16* Y = XN;
        { const attn_body::AttnTensors AT{(const attn_body::bf16*)QKV, (const attn_body::bf16*)QKV, (const attn_body::bf16*)QKV, (attn_body::bf16*)OB}; const attn_body::StaticOrder S((int)G, (int)blockIdx.x);
          attn_body::attn_phase<attn_body::StaticOrder>((char*)lds + RING_OFF, AT, S); }
        static_assert(mixa::LDS_NEED <= RING_BYTES, "mixer A LDS");
        int tid2 = tid, vcu2 = vcu; asm volatile("" : "+v"(tid2), "+s"(vcu2));
        for (int u = vcu2; u < NBATCH * 8; u += G) {
#pragma unroll 1
            for (int tb = 0; tb < 8; ++tb) mixa::unit(QKV, Y, u >> 3, u & 7, tb * 256, L + RING_OFF, tid2);
        }
    }
    SEAM(2);
    if (IN(3)) for (int rep = 0; rep < (PROBE_T ? 2 : 1); ++rep) {
        bf16* Y = XN;
        const float s1 = wave_sum(args.in[5][lane] * args.in[6][lane]), s2 = wave_sum(args.in[7][lane] * args.in[8][lane]);
        const float lam = expf(s1) - expf(s2) + 0.2f;
        for (int m = gw; m < M; m += NGW) attnB_post_row(OB, Y, args.in[9], lam, 0.8f, (size_t)m, lane);
        { LAS float* scr = (LAS float*)(L + RING_OFF + wave * 16384);
          for (int it = gw; it < 16 * 176; it += NGW) tr_item_i8<1>(args.in[25], D, NGU, (unsigned char*)W_GU0, NGU / 32, scr, it, lane, (const unsigned*)(ctl + CW_CMAX), WDQ);
          for (int it = gw; it < 16 * 176; it += NGW) tr_item_i8<1>(args.in[25] + (size_t)D * NGU, D, NGU, (unsigned char*)W_GU1, NGU / 32, scr, it, lane, (const unsigned*)(ctl + CW_CMAX) + NGU, WDQ + NGU);
          for (int it = gw; it < 16 * 184; it += NGW) tr_item_i8<2>(args.in[10], D, NZX_SRC, (unsigned char*)W_CDIN, NZX / 32, scr, it, lane, (const unsigned*)(ctl + CW_CMAX) + 2 * NGU, WDQ + 2 * NGU);
          for (int it = gw; it < 32 * 32; it += NGW) tr_item_i8rot(args.in[24], KCD, D, (unsigned char*)W_CDOUT, D / 32, scr, it, lane, (const unsigned*)(ctl + CW_CMAX) + CM_CDO, WDQ + WQ_CDO); }
    }
    SEAM(3);
    if (IN(4)) {
        pg8::Gemm g{XN, W_ABOUT, M, D, D, nullptr, nullptr}; pg8::StaticOrder S; S.init(M, D, G, bx);
        pg8::EpiResidBf<true, false, false> E{XIN, HB, D, nullptr, nullptr};
        pg8::gemm_phase<pg8::EpiResidBf<true, false, false>, pg8::StaticOrder, true, true>(L + RING_OFF, g, S, E);
    }
    SEAM(4);
    if (IN(5)) { for (int m = gw; m < M; m += NGW) rms_row_i8(HB + (size_t)m * D, args.in[2], (unsigned char*)XN + (size_t)m * D, PSUM + (size_t)m * 4, lane); }
    SEAM(5);
    if (IN(6)) {
        pg8::Gemm g{XN, W_GU0, M, NGU, D / 2, PSUM, WDQ};   pg8::StaticOrder S; S.init(M, NGU, G, bx);
        pg8::EpiSwiglu<false, 2> E{(unsigned char*)ACT, FF, 0.f};
        pg8::gemm_phase<pg8::EpiSwiglu<false, 2>, pg8::StaticOrder, true, true>(L + RING_OFF, g, S, E);
        if (PROBE_G) pg8::gemm_phase<pg8::EpiSwiglu<false, 2>, pg8::StaticOrder, true, true>(L + RING_OFF, g, S, E);
    }
    SEAM(6);
    if (IN(7)) {
        pg8::Gemm g{ACT, W_DN0, M, D, FF, nullptr, nullptr}; pg8::StaticOrder S; S.init(M, D, G, bx);
        pg8::EpiResidBf<false, false, false> E{nullptr, HB, D, nullptr, nullptr};
        pg8::gemm_phase<pg8::EpiResidBf<false, false, false>, pg8::StaticOrder, true, true>(L + RING_OFF, g, S, E);
    }
    SEAM(7);
    if (IN(8)) { for (int m = gw; m < M; m += NGW) rms_row_i8(HB + (size_t)m * D, args.in[1] + D, (unsigned char*)XN + (size_t)m * D, PSUM + (size_t)m * 4, lane); }
    SEAM(8);
    if (IN(9)) {
        pg8::Gemm g{XN, W_CDIN, M, NZX, D / 2, PSUM, WDQ + 2 * NGU};   pg8::StaticOrder S; S.init(M, NZX, G, bx);
        pg8::EpiZX<2> E{ZB, XBC, UB, VB, OPB, GT};
        pg8::gemm_phase<pg8::EpiZX<2>, pg8::StaticOrder, true, true>(L + RING_OFF, g, S, E);
        if (PROBE_G) pg8::gemm_phase<pg8::EpiZX<2>, pg8::StaticOrder, true, true>(L + RING_OFF, g, S, E);
    }
    SEAM(9);
    if (IN(10)) {
        for (int u = bx; u < NBATCH * 20; u += G) { const int bb = u / 20, cg = u % 20;
            if (cg < 12) conv_unit<0>(XBC, 1536, cg * 128, args.in[11], 1536, args.in[12], bb, tid, nullptr, nullptr, nullptr);
            else conv_unit<1>(UB, 1024, (cg - 12) * 128, args.in[17], 1024, args.in[18], bb, tid, args.in[19], args.in[20], XN); }
    }
    SEAM(10);
    if (IN(11)) {
        static_assert(mam::LDS_NEED <= LDSCTL_OFF && mls::LDS_NEED <= LDSCTL_OFF, "mixer LDS");
        for (int u = vcu; u < NBATCH * 8; u += G) mls::unit(UB, XN, VB, (bf16*)((unsigned char*)args.out + DO_CS) + (size_t)u * 32768, GT, args.in[21], args.in[22], u >> 3, (u >> 1) & 3, u & 1, L, tid);
        int tid2 = tid, vcu2 = vcu; asm volatile("" : "+v"(tid2), "+s"(vcu2));
        for (int u = vcu2; u < NBATCH * 8; u += G) mam::unit(XBC, GT, args.in[13], args.in[14], args.in[15], u >> 3, (u >> 2) & 1, u & 3, L, tid2);
    }
    SEAM(11);
    if (IN(12)) for (int rep = 0; rep < 1; ++rep) { for (int m = gw; m < M; m += NGW) gate_row(XBC, 1536, ZB, VB, OPB, (unsigned char*)YCD, PSUM + (size_t)m * 4, args.in[16], args.in[23], (size_t)m, lane); }
    SEAM(12);
    if (IN(13)) {
        pg8::Gemm g{YCD, W_CDOUT, M, D, KCD / 2, PSUM, WDQ + WQ_CDO}; pg8::StaticOrder S; S.init(M, D, G, bx);
        pg8::EpiResidBf<false, false, false, true> E{nullptr, HB, D, nullptr, nullptr};
        pg8::gemm_phase<pg8::EpiResidBf<false, false, false, true>, pg8::StaticOrder, true, true>(L + RING_OFF, g, S, E);
    }
    SEAM(13);
    if (IN(14)) { for (int m = gw; m < M; m += NGW) rms_row_i8(HB + (size_t)m * D, args.in[2] + D, (unsigned char*)XN + (size_t)m * D, PSUM + (size_t)m * 4, lane); }
    SEAM(14);
    if (IN(15)) {
        pg8::Gemm g{XN, W_GU1, M, NGU, D / 2, PSUM, WDQ + NGU};   pg8::StaticOrder S; S.init(M, NGU, G, bx);
        pg8::EpiSwiglu<false, 2> E{(unsigned char*)ACT, FF, 0.f};
        pg8::gemm_phase<pg8::EpiSwiglu<false, 2>, pg8::StaticOrder, true, true>(L + RING_OFF, g, S, E);
        if (PROBE_G) pg8::gemm_phase<pg8::EpiSwiglu<false, 2>, pg8::StaticOrder, true, true>(L + RING_OFF, g, S, E);
    }
    SEAM(15);
    if (IN(16)) {
        pg8::Gemm g{ACT, W_DN1, M, D, FF, nullptr, nullptr}; pg8::StaticOrder S; S.init(M, D, G, bx);
        pg8::EpiResidBf<false, false, false> E{nullptr, HB, D, nullptr, nullptr};
        pg8::gemm_phase<pg8::EpiResidBf<false, false, false>, pg8::StaticOrder, true, true>(L + RING_OFF, g, S, E);
    }
    SEAM(16);
    if (IN(17)) { int ln = threadIdx.x; asm volatile("" : "+v"(ln)); ln &= 63;
        for (int m = gw; m < M; m += NGW) final_row(HB + (size_t)m * D, args.in[27], out + (size_t)m * D, ln); }
#undef IN
#undef SEAM
#undef XIN
}

extern "C" void kernel_launch(void* const* d_in, const int* in_sizes, int n_in, void* d_out, int out_size, void* d_ws, size_t ws_size, hipStream_t stream) {
    static int grid = 0;
    if (grid == 0) {
        if (n_in != 28 || in_sizes[0] != M * D || out_size != M * D || ws_size < WS_END) { fprintf(stderr, "kernel_launch: unexpected shapes / workspace (%d inputs, ws %zu < %zu); nothing launched\n", n_in, ws_size, (size_t)WS_END); grid = -1; return; }
        int dev = 0, cus = 0;
        if (hipGetDevice(&dev) != hipSuccess || hipDeviceGetAttribute(&cus, hipDeviceAttributeMultiprocessorCount, dev) != hipSuccess) { grid = -1; return; }
        if (hipFuncSetAttribute((const void*)fwd_kernel, hipFuncAttributeMaxDynamicSharedMemorySize, LDS_BYTES) != hipSuccess) { grid = -1; return; }
        int per_cu = 0;
        if (hipOccupancyMaxActiveBlocksPerMultiprocessor(&per_cu, (const void*)fwd_kernel, NWAVES * 64, LDS_BYTES) != hipSuccess || per_cu < 1) fprintf(stderr, "kernel_launch: occupancy query reports %d\n", per_cu);
        (void)hipGetLastError();
        grid = cus;
    }
    if (grid < 0) return;
    if (hipMemsetAsync((char*)d_ws + WS_CTL, 0, CTL_ZERO_BYTES, stream) != hipSuccess) return;
    Args a{};
    for (int i = 0; i < 28; ++i) a.in[i] = (const float*)d_in[i];
    a.out = (float*)d_out; a.ws = (unsigned char*)d_ws;
#if MK_ONE_LAUNCH
    if (PROBE_HI > PROBE_LO) {
        a.ph_lo = 0; a.ph_hi = PROBE_HI; a.li = 0; hipLaunchKernelGGL(fwd_kernel, dim3(grid), dim3(NWAVES * 64), LDS_BYTES, stream, a);
        a.ph_lo = PROBE_LO; a.ph_hi = NPH; a.li = 1; hipLaunchKernelGGL(fwd_kernel, dim3(grid), dim3(NWAVES * 64), LDS_BYTES, stream, a);
        return;
    }
    a.ph_lo = 0; a.ph_hi = NPH;
    hipLaunchKernelGGL(fwd_kernel, dim3(grid), dim3(NWAVES * 64), LDS_BYTES, stream, a);
#else
    for (int p = 0; p < NPH; ++p) { a.ph_lo = p; a.ph_hi = p + 1; hipLaunchKernelGGL(fwd_kernel, dim3(grid), dim3(NWAVES * 64), LDS_BYTES, stream, a); }
#endif
}
```

```cpp
#include <hip/hip_runtime.h>
#include <cstdio>
#include <cstdint>
#ifndef MK_ONE_LAUNCH
#define MK_ONE_LAUNCH 1
#endif
#define PROBE_G 0
#define PROBE_T 0
#define PROBE_LO 0
#define PROBE_HI 0
namespace pg8 {
#define PG8_LAS __attribute__((address_space(3)))
typedef unsigned short bf16_t;
typedef short bf16x8 __attribute__((ext_vector_type(8)));
typedef float f32x4 __attribute__((ext_vector_type(4)));
typedef unsigned u32x4 __attribute__((ext_vector_type(4)));
constexpr int BM = 256, BK = 64, HALF = 128, HTB = HALF * BK * 2  , STAGE_BYTES = 8 * HTB, NXCD = 8, WGM = 4;

__host__ __device__ __forceinline__ int lds_byte(int r, int c) { const int st = (r >> 4) * 2 + (c >> 5), rr = r & 15, cc = c & 31, ob = rr * 64 + cc * 2; return st * 1024 + (ob ^ (((ob >> 9) & 1) << 5)); }
__host__ __device__ __forceinline__ void stage_rc(int b, int& R, int& C) { const int st = b / 1024, sb = b % 1024, swz = sb ^ (((sb >> 9) & 1) << 5); R = (st >> 1) * 16 + swz / 64; C = (st & 1) * 32 + (swz % 64) / 2; }
__host__ __device__ __forceinline__ int perm32(int rho) { const int n = rho >> 4, i = rho & 15; return 8 * (i >> 2) + 4 * n + (i & 3); }

struct Unit { int pm, pn; };
struct Gemm { const bf16_t* A; const bf16_t* Bt; int M, N, K; const float* ps; const float* wq; };

struct StaticOrder {
    int nM, nN, nwg, G, c;
    __host__ __device__ void init(int M, int N, int G_, int c_) { nM = M / BM; nN = N / BM; nwg = nM * nN; G = G_; c = c_; }
    __host__ __device__ bool next(int i, Unit& u) const {
        const long L = (long)i * G + c; if (L >= nwg) return false;
        int wgid = (int)L; { const int q = nwg / NXCD, r = nwg % NXCD, xcd = wgid % NXCD, off = wgid / NXCD; wgid = (xcd < r ? xcd * (q + 1) : r * (q + 1) + (xcd - r) * q) + off; }
        const int nig = WGM * nN, gid = wgid / nig, fm = gid * WGM, gsz = (nM - fm) < WGM ? (nM - fm) : WGM;
        u.pm = fm + ((wgid % nig) % gsz); u.pn = (wgid % nig) / gsz; return true;
    }
    __device__ __forceinline__ void a_ready(const Unit&) const {}
    __device__ __forceinline__ void done(const Unit&) const {}
};

__device__ __forceinline__ unsigned cvt_pk_bf16(float lo, float hi) { unsigned r; asm volatile("v_cvt_pk_bf16_f32 %0, %1, %2" : "=v"(r) : "v"(lo), "v"(hi)); return r; }
typedef float f32x2 __attribute__((ext_vector_type(2)));
typedef int i32x4 __attribute__((ext_vector_type(4)));
typedef int i32x8 __attribute__((ext_vector_type(8)));
__device__ __forceinline__ i32x8 cat8(bf16x8 a, bf16x8 b) { const i32x4 x = __builtin_bit_cast(i32x4, a), y = __builtin_bit_cast(i32x4, b); return __builtin_shufflevector(x, y, 0, 1, 2, 3, 4, 5, 6, 7); }
__device__ __forceinline__ float clamp8(float v) { return __builtin_fminf(__builtin_fmaxf(v, -448.f), 448.f); }
__device__ __forceinline__ unsigned pk4_fp8(float a, float b, float c, float d) { int w = 0; w = __builtin_amdgcn_cvt_pk_fp8_f32(clamp8(a), clamp8(b), w, false); w = __builtin_amdgcn_cvt_pk_fp8_f32(clamp8(c), clamp8(d), w, true); return (unsigned)w; }
constexpr float ACT8_SC = 8.f, W8_SC = 64.f;
__device__ __forceinline__ float silu_f(float x) { return x * __builtin_amdgcn_rcpf(1.f + __expf(-x)); }
__device__ __forceinline__ float row_rstd(const PG8_LAS f32x4* rst, int rl) { const f32x4 p = rst[rl]; return 1.f / sqrtf(((p[0] + p[1]) + (p[2] + p[3])) * (1.f / 1024.f) + 1e-6f); }
struct EpiQKV {
    static constexpr bool PERM = true, AFTER_DRAIN = false, RSTD = false, FP8 = false, I8 = false;
    bf16_t* O; int ldc; int sa_lo, sa_hi, sc_lo, sc_hi; float scale;
    __device__ __forceinline__ void operator()(const f32x4 (&acc)[2][2][4][2], const Unit& u, int wr, int wc, int fr, int fq) const {
        const int row0 = u.pm * BM + wr * 64 + fr, col0 = u.pn * BM + wc * 32 + 8 * fq;
        const float sc = ((u.pn >= sc_lo && u.pn < sc_hi) || (u.pn >= sa_lo && u.pn < sa_hi)) ? scale : 1.f;
#pragma unroll
        for (int ai = 0; ai < 2; ++ai)
#pragma unroll
            for (int m = 0; m < 4; ++m) { bf16_t* rowp = O + (size_t)(row0 + ai * HALF + m * 16) * ldc + col0;
#pragma unroll
                for (int bj = 0; bj < 2; ++bj) { const f32x4 v0 = acc[ai][bj][m][0] * sc, v1 = acc[ai][bj][m][1] * sc;
                    u32x4 w; w.x = cvt_pk_bf16(v0[0], v0[1]); w.y = cvt_pk_bf16(v0[2], v0[3]); w.z = cvt_pk_bf16(v1[0], v1[1]); w.w = cvt_pk_bf16(v1[2], v1[3]);
                    *(u32x4*)(rowp + bj * HALF) = w; } }
    }
};
template <int MODE> struct EpiZX {
    static constexpr bool PERM = true, AFTER_DRAIN = false, RSTD = true, FP8 = false, I8 = (MODE == 2);
    bf16_t *Z, *XBC, *U, *V, *O; float* G;
    static __device__ __forceinline__ f32x4 accf(const f32x4& a) { if constexpr (MODE == 2) return __builtin_convertvector(__builtin_bit_cast(i32x4, a), f32x4); else return a; }
    __device__ __forceinline__ void operator()(const f32x4 (&acc)[2][2][4][2], const Unit& u, int wr, int wc, int fr, int fq, const PG8_LAS f32x4* rst, const PG8_LAS f32x4* wqt) const {
        const int row0 = u.pm * BM + wr * 64 + fr; const int pn = u.pn;
        f32x4 wq[2][2];
#pragma unroll
        for (int bj = 0; bj < 2; ++bj)
#pragma unroll
            for (int n = 0; n < 2; ++n) { if constexpr (MODE == 2) wq[bj][n] = wqt[32 * bj + 8 * wc + 2 * fq + n]; else wq[bj][n] = (f32x4){1.f, 1.f, 1.f, 1.f}; }

        if (pn == 22) {
            if (wc == 0) {
#pragma unroll
                for (int ai = 0; ai < 2; ++ai)
#pragma unroll
                    for (int m = 0; m < 4; ++m) { float* gp = G + (size_t)(row0 + ai * HALF + m * 16) * 32 + 8 * fq; const int rl = ai * HALF + wr * 64 + m * 16 + fr; const float rs = (MODE == 2) ? rst[rl][0] : row_rstd(rst, rl);
                        *(f32x4*)gp = accf(acc[ai][0][m][0]) * (wq[0][0] * rs); *(f32x4*)(gp + 4) = accf(acc[ai][0][m][1]) * (wq[0][1] * rs); }
            }
            return;
        }
        bf16_t* base; int ldc, colt;
        if (pn < 4) { base = Z; ldc = 1024; colt = pn * 256; }
        else if (pn < 10) { base = XBC; ldc = 1536; colt = (pn - 4) * 256; }
        else if (pn < 14) { base = U; ldc = 1024; colt = (pn - 10) * 256; }
        else if (pn < 18) { base = V; ldc = 1024; colt = (pn - 14) * 256; }
        else { base = O; ldc = 1024; colt = (pn - 18) * 256; }
        const int col0 = colt + wc * 32 + 8 * fq;
#pragma unroll
        for (int ai = 0; ai < 2; ++ai)
#pragma unroll
            for (int m = 0; m < 4; ++m) { bf16_t* rowp = base + (size_t)(row0 + ai * HALF + m * 16) * ldc + col0; const int rl = ai * HALF + wr * 64 + m * 16 + fr; const float rs = (MODE == 2) ? rst[rl][0] : row_rstd(rst, rl);
#pragma unroll
                for (int bj = 0; bj < 2; ++bj) { const f32x4 v0 = accf(acc[ai][bj][m][0]) * (wq[bj][0] * rs), v1 = accf(acc[ai][bj][m][1]) * (wq[bj][1] * rs);
                    u32x4 w; w.x = cvt_pk_bf16(v0[0], v0[1]); w.y = cvt_pk_bf16(v0[2], v0[3]); w.z = cvt_pk_bf16(v1[0], v1[1]); w.w = cvt_pk_bf16(v1[2], v1[3]);
                    *(u32x4*)(rowp + bj * HALF) = w; } }
    }
};
__device__ __forceinline__ unsigned pk4_i8q(float a, float b, float c, float d) {
    const int x = __float2int_rn(a), y = __float2int_rn(b), z = __float2int_rn(c), w = __float2int_rn(d);
    return (unsigned)(x & 255) | ((unsigned)(y & 255) << 8) | ((unsigned)(z & 255) << 16) | ((unsigned)w << 24);
}
template <bool O8, int MODE, bool OROT = false> struct EpiSwiglu {
    static constexpr bool PERM = true, AFTER_DRAIN = false, RSTD = true, FP8 = false, I8 = (MODE == 2);
    unsigned char* O; int ldc; float wdq;
    __device__ __forceinline__ void operator()(const f32x4 (&acc)[2][2][4][2], const Unit& u, int wr, int wc, int fr, int fq, const PG8_LAS f32x4* rst, const PG8_LAS f32x4* wqt) const {
        const int row0 = u.pm * BM + wr * 64 + fr, col0 = u.pn * HALF + wc * 32 + 8 * fq;
        f32x4 wg0, wg1, wu0, wu1;
        if constexpr (MODE == 2) { const int q = 8 * wc + 2 * fq; wg0 = wqt[q]; wg1 = wqt[q + 1]; wu0 = wqt[32 + q]; wu1 = wqt[32 + q + 1]; }
#pragma unroll
        for (int ai = 0; ai < 2; ++ai)
#pragma unroll
            for (int m = 0; m < 4; ++m) {
                const int rl = ai * HALF + wr * 64 + m * 16 + fr;
                f32x4 g0, g1, u0, u1;
                if constexpr (MODE == 2) { const float rs = rst[rl][0];
                    g0 = __builtin_convertvector(__builtin_bit_cast(i32x4, acc[ai][0][m][0]), f32x4) * (wg0 * rs); g1 = __builtin_convertvector(__builtin_bit_cast(i32x4, acc[ai][0][m][1]), f32x4) * (wg1 * rs);
                    u0 = __builtin_convertvector(__builtin_bit_cast(i32x4, acc[ai][1][m][0]), f32x4) * (wu0 * rs); u1 = __builtin_convertvector(__builtin_bit_cast(i32x4, acc[ai][1][m][1]), f32x4) * (wu1 * rs); }
                else { const float rs = row_rstd(rst, rl); g0 = acc[ai][0][m][0] * rs; g1 = acc[ai][0][m][1] * rs; u0 = acc[ai][1][m][0] * rs; u1 = acc[ai][1][m][1] * rs; }
                float r[8];
#pragma unroll
                for (int j = 0; j < 4; ++j) { r[j] = silu_f(g0[j]) * u0[j]; r[4 + j] = silu_f(g1[j]) * u1[j]; }
                if constexpr (OROT) {
#pragma unroll
                    for (int h = 1; h < 8; h <<= 1)
#pragma unroll
                        for (int i = 0; i < 8; ++i) if ((i & h) == 0) { const float x = r[i], y = r[i + h]; r[i] = x + y; r[i + h] = x - y; }
                    const float qs = 0.25f * rst[rl][1];
#pragma unroll
                    for (int i = 0; i < 8; ++i) { const float p = __shfl_xor(r[i], 16); r[i] = ((fq & 1) ? (p - r[i]) : (r[i] + p)) * qs; r[i] = __builtin_fminf(__builtin_fmaxf(r[i], -127.f), 127.f); }
                    typedef unsigned u32x2 __attribute__((ext_vector_type(2)));
                    u32x2 w; w.x = pk4_i8q(r[0], r[1], r[2], r[3]); w.y = pk4_i8q(r[4], r[5], r[6], r[7]);
                    *(u32x2*)(O + (size_t)(row0 + ai * HALF + m * 16) * ldc + col0) = w; }
                else if constexpr (O8) { typedef unsigned u32x2 __attribute__((ext_vector_type(2)));
                    u32x2 w; w.x = pk4_fp8(r[0] * ACT8_SC, r[1] * ACT8_SC, r[2] * ACT8_SC, r[3] * ACT8_SC); w.y = pk4_fp8(r[4] * ACT8_SC, r[5] * ACT8_SC, r[6] * ACT8_SC, r[7] * ACT8_SC);
                    *(u32x2*)(O + (size_t)(row0 + ai * HALF + m * 16) * ldc + col0) = w; }
                else { u32x4 w; w.x = cvt_pk_bf16(r[0], r[1]); w.y = cvt_pk_bf16(r[2], r[3]); w.z = cvt_pk_bf16(r[4], r[5]); w.w = cvt_pk_bf16(r[6], r[7]);
                    *(u32x4*)((bf16_t*)O + (size_t)(row0 + ai * HALF + m * 16) * ldc + col0) = w; } }
    }
};
template <bool SRC_F32, bool PART, bool F8, bool Q8 = false> struct EpiResidBf {
    static constexpr bool PERM = true, AFTER_DRAIN = false, RSTD = Q8, FP8 = F8, I8 = Q8;
    const float* srcf; bf16_t* H; int ldc; float* ps; PG8_LAS float* red;
    __device__ __forceinline__ void operator()(const f32x4 (&acc)[2][2][4][2], const Unit& u, int wr, int wc, int fr, int fq, const PG8_LAS f32x4* rst = nullptr, const PG8_LAS f32x4* wqt = nullptr) const {
        const int row0 = u.pm * BM + wr * 64 + fr, col0 = u.pn * BM + wc * 32 + 8 * fq;
        f32x4 wq[2][2];
        if constexpr (Q8) {
#pragma unroll
            for (int bj = 0; bj < 2; ++bj)
#pragma unroll
                for (int n = 0; n < 2; ++n) wq[bj][n] = wqt[32 * bj + 8 * wc + 2 * fq + n]; }
#pragma unroll
        for (int ai = 0; ai < 2; ++ai)
#pragma unroll
            for (int m = 0; m < 4; ++m) { const size_t off = (size_t)(row0 + ai * HALF + m * 16) * ldc + col0; float ss = 0.f;
#pragma unroll
                for (int bj = 0; bj < 2; ++bj) { f32x4 s0, s1;
                    if (SRC_F32) { s0 = *(const f32x4*)(srcf + off + bj * HALF); s1 = *(const f32x4*)(srcf + off + bj * HALF + 4); }
                    else { const u32x4 hv = *(const u32x4*)(H + off + bj * HALF);
                        s0 = (f32x4){__uint_as_float(hv.x << 16), __uint_as_float(hv.x & 0xffff0000u), __uint_as_float(hv.y << 16), __uint_as_float(hv.y & 0xffff0000u)};
                        s1 = (f32x4){__uint_as_float(hv.z << 16), __uint_as_float(hv.z & 0xffff0000u), __uint_as_float(hv.w << 16), __uint_as_float(hv.w & 0xffff0000u)}; }
                    constexpr float dsc = F8 ? 1.f / (ACT8_SC * W8_SC) : 1.f;
                    f32x4 v0, v1;
                    if constexpr (Q8) { const float rs = rst[ai * HALF + wr * 64 + m * 16 + fr][0];
                        v0 = s0 + __builtin_convertvector(__builtin_bit_cast(i32x4, acc[ai][bj][m][0]), f32x4) * (wq[bj][0] * rs); v1 = s1 + __builtin_convertvector(__builtin_bit_cast(i32x4, acc[ai][bj][m][1]), f32x4) * (wq[bj][1] * rs); }
                    else { v0 = s0 + acc[ai][bj][m][0] * dsc; v1 = s1 + acc[ai][bj][m][1] * dsc; }
                    if (PART) ss += ((v0[0] * v0[0] + v0[1] * v0[1]) + (v0[2] * v0[2] + v0[3] * v0[3])) + ((v1[0] * v1[0] + v1[1] * v1[1]) + (v1[2] * v1[2] + v1[3] * v1[3]));
                    u32x4 w; w.x = cvt_pk_bf16(v0[0], v0[1]); w.y = cvt_pk_bf16(v0[2], v0[3]); w.z = cvt_pk_bf16(v1[0], v1[1]); w.w = cvt_pk_bf16(v1[2], v1[3]);
                    *(u32x4*)(H + off + bj * HALF) = w; }
                if constexpr (PART) { ss += __shfl_xor(ss, 16); ss += __shfl_xor(ss, 32); if (fq == 0) red[(ai * HALF + wr * 64 + m * 16 + fr) * 4 + wc] = ss; } }
        if constexpr (PART) {
            asm volatile("s_waitcnt lgkmcnt(0)" ::: "memory"); __builtin_amdgcn_s_barrier(); asm volatile("" ::: "memory");
            const int t = threadIdx.x;
            if (t < 256) { const f32x4 r = *(const PG8_LAS f32x4*)(red + t * 4); ps[((size_t)u.pm * BM + t) * 4 + u.pn] = (r[0] + r[1]) + (r[2] + r[3]); }
        }
    }
};

template <class Epi, class Sched, bool ALIGN_EPI = false, bool SP2 = false>
__device__ __forceinline__ void gemm_phase(PG8_LAS unsigned char* lds, const Gemm g, const Sched& S, const Epi& E) {
    const int tid = threadIdx.x, wid = __builtin_amdgcn_readfirstlane(tid >> 6), lane = tid & 63, wr = wid >> 2, wc = wid & 3, fr = lane & 15, fq = lane >> 4;
    const int K = g.K, nt = K / BK;
    unsigned voffA[2], voffB[2];
#pragma unroll
    for (int i = 0; i < 2; ++i) { int R, C; stage_rc(tid * 16 + i * 8192, R, C); const int Rb = Epi::PERM ? ((R & ~31) + perm32(R & 31)) : R;
        voffA[i] = (unsigned)(R * K + C) * 2u; voffB[i] = (unsigned)(Rb * K + C) * 2u; }
    int one8 = 0x7f7f7f7f; asm volatile("" : "+v"(one8));
    const size_t kstep = (size_t)(BK * 2);
    const size_t hstep = (size_t)HALF * K * 2;
    const size_t tstep = 2 * hstep;
    const unsigned ldsw = (unsigned)wid * 1024u;
    const int aoff = lds_byte(wr * 64 + fr, fq * 8), boff = lds_byte(wc * 32 + fr, fq * 8);
#define PG8_SA(b, h) (((b) * 2 + (h)) * HTB)
#define PG8_SB(b, h) ((4 + (b) * 2 + (h)) * HTB)
#define PG8_STAGE(bufoff, gbase, voff) do { _Pragma("unroll") for (int _i = 0; _i < 2; ++_i) \
        __builtin_amdgcn_global_load_lds((const unsigned*)((const char*)(gbase) + (voff)[_i]), (PG8_LAS unsigned*)(lds + (bufoff) + ldsw + _i * 8192), 16, 0, 0); } while (0)
#define PG8_LDA(dst, b, h) do { _Pragma("unroll") for (int m = 0; m < 4; ++m) _Pragma("unroll") for (int k = 0; k < 2; ++k) dst[m][k] = *(const PG8_LAS bf16x8*)(lds + PG8_SA(b, h) + aoff + m * 2048 + k * 1024); } while (0)
#define PG8_LDB(dst, b, h) do { _Pragma("unroll") for (int n = 0; n < 2; ++n) _Pragma("unroll") for (int k = 0; k < 2; ++k) dst[n][k] = *(const PG8_LAS bf16x8*)(lds + PG8_SB(b, h) + boff + n * 2048 + k * 1024); } while (0)
#define PG8_MMA(ai, bj, At, Bt) do { __builtin_amdgcn_s_setprio(1); \
        if constexpr (Epi::FP8) { _Pragma("unroll") for (int m = 0; m < 4; ++m) _Pragma("unroll") for (int n = 0; n < 2; ++n) \
            { const i32x8 b8 = cat8(Bt[n][0], Bt[n][1]), a8 = cat8(At[m][0], At[m][1]);     \
              asm volatile("v_mfma_scale_f32_16x16x128_f8f6f4 %0, %1, %2, %0, %3, %3 op_sel_hi:[0,0,0]" : "+v"(acc[ai][bj][m][n]) : "v"(b8), "v"(a8), "v"(one8)); } } \
        else if constexpr (Epi::I8) { _Pragma("unroll") for (int m = 0; m < 4; ++m) _Pragma("unroll") for (int n = 0; n < 2; ++n) _Pragma("unroll") for (int k = 0; k < 2; ++k)     \
            acc[ai][bj][m][n] = __builtin_bit_cast(f32x4, __builtin_amdgcn_mfma_i32_16x16x64_i8(__builtin_bit_cast(i32x4, Bt[n][k]), __builtin_bit_cast(i32x4, At[m][k]), __builtin_bit_cast(i32x4, acc[ai][bj][m][n]), 0, 0, 0)); } \
        else { _Pragma("unroll") for (int m = 0; m < 4; ++m) _Pragma("unroll") for (int n = 0; n < 2; ++n) _Pragma("unroll") for (int k = 0; k < 2; ++k) \
            acc[ai][bj][m][n] = __builtin_amdgcn_mfma_f32_16x16x32_bf16(Bt[n][k], At[m][k], acc[ai][bj][m][n], 0, 0, 0); } \
        __builtin_amdgcn_s_setprio(0); } while (0)
#define PG8_WAIT_V(n) asm volatile("s_waitcnt vmcnt(" #n ")" ::: "memory")
#define PG8_WAIT_L(n) asm volatile("s_waitcnt lgkmcnt(" #n ")" ::: "memory")
#define PG8_BAR __builtin_amdgcn_s_barrier()
#define PG8_SCHED __builtin_amdgcn_sched_barrier(0)
    Unit cur, nxt; int ui = 0;
    if (!S.next(0, cur)) return;
    f32x4 acc[2][2][4][2];
#pragma unroll
    for (int a = 0; a < 2; ++a)
#pragma unroll
        for (int b = 0; b < 2; ++b)
#pragma unroll
            for (int m = 0; m < 4; ++m)
#pragma unroll
                for (int n = 0; n < 2; ++n) acc[a][b][m][n] = (f32x4){0.f, 0.f, 0.f, 0.f};
    bf16x8 At[4][2], B0[2][2], B1[2][2];
    const char* cA = (const char*)g.A + (size_t)cur.pm * tstep; const char* cB = (const char*)g.Bt + (size_t)cur.pn * tstep;
    S.a_ready(cur);
    if constexpr (SP2) {
        PG8_STAGE(PG8_SB(0, 0), cB, voffB); PG8_STAGE(PG8_SB(0, 1), cB + hstep, voffB); PG8_STAGE(PG8_SA(0, 0), cA, voffA); PG8_STAGE(PG8_SA(0, 1), cA + hstep, voffA);
        if (wr == 1) PG8_BAR;
        PG8_WAIT_V(2); PG8_BAR;
        PG8_STAGE(PG8_SB(1, 0), cB + kstep, voffB); PG8_STAGE(PG8_SA(1, 0), cA + kstep, voffA); PG8_STAGE(PG8_SB(1, 1), cB + hstep + kstep, voffB);
        PG8_WAIT_V(6); PG8_BAR;
    } else {
        PG8_STAGE(PG8_SB(0, 0), cB, voffB); PG8_STAGE(PG8_SA(0, 0), cA, voffA); PG8_STAGE(PG8_SB(0, 1), cB + hstep, voffB); PG8_STAGE(PG8_SA(0, 1), cA + hstep, voffA);
        if (wr == 1) PG8_BAR;
        PG8_WAIT_V(4); PG8_BAR;
        PG8_STAGE(PG8_SB(1, 0), cB + kstep, voffB); PG8_STAGE(PG8_SA(1, 0), cA + kstep, voffA); PG8_STAGE(PG8_SB(1, 1), cB + hstep + kstep, voffB);
        PG8_WAIT_V(6); PG8_BAR;
    }
    for (;;) {
        const bool has_next = S.next(ui + 1, nxt);
        const char* nA = has_next ? (const char*)g.A + (size_t)nxt.pm * tstep : cA; const char* nB = has_next ? (const char*)g.Bt + (size_t)nxt.pn * tstep : cB;
        if constexpr (Epi::RSTD) { if (wid < 4)
            __builtin_amdgcn_global_load_lds((const unsigned*)(g.ps + ((size_t)cur.pm * BM + wid * 64 + lane) * 4), (PG8_LAS unsigned*)(lds + STAGE_BYTES + (ui & 1) * 4096 + wid * 1024), 16, 0, 0); }
        if constexpr (Epi::I8) { if (wid == 4)
            __builtin_amdgcn_global_load_lds((const unsigned*)(g.wq + (size_t)cur.pn * BM + lane * 4), (PG8_LAS unsigned*)(lds + STAGE_BYTES + 12288 + (ui & 1) * 1024), 16, 0, 0); }
        for (int t = 0; t < nt; t += 2) {
            const bool last = (t == nt - 2);
            const char* a1 = cA + (size_t)(t + 1) * kstep;
            const char* a2 = last ? nA : cA + (size_t)(t + 2) * kstep; const char* b2 = last ? nB : cB + (size_t)(t + 2) * kstep;
            const char* a3 = a2 + kstep; const char* b3 = b2 + kstep;
            if (last && has_next) S.a_ready(nxt);
            if constexpr (SP2) {
            PG8_LDB(B0, 0, 0); PG8_LDB(B1, 0, 1); PG8_SCHED; PG8_LDA(At, 0, 0); PG8_STAGE(PG8_SA(1, 1), a1 + hstep, voffA);
            PG8_WAIT_V(8); PG8_WAIT_L(0); PG8_BAR; PG8_MMA(0, 0, At, B0); PG8_MMA(0, 1, At, B1); PG8_BAR; PG8_SCHED;
            PG8_LDA(At, 0, 1); PG8_STAGE(PG8_SB(0, 0), b2, voffB); PG8_STAGE(PG8_SB(0, 1), b2 + hstep, voffB); PG8_STAGE(PG8_SA(0, 0), a2, voffA);
            PG8_WAIT_V(8); PG8_WAIT_L(0); PG8_BAR; PG8_MMA(1, 0, At, B0); PG8_MMA(1, 1, At, B1); PG8_BAR; PG8_SCHED;
            PG8_LDB(B0, 1, 0); PG8_LDB(B1, 1, 1); PG8_SCHED; PG8_LDA(At, 1, 0); PG8_STAGE(PG8_SA(0, 1), a2 + hstep, voffA);
            PG8_WAIT_V(8); PG8_WAIT_L(0); PG8_BAR; PG8_MMA(0, 0, At, B0); PG8_MMA(0, 1, At, B1); PG8_BAR; PG8_SCHED;
            PG8_LDA(At, 1, 1); PG8_STAGE(PG8_SB(1, 0), b3, voffB); PG8_STAGE(PG8_SB(1, 1), b3 + hstep, voffB); PG8_STAGE(PG8_SA(1, 0), a3, voffA);
            PG8_WAIT_V(8); PG8_WAIT_L(0); PG8_BAR; PG8_MMA(1, 0, At, B0); PG8_MMA(1, 1, At, B1); PG8_BAR; PG8_SCHED;
            } else {
            PG8_LDB(B0, 0, 0); PG8_SCHED; PG8_LDA(At, 0, 0); PG8_STAGE(PG8_SA(1, 1), a1 + hstep, voffA);
            PG8_WAIT_L(8); PG8_BAR; PG8_WAIT_L(0); PG8_MMA(0, 0, At, B0); PG8_BAR; PG8_SCHED;
            PG8_LDB(B1, 0, 1); PG8_STAGE(PG8_SB(0, 0), b2, voffB);
            PG8_BAR; PG8_WAIT_L(0); PG8_MMA(0, 1, At, B1); PG8_BAR;
            PG8_LDA(At, 0, 1); PG8_STAGE(PG8_SA(0, 0), a2, voffA);
            PG8_BAR; PG8_WAIT_L(0); PG8_MMA(1, 0, At, B0); PG8_BAR; PG8_SCHED;
            PG8_STAGE(PG8_SB(0, 1), b2 + hstep, voffB);
            PG8_WAIT_V(6); PG8_BAR; PG8_MMA(1, 1, At, B1); PG8_BAR;
            PG8_LDB(B0, 1, 0); PG8_SCHED; PG8_LDA(At, 1, 0); PG8_STAGE(PG8_SA(0, 1), a2 + hstep, voffA);
            PG8_WAIT_L(8); PG8_BAR; PG8_WAIT_L(0); PG8_MMA(0, 0, At, B0); PG8_BAR; PG8_SCHED;
            PG8_LDB(B1, 1, 1); PG8_STAGE(PG8_SB(1, 0), b3, voffB);
            PG8_BAR; PG8_WAIT_L(0); PG8_MMA(0, 1, At, B1); PG8_BAR;
            PG8_LDA(At, 1, 1); PG8_STAGE(PG8_SA(1, 0), a3, voffA);
            PG8_BAR; PG8_WAIT_L(0); PG8_MMA(1, 0, At, B0); PG8_BAR; PG8_SCHED;
            PG8_STAGE(PG8_SB(1, 1), b3 + hstep, voffB);
            PG8_WAIT_V(6); PG8_BAR; PG8_MMA(1, 1, At, B1); PG8_BAR;
            }
        }
        if constexpr (ALIGN_EPI) { if (wr == 0) PG8_BAR; }
        if constexpr (!Epi::AFTER_DRAIN) { if constexpr (Epi::RSTD) E(acc, cur, wr, wc, fr, fq, (const PG8_LAS f32x4*)(lds + STAGE_BYTES + (ui & 1) * 4096), (const PG8_LAS f32x4*)(lds + STAGE_BYTES + 12288 + (ui & 1) * 1024)); else E(acc, cur, wr, wc, fr, fq); S.done(cur); }
        if (!has_next) break;
#pragma unroll
        for (int a = 0; a < 2; ++a)
#pragma unroll
            for (int b = 0; b < 2; ++b)
#pragma unroll
                for (int m = 0; m < 4; ++m)
#pragma unroll
                    for (int n = 0; n < 2; ++n) acc[a][b][m][n] = (f32x4){0.f, 0.f, 0.f, 0.f};
        cur = nxt; cA = nA; cB = nB; ++ui;
        if constexpr (ALIGN_EPI) { if (wr == 1) PG8_BAR; }
    }
    PG8_WAIT_V(0);
    if constexpr (!ALIGN_EPI) { if (wr == 0) PG8_BAR; }
    PG8_BAR;
    if constexpr (Epi::AFTER_DRAIN) { E.fused(acc, cur, wr, wc, fr, fq, lds, wid, lane); S.done(cur); }
#undef PG8_SA
#undef PG8_SB
#undef PG8_STAGE
#undef PG8_LDA
#undef PG8_LDB
#undef PG8_MMA
#undef PG8_WAIT_V
#undef PG8_WAIT_L
#undef PG8_BAR
#undef PG8_SCHED
}
}
#include <hip/hip_bf16.h>
#include <cmath>
namespace attn_body {
using bf16=__hip_bfloat16;
using bf16x8=__attribute__((ext_vector_type(8)))short;
using s16x4=__attribute__((ext_vector_type(4)))short;
using f32x16=__attribute__((ext_vector_type(16)))float;
using u32x4=__attribute__((ext_vector_type(4)))unsigned;
constexpr int BATCH=32,NHEAD=16,SEQ=2048,D=64,DM=3072,DMO=1024;
constexpr int NW=8,QBLK=32,QB=QBLK*NW,KVBLK=64,NQB=SEQ/QB;
constexpr int ATTN_PITCH=DM, ATTN_UNIT_ROWS=QB;
__device__ __forceinline__ int crow(int r,int hi){return (r&3)+8*(r>>2)+4*hi;}
#define SBAR() __builtin_amdgcn_sched_barrier(0)
__device__ __forceinline__ void cmask(f32x16&p0,f32x16&p1,int jb,int qrel,int hi){
  const float NEG=-INFINITY; int kb=64*jb+4*hi;
  #pragma unroll
  for(int r=0;r<16;++r){int kv=kb+(r&3)+8*(r>>2); if(kv>qrel)p0[r]=NEG; if(kv+32>qrel)p1[r]=NEG;}
}

constexpr int NSLOT=3, SLOTB=8192;
constexpr int LDS_K=0, LDS_V=NSLOT*SLOTB, LDS_WS=2*NSLOT*SLOTB, LDS_OST=LDS_WS+NW*64*4, LDS_BYTES=LDS_OST+NW*4096;
constexpr float C2=0.125f*1.4426950408889634f;
__device__ __forceinline__ void glds16(const void*gsrc,unsigned lds_dst){unsigned keep;
  asm volatile("s_mov_b32 %0, m0\n\ts_mov_b32 m0, %2\n\ts_nop 0\n\tglobal_load_lds_dwordx4 %1, off\n\ts_mov_b32 m0, %0":"=&s"(keep):"v"(gsrc),"s"(lds_dst):"memory");}
__device__ __forceinline__ float max3f(float a,float b,float c){float r;asm("v_max3_f32 %0, %1, %2, %3":"=v"(r):"v"(a),"v"(b),"v"(c));return r;}
__device__ __forceinline__ float max2f(float a,float b){float r;asm("v_max_f32_e32 %0, %1, %2":"=v"(r):"v"(a),"v"(b));return r;}
__device__ __forceinline__ float fadd_s(float a,float b){float r;asm("v_add_f32_e32 %0, %1, %2":"=v"(r):"v"(a),"v"(b));return r;}
__device__ __forceinline__ float fsub_s(float a,float b){float r;asm("v_sub_f32_e32 %0, %1, %2":"=v"(r):"v"(a),"v"(b));return r;}
typedef float f32x2_t __attribute__((ext_vector_type(2))); typedef __bf16 bf16x2_t __attribute__((ext_vector_type(2)));
__device__ __forceinline__ unsigned cvtpk_s(float lo,float hi){f32x2_t v={lo,hi};bf16x2_t b=__builtin_convertvector(v,bf16x2_t);return __builtin_bit_cast(unsigned,b);}
#define WAIT_BAR(N) asm volatile("s_waitcnt vmcnt(" #N ") lgkmcnt(0)\n\ts_barrier":::"memory")

__device__ __forceinline__ void qkt(f32x16&p0,f32x16&p1,const char*Kslot,const bf16x8*qr,const f32x16&negm,int r32,int hi){
  const char*kb=Kslot+hi*1024+r32*16;
  #pragma unroll
  for(int d0=0;d0<4;++d0){
    const bf16x8 b0=*reinterpret_cast<const bf16x8*>(kb+d0*2048);
    const bf16x8 b1=*reinterpret_cast<const bf16x8*>(kb+d0*2048+512);
    if(d0==0){p0=__builtin_amdgcn_mfma_f32_32x32x16_bf16(b0,qr[0],negm,0,0,0);p1=__builtin_amdgcn_mfma_f32_32x32x16_bf16(b1,qr[0],negm,0,0,0);}
    else{p0=__builtin_amdgcn_mfma_f32_32x32x16_bf16(b0,qr[d0],p0,0,0,0);p1=__builtin_amdgcn_mfma_f32_32x32x16_bf16(b1,qr[d0],p1,0,0,0);}}
}
typedef __attribute__((address_space(3))) const char* lds_cptr;
typedef short v4i16_t __attribute__((ext_vector_type(4)));
__device__ __forceinline__ void kload8(bf16x8*kf,lds_cptr kp){
  kf[0]=*(const __attribute__((address_space(3))) bf16x8*)(kp);      kf[1]=*(const __attribute__((address_space(3))) bf16x8*)(kp+512);
  kf[2]=*(const __attribute__((address_space(3))) bf16x8*)(kp+2048); kf[3]=*(const __attribute__((address_space(3))) bf16x8*)(kp+2560);
  kf[4]=*(const __attribute__((address_space(3))) bf16x8*)(kp+4096); kf[5]=*(const __attribute__((address_space(3))) bf16x8*)(kp+4608);
  kf[6]=*(const __attribute__((address_space(3))) bf16x8*)(kp+6144); kf[7]=*(const __attribute__((address_space(3))) bf16x8*)(kp+6656);
}
__device__ __forceinline__ void kload2(bf16x8*kf,lds_cptr kp,int j){ kf[2*j]=*(const __attribute__((address_space(3))) bf16x8*)(kp+j*2048); kf[2*j+1]=*(const __attribute__((address_space(3))) bf16x8*)(kp+j*2048+512); }
__device__ __forceinline__ s16x4 vtr(lds_cptr p){ return __builtin_bit_cast(s16x4,__builtin_amdgcn_ds_read_tr16_b64_v4i16((__attribute__((address_space(3))) v4i16_t*)p)); }
__device__ __forceinline__ float rowmax(const f32x16&p0,const f32x16&p1){
  float a=max3f(p0[0],p0[1],p1[0]),b=max3f(p0[2],p0[3],p1[1]);a=max3f(a,p1[2],p1[3]);
  #pragma unroll
  for(int r=4;r<16;r+=4){a=max3f(a,p0[r],p0[r+1]);b=max3f(b,p0[r+2],p0[r+3]);a=max3f(a,p1[r],p1[r+1]);b=max3f(b,p1[r+2],p1[r+3]);}
  const float m=max2f(a,b);
  auto rr=__builtin_amdgcn_permlane32_swap(__float_as_uint(m),__float_as_uint(m),false,false);
  return max2f(__uint_as_float(rr[0]),__uint_as_float(rr[1]));
}
__device__ __forceinline__ void pv(f32x16*o,int vb,bf16x8 pa0,bf16x8 pa1,bf16x8 pa2,bf16x8 pa3){
  #pragma unroll
  for(int d0=0;d0<2;++d0){s16x4 lo[4],hi[4];
    #pragma unroll
    for(int ks=0;ks<4;++ks){
      asm volatile("ds_read_b64_tr_b16 %0,%1 offset:%c2":"=&v"(lo[ks]):"v"(vb),"i"(d0*4096+ks*1024):"memory");
      asm volatile("ds_read_b64_tr_b16 %0,%1 offset:%c2":"=&v"(hi[ks]):"v"(vb),"i"(d0*4096+ks*1024+512):"memory");}
    asm volatile("s_waitcnt lgkmcnt(0)":::"memory");SBAR();
    #define PK(k) (bf16x8){lo[k][0],lo[k][1],lo[k][2],lo[k][3],hi[k][0],hi[k][1],hi[k][2],hi[k][3]}
    o[d0]=__builtin_amdgcn_mfma_f32_32x32x16_bf16(pa0,PK(0),o[d0],0,0,0);
    o[d0]=__builtin_amdgcn_mfma_f32_32x32x16_bf16(pa1,PK(1),o[d0],0,0,0);
    o[d0]=__builtin_amdgcn_mfma_f32_32x32x16_bf16(pa2,PK(2),o[d0],0,0,0);
    o[d0]=__builtin_amdgcn_mfma_f32_32x32x16_bf16(pa3,PK(3),o[d0],0,0,0);
    #undef PK
  }
}

#ifndef ATTN_STORE16
#define ATTN_STORE16(p,v) (*(u32x4*)(p)=(v))
#endif
template<int THRL> __device__ __forceinline__ void attn_unit(int b,int h,int qb,const bf16*Q,const bf16*__restrict__ K,const bf16*__restrict__ V,bf16*O,char*shm){
  const int tid=threadIdx.x,lane=tid&63,r32=lane&31,hi=lane>>5; const int wid=__builtin_amdgcn_readfirstlane(tid>>6);
  const long rowbase=(long)b*SEQ; const int q0=qb*QB;
  const bf16*Qw=Q+(rowbase+q0+wid*QBLK)*DM+1536+(h>>1)*64;
  const bf16*Kh=K+rowbase*DM+2048+(h>>1)*64,*Vh=V+rowbase*DM+2560+(h>>2)*128+(h&1)*64;
  const unsigned lds0=(unsigned)(uintptr_t)shm;
  float*wsf=(float*)(shm+LDS_WS)+wid*64;
  const bf16*ksrc=Kh+(long)lane*DM+wid*8;
  const bf16*vsrc=Vh+(long)(16*(wid&3)+(lane>>2))*DM+(wid>>2)*32+(lane&3)*8;
  const unsigned kdst=lds0+LDS_K+wid*1024, vdst=lds0+LDS_V+wid*1024;
  #define DMA_K(t,slot) glds16(ksrc+(long)(t)*KVBLK*DM,(unsigned)__builtin_amdgcn_readfirstlane(kdst+(slot)))
  #define DMA_V(t,slot) glds16(vsrc+(long)(t)*KVBLK*DM,(unsigned)__builtin_amdgcn_readfirstlane(vdst+(slot)))
  const int vb0=(int)(lds0+LDS_V)+((lane>>4)&1)*32+(lane&3)*8+(4*hi+((lane&15)>>2))*64;
  const char*Kbase=shm+LDS_K; bf16x8 kf[8];
  const lds_cptr shm3=(lds_cptr)shm; const lds_cptr kp0=shm3+LDS_K+hi*1024+r32*16; const lds_cptr vp0=shm3+LDS_V+((lane>>4)&1)*32+(lane&3)*8+(4*hi+((lane&15)>>2))*64;
  const int NT=(q0+QB)/KVBLK;
  DMA_K(0,0);DMA_V(0,0);DMA_K(1,SLOTB);
  bf16x8 qr[4];
  #pragma unroll
  for(int d0=0;d0<4;++d0)qr[d0]=*reinterpret_cast<const bf16x8*>(&Qw[(long)r32*DM+d0*16+hi*8]);
  float mhat=0.f,l_reg=0.f;f32x16 o[2];o[0]=f32x16{};o[1]=f32x16{};f32x16 negm=f32x16{};asm volatile("":"+v"(negm));
  const int qrel=wid*QBLK+r32;
  #define CMASK(P0,P1,t) do{int jb_=(t)-(NT-4); if(jb_>=0)cmask(P0,P1,jb_,qrel,hi);}while(0)
  bool resc=false;
  #define START(P0,P1) do{ const float rm=rowmax(P0,P1); resc=false; \
    { const float dl=rm; mhat=fadd_s(mhat,dl); \
      _Pragma("unroll") for(int r=0;r<16;++r){P0[r]=fsub_s(P0[r],dl);P1[r]=fsub_s(P1[r],dl);} \
      _Pragma("unroll") for(int r=0;r<16;++r)negm[r]=-mhat; asm volatile("":"+v"(negm)); } \
    _Pragma("unroll") for(int r=0;r<16;++r)P0[r]=__builtin_amdgcn_exp2f(P0[r]); }while(0)
  #define RESC() do{ if(resc){ asm volatile("s_waitcnt lgkmcnt(0)":::"memory"); \
      _Pragma("unroll") for(int d_=0;d_<2;++d_) _Pragma("unroll") for(int r=0;r<16;++r)o[d_][r]*=wsf[crow(r,hi)]; } }while(0)
  f32x16 pA0,pA1,pB0,pB1;
  int sl_prev=0,sl_cur=0,sl_next=SLOTB;
  #define ROT() do{sl_prev=sl_cur;sl_cur=sl_next;sl_next=(sl_next==(NSLOT-1)*SLOTB)?0:sl_next+SLOTB;}while(0)
  DMA_K(2,2*SLOTB);
  WAIT_BAR(3);
  qkt(pA0,pA1,Kbase,qr,negm,r32,hi);asm volatile("s_nop 15\n\ts_nop 7":"+v"(pA0),"+v"(pA1));CMASK(pA0,pA1,0);
  START(pA0,pA1);
  _Pragma("unroll") for(int r=0;r<16;++r)pA1[r]=__builtin_amdgcn_exp2f(pA1[r]);
  WAIT_BAR(0);
  DMA_K(3,0);DMA_V(1,SLOTB);
  ROT();
  kload8(kf,kp0+sl_cur);
  WAIT_BAR(2);
  s16x4 vlo[8],vhi[8]; u32x4 pw0,pw1,pw2,pw3;
  #define PKW(P,B) cvtpk_s(P[B],P[B+1])
  #define PAF(k) __builtin_bit_cast(bf16x8,pw##k)
  #define VFR(i) (bf16x8){vlo[i][0],vlo[i][1],vlo[i][2],vlo[i][3],vhi[i][0],vhi[i][1],vhi[i][2],vhi[i][3]}
  #define PIN(x) asm volatile("":"+v"(x))
  #define MX3(a,b,c) __builtin_fmaxf(__builtin_fmaxf((a),(b)),(c))
  #define GAPA(MF,A0,A1,A2,A3,W0,W1,PW) do{ MF; sacc+=A0; sacc+=A1; sacc+=A2; sacc+=A3; PIN(sacc); W0; W1; PIN(PW); SBAR(); }while(0)
  #define EX(v) __builtin_amdgcn_exp2f(v)
  #define GAPB(MF,X,B) do{ MF; X[B]=EX(X[B]); X[B+1]=EX(X[B+1]); X[B+2]=EX(X[B+2]); X[B+3]=EX(X[B+3]); PIN(X); SBAR(); }while(0)
  #define VRD(i) do{ vlo[i]=vtr(vp_+(((i)>>2)*4096+((i)&3)*1024)); vhi[i]=vtr(vp_+(((i)>>2)*4096+((i)&3)*1024+512)); }while(0)
  #define KRD(G,j) do{ if(G){ kload2(kf,kp0+sl_next,j); SBAR(); } }while(0)
  #define STEP(C0,C1,P0,P1,t,GK,GV,GL) do{ SBAR(); \
    const lds_cptr vp_=vp0+sl_prev; \
    VRD(0); SBAR(); float sacc=(P0[0]+P0[1]); \
    GAPA(C0=__builtin_amdgcn_mfma_f32_32x32x16_bf16(kf[0],qr[0],negm,0,0,0), P0[2],P0[3],P0[4],P0[5],     pw0[0]=PKW(P0,0), pw0[1]=PKW(P0,2), pw0); \
    VRD(4); SBAR(); GAPA(C1=__builtin_amdgcn_mfma_f32_32x32x16_bf16(kf[1],qr[0],negm,0,0,0), P0[6],P0[7],P0[8],P0[9],     pw0[2]=PKW(P0,4), pw0[3]=PKW(P0,6), pw0); \
    VRD(1); SBAR(); GAPA(C0=__builtin_amdgcn_mfma_f32_32x32x16_bf16(kf[2],qr[1],C0,0,0,0),   P0[10],P0[11],P0[12],P0[13], pw1[0]=PKW(P0,8), pw1[1]=PKW(P0,10), pw1); \
    VRD(5); SBAR(); GAPA(C1=__builtin_amdgcn_mfma_f32_32x32x16_bf16(kf[3],qr[1],C1,0,0,0),   P0[14],P0[15],P1[0],P1[1],   pw1[2]=PKW(P0,12),pw1[3]=PKW(P0,14), pw1); \
    VRD(2); SBAR(); GAPA(C0=__builtin_amdgcn_mfma_f32_32x32x16_bf16(kf[4],qr[2],C0,0,0,0),   P1[2],P1[3],P1[4],P1[5],     pw2[0]=PKW(P1,0), pw2[1]=PKW(P1,2), pw2); \
    VRD(6); SBAR(); GAPA(C1=__builtin_amdgcn_mfma_f32_32x32x16_bf16(kf[5],qr[2],C1,0,0,0),   P1[6],P1[7],P1[8],P1[9],     pw2[2]=PKW(P1,4), pw2[3]=PKW(P1,6), pw2); \
    VRD(3); SBAR(); GAPA(C0=__builtin_amdgcn_mfma_f32_32x32x16_bf16(kf[6],qr[3],C0,0,0,0),   P1[10],P1[11],P1[12],P1[13], pw3[0]=PKW(P1,8), pw3[1]=PKW(P1,10), pw3); \
    VRD(7); SBAR(); GAPA(C1=__builtin_amdgcn_mfma_f32_32x32x16_bf16(kf[7],qr[3],C1,0,0,0),   P1[14],P1[15],0.f,0.f,       pw3[2]=PKW(P1,12),pw3[3]=PKW(P1,14), pw3); \
    l_reg+=sacc; \
    if(GK){DMA_K((t)+3,sl_cur);} if(GV){DMA_V((t)+1,sl_next);} \
    CMASK(C0,C1,t); \
    { float a=MX3(C0[0],C0[1],C1[0]),b=MX3(C0[2],C0[3],C1[1]); a=MX3(a,C1[2],C1[3]); \
      _Pragma("unroll") for(int r=4;r<16;r+=4){a=MX3(a,C0[r],C0[r+1]);b=MX3(b,C0[r+2],C0[r+3]);a=MX3(a,C1[r],C1[r+1]);b=MX3(b,C1[r+2],C1[r+3]);} \
      float rm=__builtin_fmaxf(a,b); { auto rr=__builtin_amdgcn_permlane32_swap(__float_as_uint(rm),__float_as_uint(rm),false,false); rm=__builtin_fmaxf(__uint_as_float(rr[0]),__uint_as_float(rr[1])); } \
      resc=false; \
      if(__builtin_expect(__any(rm>(float)THRL),0)){ const float dl=__builtin_fmaxf(rm,0.f); mhat+=dl; \
        _Pragma("unroll") for(int r=0;r<16;++r){C0[r]-=dl;C1[r]-=dl;} \
        _Pragma("unroll") for(int r=0;r<16;++r)negm[r]=-mhat; asm volatile("":"+v"(negm)); \
        const float f=__builtin_amdgcn_exp2f(-dl); l_reg*=f; if(hi==0)wsf[r32]=f; resc=true; } } \
    SBAR(); \
    GAPB(o[0]=__builtin_amdgcn_mfma_f32_32x32x16_bf16(PAF(0),VFR(0),o[0],0,0,0), C0,0); \
    GAPB(o[1]=__builtin_amdgcn_mfma_f32_32x32x16_bf16(PAF(0),VFR(4),o[1],0,0,0), C0,4); \
    KRD(GL,0); GAPB(o[0]=__builtin_amdgcn_mfma_f32_32x32x16_bf16(PAF(1),VFR(1),o[0],0,0,0), C0,8); \
    KRD(GL,1); GAPB(o[1]=__builtin_amdgcn_mfma_f32_32x32x16_bf16(PAF(1),VFR(5),o[1],0,0,0), C0,12); \
    KRD(GL,2); GAPB(o[0]=__builtin_amdgcn_mfma_f32_32x32x16_bf16(PAF(2),VFR(2),o[0],0,0,0), C1,0); \
    KRD(GL,3); GAPB(o[1]=__builtin_amdgcn_mfma_f32_32x32x16_bf16(PAF(2),VFR(6),o[1],0,0,0), C1,4); \
    GAPB(o[0]=__builtin_amdgcn_mfma_f32_32x32x16_bf16(PAF(3),VFR(3),o[0],0,0,0), C1,8); \
    GAPB(o[1]=__builtin_amdgcn_mfma_f32_32x32x16_bf16(PAF(3),VFR(7),o[1],0,0,0), C1,12); \
    }while(0)
  int t=1;
  #undef CMASK
  #define CMASK(P0,P1,t) do{}while(0)
  for(;t+5<NT;t+=2){
    STEP(pB0,pB1,pA0,pA1,t,true,true,true);     WAIT_BAR(2); RESC(); ROT();
    STEP(pA0,pA1,pB0,pB1,t+1,true,true,true);   WAIT_BAR(2); RESC(); ROT();
  }
  #undef CMASK
  #define CMASK(P0,P1,t) do{int jb_=(t)-(NT-4); if(jb_>=0)cmask(P0,P1,jb_,qrel,hi);}while(0)
  #define ENDW(tt) do{ if((tt)+3<NT){WAIT_BAR(2);} else if((tt)+2<NT){WAIT_BAR(1);} else {WAIT_BAR(0);} }while(0)
  for(;t+1<NT;t+=2){
    STEP(pB0,pB1,pA0,pA1,t,(t+3<NT),(t+1<NT),(t+1<NT));       ENDW(t);   RESC(); ROT();
    STEP(pA0,pA1,pB0,pB1,t+1,(t+4<NT),(t+2<NT),(t+2<NT));     ENDW(t+1); RESC(); ROT();
  }
  STEP(pB0,pB1,pA0,pA1,NT-1,false,false,false); RESC();
  { float sacc=pB0[0]+pB0[1]; _Pragma("unroll") for(int r=2;r<16;++r)sacc+=pB0[r]; _Pragma("unroll") for(int r=0;r<16;++r)sacc+=pB1[r]; l_reg+=sacc;
    pw0=(u32x4){PKW(pB0,0),PKW(pB0,2),PKW(pB0,4),PKW(pB0,6)};pw1=(u32x4){PKW(pB0,8),PKW(pB0,10),PKW(pB0,12),PKW(pB0,14)};pw2=(u32x4){PKW(pB1,0),PKW(pB1,2),PKW(pB1,4),PKW(pB1,6)};pw3=(u32x4){PKW(pB1,8),PKW(pB1,10),PKW(pB1,12),PKW(pB1,14)};
    SBAR(); pv(o,vb0+sl_cur,PAF(0),PAF(1),PAF(2),PAF(3)); }
  #undef PKW
  #undef PAF
  #undef VFR
  #undef PIN
  #undef MX3
  #undef GAPA
  #undef GAPB
  #undef EX
  #undef VRD
  #undef KRD
  #undef STEP
  #undef ENDW
  {auto rr=__builtin_amdgcn_permlane32_swap(__float_as_uint(l_reg),__float_as_uint(l_reg),false,false);l_reg=__uint_as_float(rr[0])+__uint_as_float(rr[1]);}
  if(hi==0)wsf[32+r32]=l_reg;asm volatile("s_waitcnt lgkmcnt(0)":::"memory");
  float rli[16];
  #pragma unroll
  for(int r=0;r<16;++r)rli[r]=__builtin_amdgcn_rcpf(wsf[32+crow(r,hi)]);
  bf16*Ow=O+(rowbase+q0+wid*QBLK)*DMO+h*D;
  { bf16*stg=(bf16*)(shm+LDS_OST)+wid*2048;
    #pragma unroll
    for(int r=0;r<16;++r){const int orow=crow(r,hi);
      #pragma unroll
      for(int d0=0;d0<2;++d0)stg[orow*64+d0*32+r32]=__float2bfloat16(o[d0][r]*rli[r]);}
    asm volatile("s_waitcnt lgkmcnt(0)":::"memory");
    #pragma unroll
    for(int i=0;i<4;++i){const int row=i*8+(lane>>3),ch=lane&7; const u32x4 v=*(const u32x4*)(stg+row*64+ch*8); ATTN_STORE16(Ow+(long)row*DMO+ch*8,v);} }
  asm volatile("s_waitcnt lgkmcnt(0)\n\ts_barrier":::"memory");
  #undef DMA_K
  #undef DMA_V
  #undef CMASK
  #undef START
  #undef RESC
  #undef ROT
}
constexpr int ATTN_LDS_BYTES=LDS_BYTES;
struct AttnTensors { const bf16* Q; const bf16* K; const bf16* V; bf16* O; };
struct AttnUnit { int bh; int qb; };
struct StaticOrder {
  int vcu;
  __device__ __forceinline__ explicit StaticOrder(int grid,int block):vcu((block%8)*(grid/8)+block/8){}
  __device__ __forceinline__ bool next(int i,AttnUnit&u)const{ if(i>=16)return false; const int j=i&7; u.bh=vcu*2+(i>>3); u.qb=(j&1)?7-(j>>1):(j>>1); return true; }
  __device__ __forceinline__ void a_ready(const AttnUnit&)const{}
  __device__ __forceinline__ void done(const AttnUnit&)const{}
};
template<class Sched,int THRL=8> __device__ __forceinline__ void attn_phase(char*lds,const AttnTensors&T,const Sched&S){
  AttnUnit u;
  for(int i=0;S.next(i,u);++i){ S.a_ready(u); attn_unit<THRL>(u.bh/NHEAD,u.bh%NHEAD,u.qb,T.Q,T.K,T.V,T.O,lds); S.done(u); }
}
#undef SBAR
#undef WAIT_BAR
}
namespace mixa {
using bf16x8 = __attribute__((ext_vector_type(8))) short;
using s16x4 = __attribute__((ext_vector_type(4))) short;
using f32x16 = __attribute__((ext_vector_type(16))) float;
using f32x4 = __attribute__((ext_vector_type(4))) float;
using u32x4 = __attribute__((ext_vector_type(4))) unsigned;
typedef short v4i16_t __attribute__((ext_vector_type(4)));
#define MA_LAS __attribute__((address_space(3)))
typedef unsigned short bf16;
constexpr int PQ = 3072, TT = 2048, PY = 1024;
constexpr int XO = 0, XM = 65536, XL = XM + 1024, WV = XL + 1024, WSZ = 4096 + 256;
constexpr int LDS_NEED = WV + 8 * WSZ;
__device__ __forceinline__ int crow(int r, int hi) { return (r & 3) + 8 * (r >> 2) + 4 * hi; }
__device__ __forceinline__ unsigned cvtpk(float lo, float hi) { typedef float f2 __attribute__((ext_vector_type(2))); typedef __bf16 b2 __attribute__((ext_vector_type(2))); f2 v = {lo, hi}; b2 b = __builtin_convertvector(v, b2); return __builtin_bit_cast(unsigned, b); }
template <int BR> __device__ __forceinline__ int qloc(int w, int i) {
    if (BR == 0) return 32 * w + i;
    if (BR == 1) return (w & 3) + 4 * (32 * (w >> 2) + i);
    return (2 * w + (i >> 4)) + 16 * (i & 15);
}
struct State { f32x16 o[2]; float m, l; };
template <int BR> __device__ __forceinline__ void xchg_write(const State& S, MA_LAS unsigned char* L, int w, int r32, int hi) {
    MA_LAS float* xo = (MA_LAS float*)(L + XO);
#pragma unroll
    for (int r = 0; r < 16; ++r) { const int ql = qloc<BR>(w, crow(r, hi)); xo[ql * 64 + r32] = S.o[0][r]; xo[ql * 64 + 32 + r32] = S.o[1][r]; }
    const float lt = S.l + __shfl_xor(S.l, 32);
    if (hi == 0) { const int ql = qloc<BR>(w, r32); ((MA_LAS float*)(L + XM))[ql] = S.m; ((MA_LAS float*)(L + XL))[ql] = lt; }
}
template <int BR> __device__ __forceinline__ void xchg_read(State& S, MA_LAS unsigned char* L, int w, int r32, int hi) {
    const MA_LAS float* xo = (const MA_LAS float*)(L + XO);
#pragma unroll
    for (int r = 0; r < 16; ++r) { const int ql = qloc<BR>(w, crow(r, hi)); S.o[0][r] = xo[ql * 64 + r32]; S.o[1][r] = xo[ql * 64 + 32 + r32]; }
    const int ql = qloc<BR>(w, r32);
    S.m = ((const MA_LAS float*)(L + XM))[ql]; const float lt = ((const MA_LAS float*)(L + XL))[ql]; S.l = (hi == 0) ? lt : 0.f;
}
template <int BR> __device__ __forceinline__ void branch(State& S, const bf16* Qb, int t0, MA_LAS unsigned char* L, int w, int lane) {
    constexpr int STRIDE = (BR == 0) ? 1 : (BR == 1) ? 4 : 16;
    const int r32 = lane & 31, hi = lane >> 5;
    const bf16* Kb = Qb + 512; const bf16* Vb = Qb + 1024;
    MA_LAS unsigned char* img = L + WV + w * WSZ; MA_LAS float* SC = (MA_LAS float*)(img + 4096);
    const int qi = (BR == 0) ? t0 + 32 * w + r32 : (BR == 1) ? (t0 >> 2) + 32 * (w >> 2) + r32 : (t0 >> 4) + (r32 & 15);
    const int qc = (BR == 2) ? (r32 >> 4) : 0;
    bf16x8 qf[4];
    { const bf16* qp = Qb + (size_t)(t0 + qloc<BR>(w, r32)) * PQ + 8 * hi;
#pragma unroll
      for (int d0 = 0; d0 < 4; ++d0) qf[d0] = *(const bf16x8*)(qp + 16 * d0); }
    const int nt2 = ((t0 >> 4) + 16 + 31) >> 5;
    const int ntile = (BR == 2) ? 2 * nt2 : 5;
    const int kbase = (BR == 0) ? t0 + 32 * w - 128 : (BR == 1) ? (t0 >> 2) + 32 * (w >> 2) - 128 : 0;
    const int res01 = (BR == 1) ? (w & 3) : 0;
    int n = 0;
    if (BR != 2) { while (n < ntile && kbase + 32 * n + 31 < 0) ++n; }
#define MA_TILE(nn, cls_, k0_, res_) const int cls_ = (BR == 2) ? ((nn) >= nt2 ? 1 : 0) : 0; const int k0_ = (BR == 2) ? 32 * ((nn) - cls_ * nt2) : kbase + 32 * (nn); const int res_ = (BR == 2) ? 2 * w + cls_ : res01
#define MA_LOADS(kf_, vr_, k0_, res_) do { \
        int kj_ = k0_ + r32; kj_ = kj_ < 0 ? 0 : kj_; const bf16* kp_ = Kb + (size_t)(res_ + STRIDE * kj_) * PQ + 8 * hi; \
        _Pragma("unroll") for (int d0 = 0; d0 < 4; ++d0) kf_[d0] = *(const bf16x8*)(kp_ + 16 * d0); \
        int vj_ = k0_ + (lane >> 1); vj_ = vj_ < 0 ? 0 : vj_; const bf16* vp_ = Vb + (size_t)(res_ + STRIDE * vj_) * PQ + 32 * (lane & 1); \
        _Pragma("unroll") for (int c = 0; c < 4; ++c) vr_[c] = *(const u32x4*)(vp_ + 8 * c); } while (0)
    bf16x8 kfn[4]; u32x4 vrn[4];
    if (n < ntile) { MA_TILE(n, c0, k00, r00); MA_LOADS(kfn, vrn, k00, r00); }
    const int trb = ((lane >> 4) & 1) * 32 + (lane & 3) * 8 + (4 * hi + ((lane & 15) >> 2)) * 64;
    for (; n < ntile; ++n) {
        MA_TILE(n, cls, k0, res); (void)res;
        bf16x8 kf[4]; u32x4 vr[4];
#pragma unroll
        for (int c = 0; c < 4; ++c) { kf[c] = kfn[c]; vr[c] = vrn[c]; }
        asm volatile("" ::: "memory");
#pragma unroll
        for (int c = 0; c < 4; ++c) *(MA_LAS u32x4*)(img + (lane & 1) * 2048 + (lane >> 1) * 64 + c * 16) = vr[c];
        if (n + 1 < ntile) { MA_TILE(n + 1, c1, k01, r01); (void)c1; MA_LOADS(kfn, vrn, k01, r01); }
        f32x16 s = {};
#pragma unroll
        for (int d0 = 0; d0 < 4; ++d0) s = __builtin_amdgcn_mfma_f32_32x32x16_bf16(kf[d0], qf[d0], s, 0, 0, 0);
        const int dbase = k0 + 4 * hi - qi; const int lo = (-qi > -128) ? -qi : -128; const bool tok = (BR != 2) || (qc == cls);
        float tm = -INFINITY;
#pragma unroll
        for (int r = 0; r < 16; ++r) { const int d = dbase + (r & 3) + 8 * (r >> 2); s[r] = (tok && d <= 0 && d >= lo) ? s[r] : -INFINITY; tm = fmaxf(tm, s[r]); }
        tm = fmaxf(tm, __shfl_xor(tm, 32));
        const float mn = fmaxf(S.m, tm), sc = __builtin_amdgcn_exp2f(S.m - mn);
        float ps = 0.f;
#pragma unroll
        for (int r = 0; r < 16; ++r) { s[r] = __builtin_amdgcn_exp2f(s[r] - mn); ps += s[r]; }
        S.l = S.l * sc + ps; S.m = mn;
        if (__any(sc != 1.f)) {
            if (hi == 0) SC[r32] = sc;
            asm volatile("s_waitcnt lgkmcnt(0)" ::: "memory");
#pragma unroll
            for (int j = 0; j < 4; ++j) { const f32x4 f = *(const MA_LAS f32x4*)(SC + 8 * j + 4 * hi);
#pragma unroll
                for (int e = 0; e < 4; ++e) { S.o[0][4 * j + e] *= f[e]; S.o[1][4 * j + e] *= f[e]; } }
        }
        u32x4 p0, p1;
        p0[0] = cvtpk(s[0], s[1]); p0[1] = cvtpk(s[2], s[3]); p0[2] = cvtpk(s[4], s[5]); p0[3] = cvtpk(s[6], s[7]);
        p1[0] = cvtpk(s[8], s[9]); p1[1] = cvtpk(s[10], s[11]); p1[2] = cvtpk(s[12], s[13]); p1[3] = cvtpk(s[14], s[15]);
        const bf16x8 pa0 = __builtin_bit_cast(bf16x8, p0), pa1 = __builtin_bit_cast(bf16x8, p1);
        asm volatile("s_waitcnt lgkmcnt(0)" ::: "memory");
#pragma unroll
        for (int dh = 0; dh < 2; ++dh) {
#pragma unroll
            for (int ks = 0; ks < 2; ++ks) {
                const s16x4 vlo = __builtin_bit_cast(s16x4, __builtin_amdgcn_ds_read_tr16_b64_v4i16((MA_LAS v4i16_t*)(img + dh * 2048 + ks * 1024 + trb)));
                const s16x4 vhi = __builtin_bit_cast(s16x4, __builtin_amdgcn_ds_read_tr16_b64_v4i16((MA_LAS v4i16_t*)(img + dh * 2048 + ks * 1024 + 512 + trb)));
                const bf16x8 vf = (bf16x8){vlo[0], vlo[1], vlo[2], vlo[3], vhi[0], vhi[1], vhi[2], vhi[3]};
                S.o[dh] = __builtin_amdgcn_mfma_f32_32x32x16_bf16(ks == 0 ? pa0 : pa1, vf, S.o[dh], 0, 0, 0);
            }
        }
        asm volatile("s_waitcnt lgkmcnt(0)" ::: "memory");
    }
#undef MA_TILE
#undef MA_LOADS
}
__device__ __forceinline__ void unit(const bf16* QKV, bf16* Y, int b, int h, int t0, MA_LAS unsigned char* L, int tid) {
    const int lane = tid & 63, r32 = lane & 31, hi = lane >> 5; const int w = __builtin_amdgcn_readfirstlane(tid >> 6);
    const bf16* Qb = QKV + (size_t)b * TT * PQ + h * 64;
    State S; S.o[0] = f32x16{}; S.o[1] = f32x16{}; S.m = -1e30f; S.l = 0.f;
    branch<0>(S, Qb, t0, L, w, lane);
    xchg_write<0>(S, L, w, r32, hi); __syncthreads(); xchg_read<1>(S, L, w, r32, hi); __syncthreads();
    branch<1>(S, Qb, t0, L, w, lane);
    xchg_write<1>(S, L, w, r32, hi); __syncthreads(); xchg_read<2>(S, L, w, r32, hi); __syncthreads();
    branch<2>(S, Qb, t0, L, w, lane);
    { MA_LAS unsigned char* img = L + WV + w * WSZ; MA_LAS float* SC = (MA_LAS float*)(img + 4096);
      const float lt = S.l + __shfl_xor(S.l, 32);
      if (hi == 0) SC[r32] = 1.f / lt;
      asm volatile("s_waitcnt lgkmcnt(0)" ::: "memory");
      MA_LAS float* xo = (MA_LAS float*)(L + XO);
#pragma unroll
      for (int r = 0; r < 16; ++r) { const float f = SC[crow(r, hi)]; const int ql = qloc<2>(w, crow(r, hi)); xo[ql * 64 + r32] = S.o[0][r] * f; xo[ql * 64 + 32 + r32] = S.o[1][r] * f; } }
    __syncthreads();
    { const int row = tid >> 1, hf = tid & 1; const MA_LAS float* xr = (const MA_LAS float*)(L + XO) + row * 64 + 32 * hf;
      bf16* yp = Y + ((size_t)b * TT + t0 + row) * PY + h * 64 + 32 * hf;
#pragma unroll
      for (int c = 0; c < 4; ++c) { const f32x4 a = *(const MA_LAS f32x4*)(xr + 8 * c), bq = *(const MA_LAS f32x4*)(xr + 8 * c + 4);
          u32x4 o; o[0] = cvtpk(a[0], a[1]); o[1] = cvtpk(a[2], a[3]); o[2] = cvtpk(bq[0], bq[1]); o[3] = cvtpk(bq[2], bq[3]); *(u32x4*)(yp + 8 * c) = o; } }
    __syncthreads();
}
#undef MA_LAS
}
constexpr int NBATCH = 32, T = 2048, D = 1024, M = NBATCH * T, FF = 2816;
constexpr int NQKV = 3072, NGU = 2 * FF, NZX = 5888, NZX_SRC = 5656, KCD = 2048;
constexpr float RMS_EPS = 1e-6f;
constexpr int NWAVES = 8;
constexpr int NPH = 18;
constexpr size_t MiB = 1u << 20;
constexpr size_t WS_CTL = 0, CTL_ZERO_BYTES = 192 * 1024;
constexpr size_t WS_WDQ = 192 * 1024;
constexpr size_t DO_GATES = 0;
constexpr size_t DO_CS = 16 * MiB;
constexpr size_t WS_W_ABIN = 1 * MiB, WS_W_ABOUT = 7 * MiB, WS_W_GU0 = 9 * MiB, WS_W_DN0 = 20 * MiB, WS_W_CDIN = 26 * MiB, WS_W_CDOUT = 38 * MiB, WS_W_GU1 = 42 * MiB, WS_W_DN1 = 53 * MiB;
constexpr size_t WS_XN = 59 * MiB;
constexpr size_t WS_OB = 187 * MiB;
constexpr size_t WS_R = 315 * MiB;
constexpr size_t WS_QKV = WS_R, WS_ACT = WS_R, WS_U = WS_OB, WS_Z = WS_R, WS_XBC = WS_R + 128 * MiB, WS_V = WS_XBC + 192 * MiB, WS_O = WS_V + 128 * MiB, WS_YCD = WS_XN;
constexpr size_t WS_HB = WS_O + 128 * MiB;
constexpr size_t WS_RSS = WS_HB + 128 * MiB;
constexpr size_t WS_END = WS_RSS + 4 * MiB;
static_assert(WS_W_DN1 + (size_t)D * FF * 2 <= WS_XN && WS_W_CDIN + (size_t)NZX * D * 2 <= WS_W_CDOUT && WS_W_DN0 + (size_t)D * FF * 2 <= WS_W_CDIN, "weights map");
static_assert(WS_QKV + (size_t)M * NQKV * 2 <= WS_HB && WS_ACT + (size_t)M * FF * 2 <= WS_HB && WS_YCD + (size_t)M * KCD * 2 <= WS_R && WS_U + (size_t)M * D * 2 <= WS_R && WS_END <= 1024 * MiB, "activation map");
constexpr int CW_TMO = 0, CW_CODE = 1, CW_WMAX = 64, CW_BAR = 4096, CW_CMAX = 16384  ;
constexpr int RING_OFF = 0, RING_BYTES = 131072;
constexpr int LDSCTL_OFF = 147456 - 512, MISC_OFF = LDSCTL_OFF + 320;
constexpr int LDS_BYTES = 147456;
#define GAS __attribute__((address_space(1)))
#define LAS __attribute__((address_space(3)))
typedef unsigned short bf16;
typedef unsigned v4u __attribute__((ext_vector_type(4)));
typedef float f32x4 __attribute__((ext_vector_type(4)));
typedef short bf16x8 __attribute__((ext_vector_type(8)));
typedef GAS unsigned gu32;
typedef GAS unsigned long long gu64;
#define RLX_AGENT __ATOMIC_RELAXED, __HIP_MEMORY_SCOPE_AGENT
#define LDS_WAIT() asm volatile("s_waitcnt lgkmcnt(0)" ::: "memory")
#define VM_WAIT() asm volatile("s_waitcnt vmcnt(0)" ::: "memory")
__device__ __forceinline__ unsigned long long rt() { return __builtin_amdgcn_s_memrealtime(); }
__device__ __forceinline__ unsigned f2bf(float f) { unsigned u = __builtin_bit_cast(unsigned, f); return (u + 0x7fffu + ((u >> 16) & 1u)) >> 16; }
__device__ __forceinline__ unsigned pk2(float lo, float hi) { return f2bf(lo) | (f2bf(hi) << 16); }

#define XB_TMO      128
#define XB_XCNT(j)  (256  + 64 * (j))
#define XB_XSUB(j)  (1280 + 64 * (j))
#define XB_XGEN(j)  (2304 + 64 * (j))
#define XB_TOP      3328
#define XB_TOPGEN   3392
#define XCD_BAR_WORDS 3456
#define XB_SPIN_CAP (1u << 18)

__device__ __forceinline__ unsigned xb_ld(unsigned* p)              { return __hip_atomic_load(p, __ATOMIC_RELAXED, __HIP_MEMORY_SCOPE_AGENT); }
__device__ __forceinline__ unsigned xb_add(unsigned* p, unsigned v) { return __hip_atomic_fetch_add(p, v, __ATOMIC_RELAXED, __HIP_MEMORY_SCOPE_AGENT); }
__device__ __forceinline__ unsigned xb_xcc_id() { return (unsigned)__builtin_amdgcn_s_getreg((3 << 11) | 20) & 0xFu; }
#define XB_SPIN(cond, bar) do { unsigned _sp = 0; while (cond) { __builtin_amdgcn_s_sleep(1); \
    if ((++_sp & 255u) == 0u) { if (xb_ld(&(bar)[XB_TMO])) break; if (_sp > XB_SPIN_CAP) { atomicAdd(&(bar)[XB_TMO], 1u); break; } } } } while (0)

struct XcdBarrier {
    unsigned* bar; unsigned x;
    volatile LAS unsigned* st;
};

__device__ __forceinline__ XcdBarrier xcd_barrier_post(unsigned* bar, volatile LAS unsigned* st) {
    XcdBarrier b; b.bar = bar; b.x = xb_xcc_id(); b.st = st;
    if (threadIdx.x == 0) (void)xb_add(&bar[XB_XCNT(b.x)], 1u);
    return b;
}
__device__ __forceinline__ void xcd_barrier_complete(unsigned* bar, unsigned x, unsigned& nloc, unsigned& nx) {
    const unsigned G = gridDim.x * gridDim.y * gridDim.z;
    unsigned sum, cnt, mine, sp = 0u;
    for (;;) {
        sum = 0u; cnt = 0u; mine = 0u;
#pragma unroll
        for (unsigned j = 0; j < 16; ++j) { const unsigned c = xb_ld(&bar[XB_XCNT(j)]); sum += c; cnt += (c > 0u) ? 1u : 0u; mine = (j == x) ? c : mine; }
        if (sum == G) break;
        __builtin_amdgcn_s_sleep(1);
        if ((++sp & 255u) == 0u) { if (xb_ld(&bar[XB_TMO])) break; if (sp > XB_SPIN_CAP) { atomicAdd(&bar[XB_TMO], 1u); break; } }
    }
    nloc = mine > 0u ? mine : 1u; nx = cnt > 0u ? cnt : 1u;
}

__device__ __forceinline__ void xcd_barrier(const XcdBarrier& b) {
    asm volatile("s_waitcnt vmcnt(0)" ::: "memory");
    __syncthreads();
    if (threadIdx.x == 0) {
        unsigned* bar = b.bar;
        __builtin_amdgcn_s_waitcnt(0);
        unsigned nloc = b.st[0], nx = b.st[1];
        if (nloc == 0u) { xcd_barrier_complete(bar, b.x, nloc, nx); b.st[0] = nloc; b.st[1] = nx; }
        const unsigned old = xb_add(&bar[XB_XSUB(b.x)], 1u);
        const unsigned gen = old / nloc;
        if (old + 1u == (gen + 1u) * nloc) {
            __builtin_amdgcn_fence(__ATOMIC_RELEASE, "agent");
            asm volatile("s_waitcnt vmcnt(0)" ::: "memory");
            const unsigned og = xb_add(&bar[XB_TOP], 1u);
            const unsigned tg = og / nx;
            if (og + 1u == (tg + 1u) * nx) xb_add(&bar[XB_TOPGEN], 1u);
            else XB_SPIN(xb_ld(&bar[XB_TOPGEN]) == tg, bar);
            __builtin_amdgcn_fence(__ATOMIC_ACQUIRE, "agent");
            xb_add(&bar[XB_XGEN(b.x)], 1u);
            asm volatile("s_waitcnt vmcnt(0)" ::: "memory");
        } else {
            XB_SPIN(xb_ld(&bar[XB_XGEN(b.x)]) == gen, bar);
            __builtin_amdgcn_fence(__ATOMIC_ACQUIRE, "agent");
            asm volatile("s_waitcnt vmcnt(0)" ::: "memory");
        }
    }
    __syncthreads();
}
static_assert((CW_BAR + 2 * XCD_BAR_WORDS) * 4 <= (int)CTL_ZERO_BYTES, "CTL words inside the memset region");
typedef unsigned long long u64;
__device__ __forceinline__ float wave_sum(float v) {
#pragma unroll
    for (int o = 1; o < 64; o <<= 1) v += __shfl_xor(v, o);
    return v;
}
__device__ __forceinline__ float silu_g(float x) { return x * __builtin_amdgcn_rcpf(1.f + __expf(-x)); }
__device__ __forceinline__ float sigm_g(float x) { return __builtin_amdgcn_rcpf(1.f + __expf(-x)); }
__device__ __forceinline__ float bf2f(bf16 v) { return __uint_as_float((unsigned)v << 16); }
__device__ __forceinline__ void ld8f(const bf16* p, float* f) {
    const v4u v = *(const v4u*)p;
    f[0] = __uint_as_float(v.x << 16); f[1] = __uint_as_float(v.x & 0xffff0000u); f[2] = __uint_as_float(v.y << 16); f[3] = __uint_as_float(v.y & 0xffff0000u);
    f[4] = __uint_as_float(v.z << 16); f[5] = __uint_as_float(v.z & 0xffff0000u); f[6] = __uint_as_float(v.w << 16); f[7] = __uint_as_float(v.w & 0xffff0000u);
}
__device__ __forceinline__ void st8f(bf16* p, const float* f) { v4u o; o.x = pk2(f[0], f[1]); o.y = pk2(f[2], f[3]); o.z = pk2(f[4], f[5]); o.w = pk2(f[6], f[7]); *(v4u*)p = o; }

__device__ __forceinline__ int map_gu(int n) { const int p = n >> 8, r = n & 255; return r < 128 ? 128 * p + r : FF + 128 * p + (r - 128); }
__device__ __forceinline__ int map_cdin(int n) {
    if (n < 2560) return n; if (n < 3584) return 2576 + (n - 2560); if (n < 4608) return 3600 + (n - 3584); if (n < 5632) return 4624 + (n - 4608);
    const int j = n - 5632; if (j < 16) return 2560 + j; if (j < 24) return 5648 + (j - 16); return -1;
}
template <int MAP> __device__ __forceinline__ void tr_item(const float* W, int K, int Nsrc, bf16* WT, int nblk, LAS float* scr, int item, int lane, const float* nw = nullptr) {
    const int kb = item / nblk, nb = item % nblk, k0 = 64 * kb, n0 = 32 * nb;
    const int nd = n0 + (lane & 31); const int sc = (MAP == 0) ? nd : (MAP == 1) ? map_gu(nd) : map_cdin(nd);
#pragma unroll 8
    for (int i = 0; i < 32; ++i) { const int kk = 2 * i + (lane >> 5); scr[kk * 33 + (lane & 31)] = (sc >= 0) ? W[(size_t)(k0 + kk) * Nsrc + sc] * (nw ? nw[k0 + kk] : 1.f) : 0.f; }
    LDS_WAIT(); asm volatile("" ::: "memory");
    const int c = lane & 7;
#pragma unroll
    for (int j = 0; j < 4; ++j) { const int n = (lane >> 3) + 8 * j; const LAS float* s = scr + (8 * c) * 33 + n;
        v4u o; o.x = pk2(s[0 * 33], s[1 * 33]); o.y = pk2(s[2 * 33], s[3 * 33]); o.z = pk2(s[4 * 33], s[5 * 33]); o.w = pk2(s[6 * 33], s[7 * 33]);
        *(GAS v4u*)(WT + (size_t)(n0 + n) * K + k0 + 8 * c) = o; }
    LDS_WAIT(); asm volatile("" ::: "memory");
}
__device__ __forceinline__ void tr_item8(const float* W, int K, int Nsrc, unsigned char* WT, int nblk, LAS float* scr, int item, int lane, float sc) {
    const int kb = item / nblk, nb = item % nblk, k0 = 64 * kb, n0 = 32 * nb; const int nd = n0 + (lane & 31);
#pragma unroll 8
    for (int i = 0; i < 32; ++i) { const int kk = 2 * i + (lane >> 5); scr[kk * 33 + (lane & 31)] = W[(size_t)(k0 + kk) * Nsrc + nd] * sc; }
    LDS_WAIT(); asm volatile("" ::: "memory");
    const int c = lane & 7;
#pragma unroll
    for (int j = 0; j < 4; ++j) { const int n = (lane >> 3) + 8 * j; const LAS float* s = scr + (8 * c) * 33 + n;
        const u64 o = (u64)pg8::pk4_fp8(s[0 * 33], s[1 * 33], s[2 * 33], s[3 * 33]) | ((u64)pg8::pk4_fp8(s[4 * 33], s[5 * 33], s[6 * 33], s[7 * 33]) << 32);
        *(GAS u64*)(WT + (size_t)(n0 + n) * K + k0 + 8 * c) = o; }
    LDS_WAIT(); asm volatile("" ::: "memory");
}
__device__ __forceinline__ unsigned pk4_i8(float a, float b, float c, float d) {
    const int x = __float2int_rn(a), y = __float2int_rn(b), z = __float2int_rn(c), w = __float2int_rn(d);
    return (unsigned)(x & 255) | ((unsigned)(y & 255) << 8) | ((unsigned)(z & 255) << 16) | ((unsigned)w << 24);
}
template <int MAP> __device__ __forceinline__ void tr_item_i8(const float* W, int K, int Nsrc, unsigned char* WT, int nblk, LAS float* scr, int item, int lane, const unsigned* cmax, float* wdq) {
    const int kb = item / nblk, nb = item % nblk, k0 = 64 * kb, n0 = 32 * nb; const int nd = n0 + (lane & 31); const int scn = (MAP == 0) ? nd : (MAP == 1) ? map_gu(nd) : map_cdin(nd);
    const float cm = fmaxf(__uint_as_float(cmax[scn >= 0 ? scn : 0]), 1e-30f), sc = 127.f / cm;
    if (kb == 0 && lane < 32) wdq[nd] = (scn >= 0) ? cm * (1.f / 127.f) : 0.f;
#pragma unroll 8
    for (int i = 0; i < 32; ++i) { const int kk = 2 * i + (lane >> 5); scr[kk * 33 + (lane & 31)] = (scn >= 0) ? W[(size_t)(k0 + kk) * Nsrc + scn] * sc : 0.f; }
    LDS_WAIT(); asm volatile("" ::: "memory");
    const int c = lane & 7;
#pragma unroll
    for (int j = 0; j < 4; ++j) { const int n = (lane >> 3) + 8 * j; const LAS float* s = scr + (8 * c) * 33 + n;
        const u64 o = (u64)pk4_i8(s[0 * 33], s[1 * 33], s[2 * 33], s[3 * 33]) | ((u64)pk4_i8(s[4 * 33], s[5 * 33], s[6 * 33], s[7 * 33]) << 32);
        *(GAS u64*)(WT + (size_t)(n0 + n) * K + k0 + 8 * c) = o; }
    LDS_WAIT(); asm volatile("" ::: "memory");
}
__device__ __forceinline__ void wht16(float* v) {
#pragma unroll
    for (int h = 1; h < 16; h <<= 1)
#pragma unroll
        for (int i = 0; i < 16; ++i) if ((i & h) == 0) { const float a = v[i], b = v[i + h]; v[i] = a + b; v[i + h] = a - b; }
}
__device__ __forceinline__ void tr_item_i8rot(const float* W, int K, int Nsrc, unsigned char* WT, int nblk, LAS float* scr, int item, int lane, const unsigned* cmax, float* wdq) {
    const int kb = item / nblk, nb = item % nblk, k0 = 64 * kb, n0 = 32 * nb; const int nd = n0 + (lane & 31);
    const float cm = fmaxf(__uint_as_float(cmax[nd]), 1e-30f), sc = 0.25f * 127.f / cm;
    if (kb == 0 && lane < 32) wdq[nd] = cm * (1.f / 127.f);
#pragma unroll 8
    for (int i = 0; i < 32; ++i) { const int kk = 2 * i + (lane >> 5); scr[kk * 33 + (lane & 31)] = W[(size_t)(k0 + kk) * Nsrc + nd]; }
    LDS_WAIT(); asm volatile("" ::: "memory");
#pragma unroll 1
    for (int g2 = 0; g2 < 2; ++g2) { const int grp = (lane >> 5) + 2 * g2; LAS float* s = scr + (16 * grp) * 33 + (lane & 31); float v[16];
#pragma unroll
        for (int j = 0; j < 16; ++j) v[j] = s[j * 33];
        wht16(v);
#pragma unroll
        for (int j = 0; j < 16; ++j) s[j * 33] = v[j] * sc; }
    LDS_WAIT(); asm volatile("" ::: "memory");
    const int c = lane & 7;
#pragma unroll
    for (int j = 0; j < 4; ++j) { const int n = (lane >> 3) + 8 * j; const LAS float* s = scr + (8 * c) * 33 + n;
        const u64 o = (u64)pk4_i8(s[0 * 33], s[1 * 33], s[2 * 33], s[3 * 33]) | ((u64)pk4_i8(s[4 * 33], s[5 * 33], s[6 * 33], s[7 * 33]) << 32);
        *(GAS u64*)(WT + (size_t)(n0 + n) * K + k0 + 8 * c) = o; }
    LDS_WAIT(); asm volatile("" ::: "memory");
}
__device__ __forceinline__ void act_row_rot_i8(const bf16* arow, unsigned char* orow, float* dq, int lane) {
    float v[3][16]; float am = 0.f;
#pragma unroll
    for (int i = 0; i < 3; ++i) { const int blk = lane + 64 * i;
        if (blk < FF / 16) { ld8f(arow + blk * 16, v[i]); ld8f(arow + blk * 16 + 8, v[i] + 8); wht16(v[i]);
#pragma unroll
            for (int e = 0; e < 16; ++e) { v[i][e] *= 0.25f; am = fmaxf(am, fabsf(v[i][e])); } } }
#pragma unroll
    for (int o = 1; o < 64; o <<= 1) am = fmaxf(am, __shfl_xor(am, o));
    am = fmaxf(am, 1e-20f); const float sc = 127.f / am;
#pragma unroll
    for (int i = 0; i < 3; ++i) { const int blk = lane + 64 * i;
        if (blk < FF / 16) { v4u q; q.x = pk4_i8(v[i][0] * sc, v[i][1] * sc, v[i][2] * sc, v[i][3] * sc); q.y = pk4_i8(v[i][4] * sc, v[i][5] * sc, v[i][6] * sc, v[i][7] * sc);
            q.z = pk4_i8(v[i][8] * sc, v[i][9] * sc, v[i][10] * sc, v[i][11] * sc); q.w = pk4_i8(v[i][12] * sc, v[i][13] * sc, v[i][14] * sc, v[i][15] * sc);
            *(v4u*)(orow + blk * 16) = q; } }
    if (lane == 0) dq[0] = am * (1.f / 127.f);
}
__device__ __forceinline__ void rms_row_i8(const bf16* hrow, const float* w, unsigned char* orow, float* dq, int lane) {
    float h[16]; ld8f(hrow + lane * 16, h); ld8f(hrow + lane * 16 + 8, h + 8);
    float s = 0.f;
#pragma unroll
    for (int e = 0; e < 16; ++e) s += h[e] * h[e];
    const float rstd = 1.f / sqrtf(wave_sum(s) * (1.f / D) + RMS_EPS);
    float am = 0.f;
#pragma unroll
    for (int j = 0; j < 4; ++j) { const f32x4 g = *(const f32x4*)(w + lane * 16 + 4 * j); h[4 * j] *= rstd * g.x; h[4 * j + 1] *= rstd * g.y; h[4 * j + 2] *= rstd * g.z; h[4 * j + 3] *= rstd * g.w;
        am = fmaxf(fmaxf(am, fmaxf(fabsf(h[4 * j]), fabsf(h[4 * j + 1]))), fmaxf(fabsf(h[4 * j + 2]), fabsf(h[4 * j + 3]))); }
#pragma unroll
    for (int o = 1; o < 64; o <<= 1) am = fmaxf(am, __shfl_xor(am, o));
    am = fmaxf(am, 1e-20f); const float sc = 127.f / am;
    v4u q; q.x = pk4_i8(h[0] * sc, h[1] * sc, h[2] * sc, h[3] * sc); q.y = pk4_i8(h[4] * sc, h[5] * sc, h[6] * sc, h[7] * sc); q.z = pk4_i8(h[8] * sc, h[9] * sc, h[10] * sc, h[11] * sc); q.w = pk4_i8(h[12] * sc, h[13] * sc, h[14] * sc, h[15] * sc);
    *(v4u*)(orow + lane * 16) = q;
    if (lane == 0) dq[0] = am * (1.f / 127.f);
}
__device__ __forceinline__ void rms_row_i8_clip(const bf16* hrow, const float* w, unsigned char* orow, float* dq, float* dq2, float wmsq, int lane) {
    float h[16]; ld8f(hrow + lane * 16, h); ld8f(hrow + lane * 16 + 8, h + 8);
    float s = 0.f;
#pragma unroll
    for (int e = 0; e < 16; ++e) s += h[e] * h[e];
    const float rstd = 1.f / sqrtf(wave_sum(s) * (1.f / D) + RMS_EPS);
    float am = 0.f, n2 = 0.f;
#pragma unroll
    for (int j = 0; j < 4; ++j) { const f32x4 g = *(const f32x4*)(w + lane * 16 + 4 * j); h[4 * j] *= rstd * g.x; h[4 * j + 1] *= rstd * g.y; h[4 * j + 2] *= rstd * g.z; h[4 * j + 3] *= rstd * g.w;
        n2 += (h[4 * j] * h[4 * j] + h[4 * j + 1] * h[4 * j + 1]) + (h[4 * j + 2] * h[4 * j + 2] + h[4 * j + 3] * h[4 * j + 3]);
        am = fmaxf(fmaxf(am, fmaxf(fabsf(h[4 * j]), fabsf(h[4 * j + 1]))), fmaxf(fabsf(h[4 * j + 2]), fabsf(h[4 * j + 3]))); }
#pragma unroll
    for (int o = 1; o < 64; o <<= 1) am = fmaxf(am, __shfl_xor(am, o));
    n2 = wave_sum(n2);
    am = fmaxf(am, 1e-20f); const float sc = 127.f / am;
    v4u q; q.x = pk4_i8(h[0] * sc, h[1] * sc, h[2] * sc, h[3] * sc); q.y = pk4_i8(h[4] * sc, h[5] * sc, h[6] * sc, h[7] * sc); q.z = pk4_i8(h[8] * sc, h[9] * sc, h[10] * sc, h[11] * sc); q.w = pk4_i8(h[12] * sc, h[13] * sc, h[14] * sc, h[15] * sc);
    *(v4u*)(orow + lane * 16) = q;
    if (lane == 0) { const float clip = fmaxf(3.5f * n2 * wmsq, 1e-20f); dq[0] = am * (1.f / 127.f); dq[1] = 127.f / clip; dq2[0] = clip * (1.f / 127.f); }
}
__device__ __forceinline__ void rms_row_to_bf16(const float* xrow, const float* w, bf16* orow, int lane) {
    const f32x4* xr = (const f32x4*)xrow + lane; const f32x4* wr = (const f32x4*)w + lane;
    f32x4 v[4]; float s = 0.f;
#pragma unroll
    for (int j = 0; j < 4; ++j) { v[j] = xr[64 * j]; s += (v[j].x * v[j].x + v[j].y * v[j].y) + (v[j].z * v[j].z + v[j].w * v[j].w); }
    const float rstd = 1.f / sqrtf(wave_sum(s) * (1.f / D) + RMS_EPS);
    u64* o8 = (u64*)orow + lane;
#pragma unroll
    for (int j = 0; j < 4; ++j) { const f32x4 g = wr[64 * j]; o8[64 * j] = (u64)pk2(v[j].x * rstd * g.x, v[j].y * rstd * g.y) | ((u64)pk2(v[j].z * rstd * g.z, v[j].w * rstd * g.w) << 32); }
}
__device__ __forceinline__ void rms_row_bf16(const bf16* hrow, const float* w, bf16* orow, int lane) {
    float h[16]; ld8f(hrow + lane * 16, h); ld8f(hrow + lane * 16 + 8, h + 8);
    float s = 0.f;
#pragma unroll
    for (int e = 0; e < 16; ++e) s += h[e] * h[e];
    const float rstd = 1.f / sqrtf(wave_sum(s) * (1.f / D) + RMS_EPS);
#pragma unroll
    for (int j = 0; j < 4; ++j) { const f32x4 g = *(const f32x4*)(w + lane * 16 + 4 * j); h[4 * j] *= rstd * g.x; h[4 * j + 1] *= rstd * g.y; h[4 * j + 2] *= rstd * g.z; h[4 * j + 3] *= rstd * g.w; }
    st8f(orow + lane * 16, h); st8f(orow + lane * 16 + 8, h + 8);
}
__device__ __forceinline__ void final_row(const bf16* hrow, const float* w, float* orow, int lane) {
    float h[16]; ld8f(hrow + lane * 16, h); ld8f(hrow + lane * 16 + 8, h + 8);
    float s = 0.f;
#pragma unroll
    for (int e = 0; e < 16; ++e) s += h[e] * h[e];
    const float rstd = 1.f / sqrtf(wave_sum(s) * (1.f / D) + RMS_EPS);
#pragma unroll
    for (int j = 0; j < 4; ++j) { const f32x4 g = *(const f32x4*)(w + lane * 16 + 4 * j); *(f32x4*)(orow + lane * 16 + 4 * j) = (f32x4){h[4 * j] * rstd * g.x, h[4 * j + 1] * rstd * g.y, h[4 * j + 2] * rstd * g.z, h[4 * j + 3] * rstd * g.w}; }
}
__device__ __forceinline__ void rms_row_inplace_f32(float* xrow, const float* w, int lane) {
    f32x4* xr = (f32x4*)xrow + lane; const f32x4* wr = (const f32x4*)w + lane;
    f32x4 v[4]; float s = 0.f;
#pragma unroll
    for (int j = 0; j < 4; ++j) { v[j] = xr[64 * j]; s += (v[j].x * v[j].x + v[j].y * v[j].y) + (v[j].z * v[j].z + v[j].w * v[j].w); }
    const float rstd = 1.f / sqrtf(wave_sum(s) * (1.f / D) + RMS_EPS);
#pragma unroll
    for (int j = 0; j < 4; ++j) { const f32x4 g = wr[64 * j]; xr[64 * j] = v[j] * rstd * g; }
}

__device__ __forceinline__ void attnA_naive_item(const bf16* QKV, bf16* Y, int b, int h, int tb, int lane) {
    const int t = tb * 64 + lane; const size_t row = (size_t)b * T + t;
    float q[64], o[64];
#pragma unroll
    for (int c = 0; c < 8; ++c) ld8f(QKV + row * NQKV + h * 64 + 8 * c, q + 8 * c);
#pragma unroll
    for (int e = 0; e < 64; ++e) { q[e] *= 0.125f; o[e] = 0.f; }
    float m = -1e30f, l = 0.f;
#define A_KEY(tk, cw) do { const bf16* kr = QKV + ((size_t)b * T + (tk)) * NQKV + 512 + h * 64; float s = 0.f; \
    _Pragma("unroll") for (int c = 0; c < 8; ++c) { float kf[8]; ld8f(kr + 8 * c, kf); _Pragma("unroll") for (int e = 0; e < 8; ++e) s += q[8 * c + e] * kf[e]; } \
    const float mn = fmaxf(m, s); const float sc = __expf(m - mn); const float p = (cw) * __expf(s - mn); l = l * sc + p; m = mn; \
    const bf16* vr = kr + 512; \
    _Pragma("unroll") for (int c = 0; c < 8; ++c) { float vf[8]; ld8f(vr + 8 * c, vf); _Pragma("unroll") for (int e = 0; e < 8; ++e) o[8 * c + e] = o[8 * c + e] * sc + p * vf[e]; } } while (0)
    for (int d = 0; d <= 128 && d <= t; ++d) { const float cw = 1.f + ((d & 3) == 0 ? 1.f : 0.f) + ((d & 15) == 0 ? 1.f : 0.f); A_KEY(t - d, cw); }
    for (int d = 132; d <= 512 && d <= t; d += 4) { const float cw = 1.f + ((d & 15) == 0 ? 1.f : 0.f); A_KEY(t - d, cw); }
    for (int d = 528; d <= t; d += 16) { A_KEY(t - d, 1.f); }
#undef A_KEY
    const float il = 1.f / l;
#pragma unroll
    for (int e = 0; e < 64; ++e) o[e] *= il;
#pragma unroll
    for (int c = 0; c < 8; ++c) st8f(Y + row * D + h * 64 + 8 * c, o + 8 * c);
}
__device__ __forceinline__ void attnB_naive_item(const bf16* QKV, bf16* OB, int b, int hv, int tb, int lane, float qscale) {
    const int h = hv >> 2, c2 = (hv >> 1) & 1, vh = hv & 1;
    const bf16* Qp = QKV + 1536 + h * 128 + c2 * 64; const bf16* Kp = QKV + 2048 + h * 128 + c2 * 64; const bf16* Vp = QKV + 2560 + h * 128 + vh * 64;
    const int t = tb * 64 + lane; const size_t row = (size_t)b * T + t;
    float q[64], o[64];
#pragma unroll
    for (int c = 0; c < 8; ++c) ld8f(Qp + row * NQKV + 8 * c, q + 8 * c);
#pragma unroll
    for (int e = 0; e < 64; ++e) { q[e] *= qscale; o[e] = 0.f; }
    float m = -1e30f, l = 0.f;
    const int nk = tb * 64 + 64;
    for (int kk = 0; kk < nk; ++kk) {
        const bf16* kr = Kp + ((size_t)b * T + kk) * NQKV; float s = 0.f;
#pragma unroll
        for (int c = 0; c < 8; ++c) { float kf[8]; ld8f(kr + 8 * c, kf);
#pragma unroll
            for (int e = 0; e < 8; ++e) s += q[8 * c + e] * kf[e]; }
        const bool valid = kk <= t; const float sv = valid ? s : -1e30f;
        const float mn = fmaxf(m, sv); const float sc = __expf(m - mn); const float p = valid ? __expf(sv - mn) : 0.f; l = l * sc + p; m = mn;
        const bf16* vr = Vp + ((size_t)b * T + kk) * NQKV;
#pragma unroll
        for (int c = 0; c < 8; ++c) { float vf[8]; ld8f(vr + 8 * c, vf);
#pragma unroll
            for (int e = 0; e < 8; ++e) o[8 * c + e] = o[8 * c + e] * sc + p * vf[e]; }
    }
    const float il = 1.f / l;
#pragma unroll
    for (int e = 0; e < 64; ++e) o[e] *= il;
#pragma unroll
    for (int c = 0; c < 8; ++c) st8f(OB + row * D + hv * 64 + 8 * c, o + 8 * c);
}
__device__ __forceinline__ void attnB_post_row(const bf16* OB, bf16* Y, const float* subw, float lam, float outscale, size_t row, int lane) {
    const int h = lane >> 4, sub = lane & 15, vh = sub >> 3, d0 = (sub & 7) * 8;
    float a[8], b[8], r[8];
    ld8f(OB + row * D + ((h * 2 + 0) * 2 + vh) * 64 + d0, a); ld8f(OB + row * D + ((h * 2 + 1) * 2 + vh) * 64 + d0, b);
    float ss = 0.f;
#pragma unroll
    for (int e = 0; e < 8; ++e) { r[e] = a[e] - lam * b[e]; ss += r[e] * r[e]; }
    ss += __shfl_xor(ss, 1); ss += __shfl_xor(ss, 2); ss += __shfl_xor(ss, 4); ss += __shfl_xor(ss, 8);
    const float rstd = 1.f / sqrtf(ss * (1.f / 128.f) + RMS_EPS);
    const int dv = vh * 64 + d0;
#pragma unroll
    for (int e = 0; e < 8; ++e) r[e] = r[e] * rstd * subw[dv + e] * outscale;
    st8f(Y + row * D + 512 + h * 128 + dv, r);
}
template <int MODE> __device__ __forceinline__ void conv_unit(bf16* X, int pitch, int c0, const float* cw, int cwp, const float* cb, int b, int tid, const float* wq, const float* wk, bf16* KB) {
    const int oct = tid & 15, seg = tid >> 4, ch = c0 + 8 * oct;
    float w0[8], w1[8], w2[8], w3[8], bs[8], h0[8], h1[8], h2[8];
#pragma unroll
    for (int e = 0; e < 8; ++e) { w0[e] = cw[ch + e]; w1[e] = cw[cwp + ch + e]; w2[e] = cw[2 * cwp + ch + e]; w3[e] = cw[3 * cwp + ch + e]; bs[e] = cb[ch + e]; }
    bf16* base = X + ((size_t)b * T + seg * 64) * pitch + ch;
    if (seg == 0) {
#pragma unroll
        for (int e = 0; e < 8; ++e) { h0[e] = 0.f; h1[e] = 0.f; h2[e] = 0.f; }
    } else { ld8f(base - 3 * (size_t)pitch, h0); ld8f(base - 2 * (size_t)pitch, h1); ld8f(base - (size_t)pitch, h2); }
    float wqv[2][4][4], wkv[2][4][4];
    if (MODE == 1) {
#pragma unroll
        for (int a = 0; a < 2; ++a)
#pragma unroll
            for (int j = 0; j < 4; ++j)
#pragma unroll
                for (int i = 0; i < 4; ++i) { const int nb = (ch >> 2) + a; wqv[a][j][i] = wq[(nb * 4 + j) * 4 + i]; wkv[a][j][i] = wk[(nb * 4 + j) * 4 + i] * 0.0625f; }
    }
    __syncthreads();
#pragma unroll 4
    for (int s = 0; s < 64; ++s) {
        float raw[8], o[8];
        ld8f(base + (size_t)s * pitch, raw);
#pragma unroll
        for (int e = 0; e < 8; ++e) { const float v = w0[e] * h0[e] + w1[e] * h1[e] + w2[e] * h2[e] + w3[e] * raw[e] + bs[e]; o[e] = silu_g(v); h0[e] = h1[e]; h1[e] = h2[e]; h2[e] = raw[e]; }
        if (MODE == 0) st8f(base + (size_t)s * pitch, o);
        else {
            float q[8], k[8];
#pragma unroll
            for (int a = 0; a < 2; ++a)
#pragma unroll
                for (int i = 0; i < 4; ++i) { float qa = 0.f, ka = 0.f;
#pragma unroll
                    for (int j = 0; j < 4; ++j) { qa += o[4 * a + j] * wqv[a][j][i]; ka += o[4 * a + j] * wkv[a][j][i]; }
                    q[4 * a + i] = qa; k[4 * a + i] = ka; }
            st8f(base + (size_t)s * pitch, q); st8f(KB + ((size_t)b * T + seg * 64 + s) * D + ch, k);
        }
    }
    __syncthreads();
}
namespace mam {
using bf16x8 = __attribute__((ext_vector_type(8))) short;
using s16x4 = __attribute__((ext_vector_type(4))) short;
using f32x16 = __attribute__((ext_vector_type(16))) float;
using f32x4 = __attribute__((ext_vector_type(4))) float;
using u32x4 = __attribute__((ext_vector_type(4))) unsigned;
using u32x2 = __attribute__((ext_vector_type(2))) unsigned;
typedef short v4i16_t __attribute__((ext_vector_type(4)));
#define MM_LAS __attribute__((address_space(3)))
typedef unsigned short bf16;
constexpr int PXBC = 1536, TT = 2048;
constexpr int PB = 272, PX = 144, PS = 272;
constexpr int LB = 0, LC = LB + 128 * PB, LX = LC + 128 * PB, LS = LX + 2 * 128 * PX, LV = LS + 2 * 64 * PS, VSZ = 5 * 512;
constexpr int LDS_NEED = LV + 2 * VSZ;
__device__ __forceinline__ int crow(int r, int hi) { return (r & 3) + 8 * (r >> 2) + 4 * hi; }
__device__ __forceinline__ unsigned cvtpk(float lo, float hi) { typedef float f2 __attribute__((ext_vector_type(2))); typedef __bf16 b2 __attribute__((ext_vector_type(2))); f2 v = {lo, hi}; b2 b = __builtin_convertvector(v, b2); return __builtin_bit_cast(unsigned, b); }
__device__ __forceinline__ bf16x8 trfrag(const MM_LAS unsigned char* p, int rowpitch8) {
    const s16x4 lo = __builtin_bit_cast(s16x4, __builtin_amdgcn_ds_read_tr16_b64_v4i16((MM_LAS v4i16_t*)p));
    const s16x4 hi = __builtin_bit_cast(s16x4, __builtin_amdgcn_ds_read_tr16_b64_v4i16((MM_LAS v4i16_t*)(p + rowpitch8)));
    return (bf16x8){lo[0], lo[1], lo[2], lo[3], hi[0], hi[1], hi[2], hi[3]};
}
__device__ __forceinline__ void unit(bf16* XBC, const float* GT, const float* dtb, const float* alog, const float* dsk, int b, int g, int hp, MM_LAS unsigned char* L, int tid) {
    const int lane = tid & 63, r32 = lane & 31, hi = lane >> 5; const int w = __builtin_amdgcn_readfirstlane(tid >> 6);
    const int hh = w >> 2, it = hh ? 3 - (w & 3) : (w & 3), head = g * 8 + 2 * hp + hh;
    const float a_neg = -expf(alog[head]), dskh = dsk[head];
    const int q4 = (lane & 15) >> 2, p4 = lane & 3, blk = (lane >> 4) & 1;
    MM_LAS float* V = (MM_LAS float*)(L + LV + hh * VSZ);
    f32x16 st[2]; st[0] = f32x16{}; st[1] = f32x16{};
    for (int i = tid; i < 2 * 64 * PS / 4; i += 512) ((MM_LAS unsigned*)(L + LS))[i] = 0u;
    const unsigned sgo = (unsigned)(tid >> 4) * (PXBC * 2) + (unsigned)(tid & 15) * 16;
    const unsigned slo = (unsigned)(tid >> 4) * PB + (unsigned)(tid & 15) * 16;
    const unsigned sxo = (unsigned)((tid & 15) >> 3) * 128 * PX + (unsigned)(tid >> 4) * PX + (unsigned)(tid & 7) * 16;
    u32x4 tb[4], tc[4], tx[4];
    { const unsigned char* g0 = (const unsigned char*)(XBC + (size_t)b * TT * PXBC);
#pragma unroll
      for (int q = 0; q < 4; ++q) { tb[q] = *(const u32x4*)(g0 + (size_t)q * (32 * PXBC * 2) + (1024 + g * 128) * 2 + sgo); tc[q] = *(const u32x4*)(g0 + (size_t)q * (32 * PXBC * 2) + (1280 + g * 128) * 2 + sgo);
          tx[q] = *(const u32x4*)(g0 + (size_t)q * (32 * PXBC * 2) + ((g * 8 + 2 * hp) * 64) * 2 + sgo); } }
    for (int c = 0; c < 16; ++c) {
        const size_t row0 = (size_t)b * TT + c * 128;
        __syncthreads();
#pragma unroll
        for (int q = 0; q < 4; ++q) { *(MM_LAS u32x4*)(L + LB + q * (32 * PB) + slo) = tb[q]; *(MM_LAS u32x4*)(L + LC + q * (32 * PB) + slo) = tc[q]; *(MM_LAS u32x4*)(L + LX + q * (32 * PX) + sxo) = tx[q]; }
        if ((w & 3) == 0) {
            const float x0 = GT[(row0 + 2 * lane) * 32 + head] + dtb[head], x1 = GT[(row0 + 2 * lane + 1) * 32 + head] + dtb[head];
            const float dt0 = x0 > 20.f ? x0 : log1pf(expf(x0)), dt1 = x1 > 20.f ? x1 : log1pf(expf(x1));
            const float v0 = dt0 * a_neg, v1 = dt1 * a_neg, ps = v0 + v1; float inc = ps;
#pragma unroll
            for (int o = 1; o < 64; o <<= 1) { const float t = __shfl_up(inc, o); if (lane >= o) inc += t; }
            const float ac0 = inc - ps + v0, ac1 = inc, aend = __shfl(inc, 63);
            V[2 * lane] = dt0; V[2 * lane + 1] = dt1; V[128 + 2 * lane] = ac0 * 1.4426950408889634f; V[128 + 2 * lane + 1] = ac1 * 1.4426950408889634f;
            V[256 + 2 * lane] = dt0 * expf(aend - ac0); V[256 + 2 * lane + 1] = dt1 * expf(aend - ac1); V[384 + 2 * lane] = expf(ac0); V[384 + 2 * lane + 1] = expf(ac1);
            if (lane == 0) V[512] = expf(aend);
        }
        __syncthreads();
        if (c < 15) { const unsigned char* g0 = (const unsigned char*)(XBC + (row0 + 128) * PXBC);
#pragma unroll
            for (int q = 0; q < 4; ++q) { tb[q] = *(const u32x4*)(g0 + (size_t)q * (32 * PXBC * 2) + (1024 + g * 128) * 2 + sgo); tc[q] = *(const u32x4*)(g0 + (size_t)q * (32 * PXBC * 2) + (1280 + g * 128) * 2 + sgo);
                tx[q] = *(const u32x4*)(g0 + (size_t)q * (32 * PXBC * 2) + ((g * 8 + 2 * hp) * 64) * 2 + sgo); } }
        const MM_LAS unsigned char* cfp = L + LC + (32 * it + r32) * PB + 8 * hi * 2;
#define MM_CF(kn) (*(const MM_LAS bf16x8*)(cfp + 32 * (kn)))
        f32x16 yd[2]; yd[0] = f32x16{}; yd[1] = f32x16{};
#pragma unroll
        for (int pt = 0; pt < 2; ++pt)
#pragma unroll
            for (int kn = 0; kn < 8; ++kn) { const bf16x8 sf = *(const MM_LAS bf16x8*)(L + LS + hh * 64 * PS + (32 * pt + r32) * PS + (16 * kn + 8 * hi) * 2);
                yd[pt] = __builtin_amdgcn_mfma_f32_32x32x16_bf16(MM_CF(kn), sf, yd[pt], 0, 0, 0); }
#pragma unroll
        for (int jj = 0; jj < 4; ++jj) { const f32x4 ea = *(const MM_LAS f32x4*)(V + 384 + 32 * it + 8 * jj + 4 * hi);
#pragma unroll
            for (int e = 0; e < 4; ++e) { yd[0][4 * jj + e] *= ea[e]; yd[1][4 * jj + e] *= ea[e]; } }
        const float a2l = V[128 + 32 * it + r32];
        const MM_LAS unsigned char* xbase = L + LX + hh * 128 * PX + (4 * hi + q4) * PX + blk * 32 + 8 * p4;
        for (int j = 0; j <= it; ++j) {
            f32x16 X = {};
            unsigned cfo = (unsigned)((32 * it + r32) * PB + 16 * hi); asm volatile("" : "+v"(cfo));
#pragma unroll
            for (int kn = 0; kn < 8; ++kn) { const bf16x8 bfr = *(const MM_LAS bf16x8*)(L + LB + (32 * j + r32) * PB + (16 * kn + 8 * hi) * 2);
                X = __builtin_amdgcn_mfma_f32_32x32x16_bf16(bfr, *(const MM_LAS bf16x8*)(L + LC + cfo + 32 * kn), X, 0, 0, 0); }
#pragma unroll
            for (int jj = 0; jj < 4; ++jj) { const f32x4 a2s = *(const MM_LAS f32x4*)(V + 128 + 32 * j + 8 * jj + 4 * hi), dts = *(const MM_LAS f32x4*)(V + 32 * j + 8 * jj + 4 * hi);
#pragma unroll
                for (int e = 0; e < 4; ++e) { const int r = 4 * jj + e; const bool ok = (j < it) || (8 * jj + 4 * hi + e <= r32);
                    X[r] = ok ? X[r] * __builtin_amdgcn_exp2f(a2l - a2s[e]) * dts[e] : 0.f; } }
            u32x4 p0, p1;
            p0[0] = cvtpk(X[0], X[1]); p0[1] = cvtpk(X[2], X[3]); p0[2] = cvtpk(X[4], X[5]); p0[3] = cvtpk(X[6], X[7]);
            p1[0] = cvtpk(X[8], X[9]); p1[1] = cvtpk(X[10], X[11]); p1[2] = cvtpk(X[12], X[13]); p1[3] = cvtpk(X[14], X[15]);
            const bf16x8 pa0 = __builtin_bit_cast(bf16x8, p0), pa1 = __builtin_bit_cast(bf16x8, p1);
#pragma unroll
            for (int pt = 0; pt < 2; ++pt)
#pragma unroll
                for (int ks = 0; ks < 2; ++ks) { const bf16x8 xf = trfrag(xbase + (32 * j + 16 * ks) * PX + pt * 64, 8 * PX);
                    yd[pt] = __builtin_amdgcn_mfma_f32_32x32x16_bf16(ks == 0 ? pa0 : pa1, xf, yd[pt], 0, 0, 0); }
        }
        { const float eend = V[512];
#pragma unroll
          for (int r = 0; r < 16; ++r) { st[0][r] *= eend; st[1][r] *= eend; } }
        const MM_LAS unsigned char* bbase = L + LB + (4 * hi + q4) * PB + (32 * it + 16 * blk) * 2 + 8 * p4;
#pragma unroll
        for (int ks = 0; ks < 8; ++ks) {
            const bf16x8 bt = trfrag(bbase + 16 * ks * PB, 8 * PB);
            const f32x4 c0 = *(const MM_LAS f32x4*)(V + 256 + 16 * ks + 4 * hi), c1 = *(const MM_LAS f32x4*)(V + 256 + 16 * ks + 8 + 4 * hi);
            float f[8];
#pragma unroll
            for (int e = 0; e < 4; ++e) { f[e] = __uint_as_float((unsigned)(unsigned short)bt[e] << 16) * c0[e]; f[4 + e] = __uint_as_float((unsigned)(unsigned short)bt[4 + e] << 16) * c1[e]; }
            u32x4 pk; pk[0] = cvtpk(f[0], f[1]); pk[1] = cvtpk(f[2], f[3]); pk[2] = cvtpk(f[4], f[5]); pk[3] = cvtpk(f[6], f[7]);
            const bf16x8 af = __builtin_bit_cast(bf16x8, pk);
#pragma unroll
            for (int pt = 0; pt < 2; ++pt) { const bf16x8 xf = trfrag(xbase + 16 * ks * PX + pt * 64, 8 * PX); st[pt] = __builtin_amdgcn_mfma_f32_32x32x16_bf16(af, xf, st[pt], 0, 0, 0); }
        }
#pragma unroll
        for (int r = 0; r < 16; ++r) { const int l = 32 * it + crow(r, hi);
#pragma unroll
            for (int pt = 0; pt < 2; ++pt) { const float xv = __uint_as_float((unsigned)*(const MM_LAS unsigned short*)(L + LX + hh * 128 * PX + l * PX + (32 * pt + r32) * 2) << 16);
                const float y = yd[pt][r] + dskh * xv;
                XBC[(row0 + l) * PXBC + head * 64 + 32 * pt + r32] = (bf16)(cvtpk(y, 0.f) & 0xffffu); } }
        __syncthreads();
#pragma unroll
        for (int pt = 0; pt < 2; ++pt) {
#pragma unroll
            for (int jj = 0; jj < 4; ++jj) { u32x2 o; o[0] = cvtpk(st[pt][4 * jj], st[pt][4 * jj + 1]); o[1] = cvtpk(st[pt][4 * jj + 2], st[pt][4 * jj + 3]);
                *(MM_LAS u32x2*)(L + LS + hh * 64 * PS + (32 * pt + r32) * PS + (32 * it + 8 * jj + 4 * hi) * 2) = o; }
        }
    }
    __syncthreads();
}
#undef MM_CF
#undef MM_LAS
}
namespace mls {
using bf16x8 = __attribute__((ext_vector_type(8))) short;
using s16x4 = __attribute__((ext_vector_type(4))) short;
using f32x16 = __attribute__((ext_vector_type(16))) float;
using f32x4 = __attribute__((ext_vector_type(4))) float;
using u32x4 = __attribute__((ext_vector_type(4))) unsigned;
using u32x2 = __attribute__((ext_vector_type(2))) unsigned;
typedef short v4i16_t __attribute__((ext_vector_type(4)));
#define ML_LAS __attribute__((address_space(3)))
typedef unsigned short bf16;
constexpr int PD = 1024, TT = 2048;
constexpr int PK = 528, PV = 272;
constexpr int LK = 0, LVV = LK + 128 * PK, LG = LVV + 128 * PV, GSZ = 5 * 512, LN = LG + 2 * GSZ, LW = LN + 1024, LDS_NEED = LW + 8 * 256;
constexpr float LOG2E = 1.4426950408889634f;
__device__ __forceinline__ int crow(int r, int hi) { return (r & 3) + 8 * (r >> 2) + 4 * hi; }
__device__ __forceinline__ unsigned cvtpk(float lo, float hi) { typedef float f2 __attribute__((ext_vector_type(2))); typedef __bf16 b2 __attribute__((ext_vector_type(2))); f2 v = {lo, hi}; b2 b = __builtin_convertvector(v, b2); return __builtin_bit_cast(unsigned, b); }
__device__ __forceinline__ float bfx(short v) { return __uint_as_float((unsigned)(unsigned short)v << 16); }
__device__ __forceinline__ bf16x8 trfrag(const ML_LAS unsigned char* p, int rowpitch8) {
    const s16x4 lo = __builtin_bit_cast(s16x4, __builtin_amdgcn_ds_read_tr16_b64_v4i16((ML_LAS v4i16_t*)p));
    const s16x4 hi = __builtin_bit_cast(s16x4, __builtin_amdgcn_ds_read_tr16_b64_v4i16((ML_LAS v4i16_t*)(p + rowpitch8)));
    return (bf16x8){lo[0], lo[1], lo[2], lo[3], hi[0], hi[1], hi[2], hi[3]};
}
__device__ __forceinline__ void gate_vectors(ML_LAS float* gv, const float* GT, size_t row0, int h, float ibh, float fbh, float m_in, int lane) {
    const float* gb = GT + row0 * 32 + h; const unsigned go = (unsigned)lane * 64u;
    const float xi0 = gb[go + 16] + ibh, xi1 = gb[go + 48] + ibh;
    const float xf0 = gb[go + 20] + fbh, xf1 = gb[go + 52] + fbh;
    const float lf0 = xf0 > 0.f ? -log1pf(expf(-xf0)) : xf0 - log1pf(expf(xf0)), lf1 = xf1 > 0.f ? -log1pf(expf(-xf1)) : xf1 - log1pf(expf(xf1));
    const float ps = lf0 + lf1; float inc = ps;
#pragma unroll
    for (int o = 1; o < 64; o <<= 1) { const float t = __shfl_up(inc, o); if (lane >= o) inc += t; }
    const float bc0 = inc - ps + lf0, bc1 = inc, g0 = xi0 - bc0, g1 = xi1 - bc1;
    float pmx = fmaxf(g0, g1);
#pragma unroll
    for (int o = 1; o < 64; o <<= 1) { const float t = __shfl_up(pmx, o); if (lane >= o) pmx = fmaxf(pmx, t); }
    float pex = __shfl_up(pmx, 1); if (lane == 0) pex = -INFINITY;
    const float gtot0 = __shfl(inc, 63), pm127 = __shfl(pmx, 63), mm0 = fmaxf(m_in, pm127);
    gv[2 * lane] = g0 * LOG2E; gv[2 * lane + 1] = g1 * LOG2E; gv[128 + 2 * lane] = fmaxf(pex, g0); gv[128 + 2 * lane + 1] = pmx; gv[256 + 2 * lane] = bc0; gv[256 + 2 * lane + 1] = bc1;
    gv[384 + 2 * lane] = expf(g0 - mm0); gv[384 + 2 * lane + 1] = expf(g1 - mm0);
    if (lane == 0) { gv[512] = gtot0; gv[513] = pm127; }
}
__device__ __forceinline__ void unit(const bf16* Qg, const bf16* Kg, bf16* Vg, bf16* CS, const float* GT, const float* ib, const float* fb, int b, int h, int vh, ML_LAS unsigned char* L, int tid) {
    const int lane = tid & 63, r32 = lane & 31, hi = lane >> 5; const int w = __builtin_amdgcn_readfirstlane(tid >> 6);
    const int q4 = (lane & 15) >> 2, p4 = lane & 3, blk = (lane >> 4) & 1;
    ML_LAS float* NV = (ML_LAS float*)(L + LN); ML_LAS float* WS = (ML_LAS float*)(L + LW + w * 256);
    float m_in = 0.f;
    if (tid < 256) NV[tid] = 0.f;
    if (w < 4) {
        const int lt = w, l = 32 * lt + r32;
        const float ibh = ib[h], fbh = fb[h];
        if (w == 0) gate_vectors((ML_LAS float*)(L + LG), GT, (size_t)b * TT, h, ibh, fbh, 0.f, lane);
        for (int c = 0; c < 16; ++c) {
            const size_t row0 = (size_t)b * TT + c * 128;
            ML_LAS float* G2 = (ML_LAS float*)(L + LG + (c & 1) * GSZ); ML_LAS float* PM = G2 + 128; ML_LAS float* BC = G2 + 256; ML_LAS float* SCL = G2 + 512;
            __syncthreads();
            const bf16* qp = Qg + (row0 + l) * PD + h * 256 + 8 * hi;
            f32x16 num[4]; num[0] = f32x16{}; num[1] = f32x16{}; num[2] = f32x16{}; num[3] = f32x16{};
            float qn = 0.f;
            if (c > 0) {
                const bf16* cp = CS + (size_t)r32 * 256 + 8 * hi;
#pragma unroll 4
                for (int kk = 0; kk < 16; ++kk) {
                    const bf16x8 q8 = *(const bf16x8*)(qp + 16 * kk);
                    const f32x4 n0 = *(const ML_LAS f32x4*)(NV + 16 * kk + 8 * hi), n1 = *(const ML_LAS f32x4*)(NV + 16 * kk + 8 * hi + 4);
#pragma unroll
                    for (int e = 0; e < 4; ++e) { qn += bfx(q8[e]) * n0[e]; qn += bfx(q8[4 + e]) * n1[e]; }
#pragma unroll
                    for (int vt = 0; vt < 4; ++vt) { const bf16x8 cs = *(const bf16x8*)(cp + (size_t)vt * 32 * 256 + 16 * kk); num[vt] = __builtin_amdgcn_mfma_f32_32x32x16_bf16(q8, cs, num[vt], 0, 0, 0); }
                }
                qn += __shfl_xor(qn, 32);
            }
            asm volatile("" ::: "memory");
            bf16x8 qf[16];
#pragma unroll
            for (int kk = 0; kk < 16; ++kk) qf[kk] = *(const bf16x8*)(qp + 16 * kk);
            __syncthreads();
            const float gtot = SCL[0], mm = fmaxf(m_in, SCL[1]);
            const float ml = fmaxf(PM[l], m_in), ei = expf(m_in - ml), ml2 = ml * LOG2E;
            if (hi == 0) WS[r32] = ei;
            asm volatile("s_waitcnt lgkmcnt(0)" ::: "memory");
#pragma unroll
            for (int jj = 0; jj < 4; ++jj) { const f32x4 f = *(const ML_LAS f32x4*)(WS + 8 * jj + 4 * hi);
#pragma unroll
                for (int e = 0; e < 4; ++e) { num[0][4 * jj + e] *= f[e]; num[1][4 * jj + e] *= f[e]; num[2][4 * jj + e] *= f[e]; num[3][4 * jj + e] *= f[e]; } }
            float dsum = 0.f;
            const ML_LAS unsigned char* vbase = L + LVV + (4 * hi + q4) * PV + blk * 32 + 8 * p4;
            for (int j = 0; j <= lt; ++j) {
                f32x16 S = {};
#pragma unroll
                for (int kk = 0; kk < 16; ++kk) { const bf16x8 kf = *(const ML_LAS bf16x8*)(L + LK + (32 * j + r32) * PK + (16 * kk + 8 * hi) * 2);
                    S = __builtin_amdgcn_mfma_f32_32x32x16_bf16(kf, qf[kk], S, 0, 0, 0);
                    if ((kk & 3) == 3) asm volatile("" ::: "memory"); }
#pragma unroll
                for (int jj = 0; jj < 4; ++jj) { const f32x4 g2 = *(const ML_LAS f32x4*)(G2 + 32 * j + 8 * jj + 4 * hi);
#pragma unroll
                    for (int e = 0; e < 4; ++e) { const int r = 4 * jj + e; const bool ok = (j < lt) || (8 * jj + 4 * hi + e <= r32);
                        S[r] = ok ? S[r] * __builtin_amdgcn_exp2f(g2[e] - ml2) : 0.f; dsum += S[r]; } }
                u32x4 p0, p1;
                p0[0] = cvtpk(S[0], S[1]); p0[1] = cvtpk(S[2], S[3]); p0[2] = cvtpk(S[4], S[5]); p0[3] = cvtpk(S[6], S[7]);
                p1[0] = cvtpk(S[8], S[9]); p1[1] = cvtpk(S[10], S[11]); p1[2] = cvtpk(S[12], S[13]); p1[3] = cvtpk(S[14], S[15]);
                const bf16x8 pa0 = __builtin_bit_cast(bf16x8, p0), pa1 = __builtin_bit_cast(bf16x8, p1);
#pragma unroll
                for (int vt = 0; vt < 4; ++vt)
#pragma unroll
                    for (int ks = 0; ks < 2; ++ks) { const bf16x8 vf = trfrag(vbase + (32 * j + 16 * ks) * PV + vt * 64, 8 * PV);
                        num[vt] = __builtin_amdgcn_mfma_f32_32x32x16_bf16(ks == 0 ? pa0 : pa1, vf, num[vt], 0, 0, 0); }
            }
            { const float dtot = dsum + __shfl_xor(dsum, 32); const float den = dtot + ei * qn; const float mo = BC[l] + ml;
              const float dn = fmaxf(fabsf(den), expf(-mo));
              if (hi == 0) WS[32 + r32] = 1.f / dn; }
            asm volatile("s_waitcnt lgkmcnt(0)" ::: "memory");
#pragma unroll
            for (int jj = 0; jj < 4; ++jj) { const f32x4 f = *(const ML_LAS f32x4*)(WS + 32 + 8 * jj + 4 * hi);
#pragma unroll
                for (int e = 0; e < 4; ++e) { const int r = 4 * jj + e; bf16* ob = Vg + (row0 + 32 * lt) * PD + h * 256 + vh * 128; const unsigned oo = (unsigned)(8 * jj + 4 * hi + e) * PD + (unsigned)r32;
#pragma unroll
                    for (int vt = 0; vt < 4; ++vt) ob[oo + 32 * vt] = (bf16)(cvtpk(num[vt][r] * f[e], 0.f) & 0xffffu); } }
            m_in = gtot + mm;
            if (w == 0 && c < 15) gate_vectors((ML_LAS float*)(L + LG + ((c + 1) & 1) * GSZ), GT, row0 + 128, h, ibh, fbh, m_in, lane);
            __syncthreads();
        }
    } else {
        const int sw = w - 4, t2 = tid - 256;
        f32x16 acc[2][4];
#pragma unroll
        for (int kt = 0; kt < 2; ++kt)
#pragma unroll
            for (int vt = 0; vt < 4; ++vt) acc[kt][vt] = f32x16{};
        float nreg[2] = {0.f, 0.f};
        for (int c = 0; c < 16; ++c) {
            const size_t row0 = (size_t)b * TT + c * 128;
            ML_LAS float* CF = (ML_LAS float*)(L + LG + (c & 1) * GSZ) + 384; ML_LAS float* SCL = CF + 128;
            __syncthreads();
            {
              const unsigned char* kb = (const unsigned char*)(Kg + row0 * PD + h * 256); const unsigned char* vb = (const unsigned char*)(Vg + row0 * PD + h * 256 + vh * 128);
              const unsigned kvo = (unsigned)(t2 >> 5) * (PD * 2) + (unsigned)(t2 & 31) * 16, vvo = (unsigned)(t2 >> 4) * (PD * 2) + (unsigned)(t2 & 15) * 16;
              const unsigned klo = (unsigned)(t2 >> 5) * PK + (unsigned)(t2 & 31) * 16, vlo = (unsigned)(t2 >> 4) * PV + (unsigned)(t2 & 15) * 16;
              u32x4 t[12];
#pragma unroll
              for (int q = 0; q < 12; ++q) t[q] = *(const u32x4*)(kb + (size_t)q * (8 * PD * 2) + kvo);
#pragma unroll
              for (int q = 0; q < 12; ++q) *(ML_LAS u32x4*)(L + LK + q * (8 * PK) + klo) = t[q];
#pragma unroll
              for (int q = 0; q < 4; ++q) t[q] = *(const u32x4*)(kb + (size_t)(12 + q) * (8 * PD * 2) + kvo);
#pragma unroll
              for (int q = 0; q < 8; ++q) t[4 + q] = *(const u32x4*)(vb + (size_t)q * (16 * PD * 2) + vvo);
#pragma unroll
              for (int q = 0; q < 4; ++q) *(ML_LAS u32x4*)(L + LK + (12 + q) * (8 * PK) + klo) = t[q];
#pragma unroll
              for (int q = 0; q < 8; ++q) *(ML_LAS u32x4*)(L + LVV + q * (16 * PV) + vlo) = t[4 + q]; }
            __syncthreads();
            const float gtot = SCL[0], mm = fmaxf(m_in, SCL[1]), d_old = expf(m_in - mm);
#pragma unroll
            for (int kt = 0; kt < 2; ++kt)
#pragma unroll
                for (int vt = 0; vt < 4; ++vt)
#pragma unroll
                    for (int r = 0; r < 16; ++r) acc[kt][vt][r] *= d_old;
            const ML_LAS unsigned char* kbase = L + LK + (4 * hi + q4) * PK + (64 * sw + 16 * blk) * 2 + 8 * p4;
            const ML_LAS unsigned char* vb4 = L + LVV + (4 * hi + q4) * PV + blk * 32 + 8 * p4;
            float nacc[2] = {0.f, 0.f};
#pragma unroll 2
            for (int ks = 0; ks < 8; ++ks) {
                const f32x4 c0 = *(const ML_LAS f32x4*)(CF + 16 * ks + 4 * hi), c1 = *(const ML_LAS f32x4*)(CF + 16 * ks + 8 + 4 * hi);
                bf16x8 af[2];
#pragma unroll
                for (int kt = 0; kt < 2; ++kt) { const bf16x8 ktf = trfrag(kbase + 16 * ks * PK + kt * 64, 8 * PK);
                    float f[8];
#pragma unroll
                    for (int e = 0; e < 4; ++e) { f[e] = bfx(ktf[e]) * c0[e]; f[4 + e] = bfx(ktf[4 + e]) * c1[e]; }
                    nacc[kt] += ((f[0] + f[1]) + (f[2] + f[3])) + ((f[4] + f[5]) + (f[6] + f[7]));
                    u32x4 pk; pk[0] = cvtpk(f[0], f[1]); pk[1] = cvtpk(f[2], f[3]); pk[2] = cvtpk(f[4], f[5]); pk[3] = cvtpk(f[6], f[7]);
                    af[kt] = __builtin_bit_cast(bf16x8, pk); }
#pragma unroll
                for (int vt = 0; vt < 4; ++vt) { const bf16x8 vf = trfrag(vb4 + 16 * ks * PV + vt * 64, 8 * PV);
                    acc[0][vt] = __builtin_amdgcn_mfma_f32_32x32x16_bf16(af[0], vf, acc[0][vt], 0, 0, 0); acc[1][vt] = __builtin_amdgcn_mfma_f32_32x32x16_bf16(af[1], vf, acc[1][vt], 0, 0, 0); }
            }
            nacc[0] += __shfl_xor(nacc[0], 32); nacc[1] += __shfl_xor(nacc[1], 32);
            nreg[0] = d_old * nreg[0] + nacc[0]; nreg[1] = d_old * nreg[1] + nacc[1];
            __syncthreads();
#pragma unroll
            for (int kt = 0; kt < 2; ++kt)
#pragma unroll
                for (int vt = 0; vt < 4; ++vt)
#pragma unroll
                    for (int jj = 0; jj < 4; ++jj) { u32x2 o; o[0] = cvtpk(acc[kt][vt][4 * jj], acc[kt][vt][4 * jj + 1]); o[1] = cvtpk(acc[kt][vt][4 * jj + 2], acc[kt][vt][4 * jj + 3]);
                        *(u32x2*)(CS + (size_t)(32 * vt + r32) * 256 + 64 * sw + 32 * kt + 8 * jj + 4 * hi) = o; }
            if (hi == 0) { NV[64 * sw + r32] = nreg[0]; NV[64 * sw + 32 + r32] = nreg[1]; }
            m_in = gtot + mm;
        }
    }
    __syncthreads();
}
#undef ML_LAS
}
__device__ __forceinline__ void mamba_naive_unit(LAS unsigned char* L, const bf16* XBC, const float* GT, bf16* YM, const float* cw, const float* cb, const float* dtb, const float* alog, const float* dsk, int b, int g, int tid) {
    LAS float* BC = (LAS float*)L;
    LAS float* DT = (LAS float*)(L + 8192);
    const int hl = tid >> 6, p = tid & 63, head = g * 8 + hl, colx = head * 64 + p;
    const float w0 = cw[colx], w1 = cw[1536 + colx], w2 = cw[2 * 1536 + colx], w3 = cw[3 * 1536 + colx], bb = cb[colx];
    float h0 = 0.f, h1 = 0.f, h2 = 0.f;
    const int colbc = 1024 + ((tid & 255) < 128 ? g * 128 + (tid & 255) : 256 + g * 128 + ((tid & 255) - 128));
    const float v0 = cw[colbc], v1 = cw[1536 + colbc], v2 = cw[2 * 1536 + colbc], v3 = cw[3 * 1536 + colbc], vb = cb[colbc];
    float g0 = 0.f, g1 = 0.f, g2 = 0.f;
    const float dskh = dsk[head];
    float S[128];
#pragma unroll
    for (int n = 0; n < 128; ++n) S[n] = 0.f;
    for (int t0 = 0; t0 < T; t0 += 8) {
        if (tid < 256) {
#pragma unroll
            for (int s = 0; s < 8; ++s) { const float raw = bf2f(XBC[((size_t)b * T + t0 + s) * 1536 + colbc]); const float v = v0 * g0 + v1 * g1 + v2 * g2 + v3 * raw + vb; g0 = g1; g1 = g2; g2 = raw; BC[s * 256 + tid] = silu_g(v); }
        } else if (tid < 320) {
            const int s = (tid - 256) >> 3, hh = (tid - 256) & 7, hd2 = g * 8 + hh;
            const float x = GT[((size_t)b * T + t0 + s) * 32 + hd2] + dtb[hd2]; const float dt = x > 20.f ? x : log1pf(expf(x));
            DT[s * 8 + hh] = dt; DT[64 + s * 8 + hh] = expf(-dt * expf(alog[hd2]));
        }
        __syncthreads();
#pragma unroll 1
        for (int s = 0; s < 8; ++s) {
            const size_t row = (size_t)b * T + t0 + s;
            const float raw = bf2f(XBC[row * 1536 + colx]); const float v = w0 * h0 + w1 * h1 + w2 * h2 + w3 * raw + bb; h0 = h1; h1 = h2; h2 = raw;
            const float xv = silu_g(v), dt = DT[s * 8 + hl], dA = DT[64 + s * 8 + hl], coef = dt * xv;
            float acc = 0.f;
#pragma unroll
            for (int n4 = 0; n4 < 32; ++n4) { const f32x4 Bv = *(const LAS f32x4*)(BC + s * 256 + 4 * n4), Cv = *(const LAS f32x4*)(BC + s * 256 + 128 + 4 * n4);
#pragma unroll
                for (int j = 0; j < 4; ++j) { S[4 * n4 + j] = dA * S[4 * n4 + j] + coef * Bv[j]; acc += Cv[j] * S[4 * n4 + j]; } }
            YM[row * D + colx] = (bf16)f2bf(acc + dskh * xv);
        }
        __syncthreads();
    }
}
__device__ __forceinline__ void mlstm_naive_unit(LAS unsigned char* L, const bf16* U, bf16* V, const float* GT, const float* cw, const float* cb, const float* wq, const float* wk, const float* ib, const float* fb, int b, int h, int vh, int tid) {
    LAS float* UC = (LAS float*)L;
    LAS float* Q8 = (LAS float*)(L + 8192);
    LAS float* K8 = (LAS float*)(L + 8192 + 8704);
    LAS float* IF = (LAS float*)(L + 8192 + 2 * 8704);
    const int vl = tid >> 2, kq = tid & 3, colv = h * 256 + vh * 128 + vl;
    const int ju = tid & 255, colu = h * 256 + ju;
    const float w0 = cw[colu], w1 = cw[1024 + colu], w2 = cw[2048 + colu], w3 = cw[3072 + colu], bu = cb[colu];
    float h0 = 0.f, h1 = 0.f, h2 = 0.f;
    float wqv[4], wkv[4];
    { const int nblk = h * 64 + (ju >> 2), i = ju & 3;
#pragma unroll
      for (int jj = 0; jj < 4; ++jj) { wqv[jj] = wq[(nblk * 4 + jj) * 4 + i]; wkv[jj] = wk[(nblk * 4 + jj) * 4 + i] * 0.0625f; } }
    float C[64], N[64];
#pragma unroll
    for (int j = 0; j < 64; ++j) { C[j] = 0.f; N[j] = 0.f; }
    const float ibh = ib[h], fbh = fb[h];
    for (int t0 = 0; t0 < T; t0 += 8) {
        if (tid < 256) {
#pragma unroll
            for (int s = 0; s < 8; ++s) { const float raw = bf2f(U[((size_t)b * T + t0 + s) * D + colu]); const float v = w0 * h0 + w1 * h1 + w2 * h2 + w3 * raw + bu; h0 = h1; h1 = h2; h2 = raw; UC[s * 256 + tid] = silu_g(v); }
        } else if (tid < 264) {
            const int s = tid - 256; const size_t row = (size_t)b * T + t0 + s;
            IF[2 * s] = expf(GT[row * 32 + 16 + h] + ibh); IF[2 * s + 1] = sigm_g(GT[row * 32 + 20 + h] + fbh);
        }
        __syncthreads();
        if (tid < 256) {
#pragma unroll
            for (int s = 0; s < 8; ++s) { const f32x4 u4 = *(const LAS f32x4*)(UC + s * 256 + (tid & ~3));
                const float qv = u4[0] * wqv[0] + u4[1] * wqv[1] + u4[2] * wqv[2] + u4[3] * wqv[3], kv = u4[0] * wkv[0] + u4[1] * wkv[1] + u4[2] * wkv[2] + u4[3] * wkv[3];
                Q8[s * 272 + (tid >> 6) * 68 + (tid & 63)] = qv; K8[s * 272 + (tid >> 6) * 68 + (tid & 63)] = kv; }
        }
        __syncthreads();
#pragma unroll 1
        for (int s = 0; s < 8; ++s) {
            const size_t row = (size_t)b * T + t0 + s;
            const float vt = bf2f(V[row * D + colv]), ig = IF[2 * s], f = IF[2 * s + 1], iv = ig * vt;
            float num = 0.f, den = 0.f;
#pragma unroll
            for (int j4 = 0; j4 < 16; ++j4) { const f32x4 kv = *(const LAS f32x4*)(K8 + s * 272 + kq * 68 + 4 * j4), qv = *(const LAS f32x4*)(Q8 + s * 272 + kq * 68 + 4 * j4);
#pragma unroll
                for (int j = 0; j < 4; ++j) { C[4 * j4 + j] = f * C[4 * j4 + j] + iv * kv[j]; N[4 * j4 + j] = f * N[4 * j4 + j] + ig * kv[j]; num += C[4 * j4 + j] * qv[j]; den += N[4 * j4 + j] * qv[j]; } }
            num += __shfl_xor(num, 1); num += __shfl_xor(num, 2); den += __shfl_xor(den, 1); den += __shfl_xor(den, 2);
            const float hv = num / fmaxf(fabsf(den), 1.f);
            if (kq == 0) V[row * D + colv] = (bf16)f2bf(hv);
        }
        __syncthreads();
    }
}
__device__ __forceinline__ void gate_row(const bf16* YM, int ymp, const bf16* Z, const bf16* HD, const bf16* OP, bf16* YCD, const float* cnw, const float* dnw, size_t row, int lane) {
    float y[16], z[16];
    ld8f(YM + row * ymp + lane * 16, y); ld8f(YM + row * ymp + lane * 16 + 8, y + 8); ld8f(Z + row * D + lane * 16, z); ld8f(Z + row * D + lane * 16 + 8, z + 8);
    float ss = 0.f;
#pragma unroll
    for (int e = 0; e < 16; ++e) { y[e] = y[e] * silu_g(z[e]); ss += y[e] * y[e]; }
    ss = wave_sum(ss); float rstd = 1.f / sqrtf(ss * (1.f / 1024.f) + RMS_EPS);
#pragma unroll
    for (int e = 0; e < 16; ++e) y[e] = y[e] * rstd * cnw[lane * 16 + e];
    st8f(YCD + row * KCD + lane * 16, y); st8f(YCD + row * KCD + lane * 16 + 8, y + 8);
    ld8f(HD + row * D + lane * 16, y); ld8f(HD + row * D + lane * 16 + 8, y + 8); ld8f(OP + row * D + lane * 16, z); ld8f(OP + row * D + lane * 16 + 8, z + 8);
    ss = 0.f;
#pragma unroll
    for (int e = 0; e < 16; ++e) ss += y[e] * y[e];
    ss += __shfl_xor(ss, 1); ss += __shfl_xor(ss, 2); ss += __shfl_xor(ss, 4); ss += __shfl_xor(ss, 8);
    rstd = 1.f / sqrtf(ss * (1.f / 256.f) + RMS_EPS);
#pragma unroll
    for (int e = 0; e < 16; ++e) y[e] = sigm_g(z[e]) * y[e] * rstd * dnw[lane * 16 + e];
    st8f(YCD + row * KCD + 1024 + lane * 16, y); st8f(YCD + row * KCD + 1024 + lane * 16 + 8, y + 8);
}

struct Args { const float* in[28]; float* out; unsigned char* ws; int ph_lo, ph_hi, li, pad; };
__global__ void __launch_bounds__(NWAVES * 64, 2) fwd_kernel(Args args) {
    extern __shared__ __attribute__((aligned(16))) unsigned char lds[];
    LAS unsigned char* L = (LAS unsigned char*)lds;
    volatile LAS unsigned* MISC = (volatile LAS unsigned*)(L + MISC_OFF);
    const int tid = threadIdx.x, lane = tid & 63, wave = __builtin_amdgcn_readfirstlane(tid >> 6);
    const int G = gridDim.x, bx = blockIdx.x; const int vcu = (G % 8 == 0) ? (bx % 8) * (G / 8) + bx / 8 : bx;
    const int gw = vcu * NWAVES + wave, NGW = G * NWAVES;
    unsigned char* ws = args.ws;
    gu32* ctl = (gu32*)(ws + WS_CTL);
    for (int u = tid; u < (LDS_BYTES - LDSCTL_OFF) / 4; u += NWAVES * 64) ((LAS unsigned*)(L + LDSCTL_OFF))[u] = 0u;
    __syncthreads();
    XcdBarrier bar; bar.bar = (unsigned*)(ctl + CW_BAR) + args.li * XCD_BAR_WORDS; bar.x = 0; bar.st = nullptr;
    if (MK_ONE_LAUNCH) bar = xcd_barrier_post((unsigned*)(ctl + CW_BAR) + args.li * XCD_BAR_WORDS, MISC + 8);
    const int lo = args.ph_lo, hi = args.ph_hi;
#define IN(k) (lo <= (k) && (k) < hi)
#define SEAM(k) do { if (MK_ONE_LAUNCH && IN(k) && IN((k) + 1)) xcd_barrier(bar); } while (0)
    float* out = args.out;
#define XIN (args.in[0])
#define W_ABIN ((bf16*)(ws + WS_W_ABIN))
#define W_ABOUT ((bf16*)(ws + WS_W_ABOUT))
#define W_GU0 ((bf16*)(ws + WS_W_GU0))
#define W_DN0 ((bf16*)(ws + WS_W_DN0))
#define W_CDIN ((bf16*)(ws + WS_W_CDIN))
#define W_CDOUT ((bf16*)(ws + WS_W_CDOUT))
#define W_GU1 ((bf16*)(ws + WS_W_GU1))
#define W_DN1 ((bf16*)(ws + WS_W_DN1))
#define XN ((bf16*)(ws + WS_XN))
#define OB ((bf16*)(ws + WS_OB))
#define QKV ((bf16*)(ws + WS_QKV))
#define ACT ((bf16*)(ws + WS_ACT))
#define ZB ((bf16*)(ws + WS_Z))
#define XBC ((bf16*)(ws + WS_XBC))
#define UB ((bf16*)(ws + WS_U))
#define VB ((bf16*)(ws + WS_V))
#define OPB ((bf16*)(ws + WS_O))
#define YCD ((bf16*)(ws + WS_YCD))
#define GT ((float*)((unsigned char*)args.out + DO_GATES))
#define HB ((bf16*)(ws + WS_HB))
#define WDQ ((float*)(ws + WS_WDQ))
#define WSQ (WDQ + 24000)
#define PSUM2 ((float*)(ws + WS_RSS + 1 * MiB))
    constexpr int CM_DN1 = 2 * NGU + 5696, WQ_DN1 = 2 * NGU + NZX;
#define PSUM ((float*)(ws + WS_RSS))
#define RED ((LAS float*)(L + RING_OFF + RING_BYTES + 8192))

    if (IN(0)) for (int rep = 0; rep < 1; ++rep) {
        LAS float* scr = (LAS float*)(L + RING_OFF + wave * 16384);
        constexpr int I0 = 16 * 96, I1 = 16 * 32, I2 = 16 * 176, I3 = 44 * 32, I4 = 16 * 184, I5 = 32 * 32;
        constexpr int NITEMS = I0 + I1 + I3 + I5;
        for (int it = gw; it < NITEMS; it += NGW) {
            int r = it;
            if (r < I0) { tr_item<0>(args.in[3], D, NQKV, W_ABIN, NQKV / 32, scr, r, lane); continue; } r -= I0;
            if (r < I1) { tr_item<0>(args.in[4], D, D, W_ABOUT, D / 32, scr, r, lane); continue; } r -= I1;

            if (r < I3) { tr_item<0>(args.in[26], FF, D, W_DN0, D / 32, scr, r, lane); continue; } r -= I3;

            if (r < I5) { tr_item<0>(args.in[24], KCD, D, W_CDOUT, D / 32, scr, r, lane); continue; } r -= I5;


        }
        for (int blk = gw; blk < 2 * 16 * 88; blk += NGW) {
            const int l = blk / (16 * 88), r2 = blk % (16 * 88), kb = r2 / 88, nb = r2 % 88; const float* wp = args.in[25] + (size_t)l * D * NGU + (size_t)(64 * kb) * NGU + 64 * nb + lane; float am = 0.f;
            float sq = 0.f;
#pragma unroll 8
            for (int kk = 0; kk < 64; ++kk) { const float wv = wp[(size_t)kk * NGU]; am = fmaxf(am, fabsf(wv)); sq += wv * wv; }
            sq = wave_sum(sq); if (lane == 0) WSQ[blk] = sq;
            __hip_atomic_fetch_max((unsigned*)(ctl + CW_CMAX) + l * NGU + 64 * nb + lane, __float_as_uint(am), __ATOMIC_RELAXED, __HIP_MEMORY_SCOPE_AGENT); }
        for (int blk = gw; blk < 44 * 16; blk += NGW) {
            const int kb = blk / 16, nb = blk % 16; const float* wp = args.in[26] + (size_t)FF * D + (size_t)(64 * kb) * D + 64 * nb + lane; float am = 0.f;
#pragma unroll 1
            for (int g4 = 0; g4 < 4; ++g4) { float v[16];
#pragma unroll
                for (int j = 0; j < 16; ++j) v[j] = wp[(size_t)(16 * g4 + j) * D];
                wht16(v);
#pragma unroll
                for (int j = 0; j < 16; ++j) am = fmaxf(am, fabsf(v[j])); }
            __hip_atomic_fetch_max((unsigned*)(ctl + CW_CMAX) + CM_DN1 + 64 * nb + lane, __float_as_uint(am * 0.25f), __ATOMIC_RELAXED, __HIP_MEMORY_SCOPE_AGENT); }
        for (int blk = gw; blk < 16 * 89; blk += NGW) {
            const int kb = blk / 89, nb = blk % 89, col = 64 * nb + lane; float am = 0.f;
            if (col < NZX_SRC) { const float* wp = args.in[10] + (size_t)(64 * kb) * NZX_SRC + col;
#pragma unroll 8
                for (int kk = 0; kk < 64; ++kk) am = fmaxf(am, fabsf(wp[(size_t)kk * NZX_SRC]));
                __hip_atomic_fetch_max((unsigned*)(ctl + CW_CMAX) + 2 * NGU + col, __float_as_uint(am), __ATOMIC_RELAXED, __HIP_MEMORY_SCOPE_AGENT); } }
        for (int m = gw; m < M; m += NGW) rms_row_to_bf16(XIN + (size_t)m * D, args.in[1], XN + (size_t)m * D, lane);
    }
    SEAM(0);
    if (IN(1)) {
        pg8::Gemm g{XN, W_ABIN, M, NQKV, D, nullptr, nullptr}; pg8::StaticOrder S; S.init(M, NQKV, G, bx);
        pg8::EpiQKV E{QKV, NQKV, 0, 2, 6, 8, attn_body::C2};
        pg8::gemm_phase<pg8::EpiQKV, pg8::StaticOrder, true, true>(L + RING_OFF, g, S, E);
        if (PROBE_G) pg8::gemm_phase<pg8::EpiQKV, pg8::StaticOrder, true, true>(L + RING_OFF, g, S, E);
    }
    SEAM(1);
    if (IN(2)) for (int rep = 0; rep < (PROBE_T ? 2 : 1); ++rep) {
        bf16* Y = XN;
        { const attn_body::AttnTensors AT{(const attn_body::bf16*)QKV, (const attn_body::bf16*)QKV, (const attn_body::bf16*)QKV, (attn_body::bf16*)OB}; const attn_body::StaticOrder S((int)G, (int)blockIdx.x);
          attn_body::attn_phase<attn_body::StaticOrder>((char*)lds + RING_OFF, AT, S); }
        static_assert(mixa::LDS_NEED <= RING_BYTES, "mixer A LDS");
        int tid2 = tid, vcu2 = vcu; asm volatile("" : "+v"(tid2), "+s"(vcu2));
        for (int u = vcu2; u < NBATCH * 8; u += G) {
#pragma unroll 1
            for (int tb = 0; tb < 8; ++tb) mixa::unit(QKV, Y, u >> 3, u & 7, tb * 256, L + RING_OFF, tid2);
        }
    }
    SEAM(2);
    if (IN(3)) for (int rep = 0; rep < (PROBE_T ? 2 : 1); ++rep) {
        bf16* Y = XN;
        const float s1 = wave_sum(args.in[5][lane] * args.in[6][lane]), s2 = wave_sum(args.in[7][lane] * args.in[8][lane]);
        const float lam = expf(s1) - expf(s2) + 0.2f;
        for (int m = gw; m < M; m += NGW) attnB_post_row(OB, Y, args.in[9], lam, 0.8f, (size_t)m, lane);
        if (gw == 0) { float a = 0.f; for (int i = lane; i < 16 * 88; i += 64) a += WSQ[16 * 88 + i]; a = wave_sum(a); if (lane == 0) WSQ[2 * 16 * 88] = a * (1.f / ((float)D * (float)NGU)); }
        { LAS float* scr = (LAS float*)(L + RING_OFF + wave * 16384);
          for (int it = gw; it < 16 * 176; it += NGW) tr_item_i8<1>(args.in[25], D, NGU, (unsigned char*)W_GU0, NGU / 32, scr, it, lane, (const unsigned*)(ctl + CW_CMAX), WDQ);
          for (int it = gw; it < 16 * 176; it += NGW) tr_item_i8<1>(args.in[25] + (size_t)D * NGU, D, NGU, (unsigned char*)W_GU1, NGU / 32, scr, it, lane, (const unsigned*)(ctl + CW_CMAX) + NGU, WDQ + NGU);
          for (int it = gw; it < 16 * 184; it += NGW) tr_item_i8<2>(args.in[10], D, NZX_SRC, (unsigned char*)W_CDIN, NZX / 32, scr, it, lane, (const unsigned*)(ctl + CW_CMAX) + 2 * NGU, WDQ + 2 * NGU);
          for (int it = gw; it < 44 * 32; it += NGW) tr_item_i8rot(args.in[26] + (size_t)FF * D, FF, D, (unsigned char*)W_DN1, D / 32, scr, it, lane, (const unsigned*)(ctl + CW_CMAX) + CM_DN1, WDQ + WQ_DN1); }
    }
    SEAM(3);
    if (IN(4)) {
        pg8::Gemm g{XN, W_ABOUT, M, D, D, nullptr, nullptr}; pg8::StaticOrder S; S.init(M, D, G, bx);
        pg8::EpiResidBf<true, false, false> E{XIN, HB, D, nullptr, nullptr};
        pg8::gemm_phase<pg8::EpiResidBf<true, false, false>, pg8::StaticOrder, true, true>(L + RING_OFF, g, S, E);
    }
    SEAM(4);
    if (IN(5)) { for (int m = gw; m < M; m += NGW) rms_row_i8(HB + (size_t)m * D, args.in[2], (unsigned char*)XN + (size_t)m * D, PSUM + (size_t)m * 4, lane); }
    SEAM(5);
    if (IN(6)) {
        pg8::Gemm g{XN, W_GU0, M, NGU, D / 2, PSUM, WDQ};   pg8::StaticOrder S; S.init(M, NGU, G, bx);
        pg8::EpiSwiglu<false, 2> E{(unsigned char*)ACT, FF, 0.f};
        pg8::gemm_phase<pg8::EpiSwiglu<false, 2>, pg8::StaticOrder, true, true>(L + RING_OFF, g, S, E);
        if (PROBE_G) pg8::gemm_phase<pg8::EpiSwiglu<false, 2>, pg8::StaticOrder, true, true>(L + RING_OFF, g, S, E);
    }
    SEAM(6);
    if (IN(7)) {
        pg8::Gemm g{ACT, W_DN0, M, D, FF, nullptr, nullptr}; pg8::StaticOrder S; S.init(M, D, G, bx);
        pg8::EpiResidBf<false, false, false> E{nullptr, HB, D, nullptr, nullptr};
        pg8::gemm_phase<pg8::EpiResidBf<false, false, false>, pg8::StaticOrder, true, true>(L + RING_OFF, g, S, E);
    }
    SEAM(7);
    if (IN(8)) { for (int m = gw; m < M; m += NGW) rms_row_i8(HB + (size_t)m * D, args.in[1] + D, (unsigned char*)XN + (size_t)m * D, PSUM + (size_t)m * 4, lane); }
    SEAM(8);
    if (IN(9)) {
        pg8::Gemm g{XN, W_CDIN, M, NZX, D / 2, PSUM, WDQ + 2 * NGU};   pg8::StaticOrder S; S.init(M, NZX, G, bx);
        pg8::EpiZX<2> E{ZB, XBC, UB, VB, OPB, GT};
        pg8::gemm_phase<pg8::EpiZX<2>, pg8::StaticOrder, true, true>(L + RING_OFF, g, S, E);
        if (PROBE_G) pg8::gemm_phase<pg8::EpiZX<2>, pg8::StaticOrder, true, true>(L + RING_OFF, g, S, E);
    }
    SEAM(9);
    if (IN(10)) {
        for (int u = bx; u < NBATCH * 20; u += G) { const int bb = u / 20, cg = u % 20;
            if (cg < 12) conv_unit<0>(XBC, 1536, cg * 128, args.in[11], 1536, args.in[12], bb, tid, nullptr, nullptr, nullptr);
            else conv_unit<1>(UB, 1024, (cg - 12) * 128, args.in[17], 1024, args.in[18], bb, tid, args.in[19], args.in[20], XN); }
    }
    SEAM(10);
    if (IN(11)) {
        static_assert(mam::LDS_NEED <= LDSCTL_OFF && mls::LDS_NEED <= LDSCTL_OFF, "mixer LDS");
        for (int u = vcu; u < NBATCH * 8; u += G) mls::unit(UB, XN, VB, (bf16*)((unsigned char*)args.out + DO_CS) + (size_t)u * 32768, GT, args.in[21], args.in[22], u >> 3, (u >> 1) & 3, u & 1, L, tid);
        int tid2 = tid, vcu2 = vcu; asm volatile("" : "+v"(tid2), "+s"(vcu2));
        for (int u = vcu2; u < NBATCH * 8; u += G) mam::unit(XBC, GT, args.in[13], args.in[14], args.in[15], u >> 3, (u >> 2) & 1, u & 3, L, tid2);
    }
    SEAM(11);
    if (IN(12)) for (int rep = 0; rep < 1; ++rep) { for (int m = gw; m < M; m += NGW) gate_row(XBC, 1536, ZB, VB, OPB, YCD, args.in[16], args.in[23], (size_t)m, lane); }
    SEAM(12);
    if (IN(13)) {
        pg8::Gemm g{YCD, W_CDOUT, M, D, KCD, nullptr, nullptr}; pg8::StaticOrder S; S.init(M, D, G, bx);
        pg8::EpiResidBf<false, false, false> E{nullptr, HB, D, nullptr, nullptr};
        pg8::gemm_phase<pg8::EpiResidBf<false, false, false>, pg8::StaticOrder, true, true>(L + RING_OFF, g, S, E);
    }
    SEAM(13);
    if (IN(14)) { const float wmsq = WSQ[2 * 16 * 88]; for (int m = gw; m < M; m += NGW) rms_row_i8_clip(HB + (size_t)m * D, args.in[2] + D, (unsigned char*)XN + (size_t)m * D, PSUM + (size_t)m * 4, PSUM2 + (size_t)m * 4, wmsq, lane); }
    SEAM(14);
    if (IN(15)) {
        pg8::Gemm g{XN, W_GU1, M, NGU, D / 2, PSUM, WDQ + NGU};   pg8::StaticOrder S; S.init(M, NGU, G, bx);
        pg8::EpiSwiglu<false, 2, true> E{(unsigned char*)ACT, FF, 0.f};
        pg8::gemm_phase<pg8::EpiSwiglu<false, 2, true>, pg8::StaticOrder, true, true>(L + RING_OFF, g, S, E);
        if (PROBE_G) pg8::gemm_phase<pg8::EpiSwiglu<false, 2, true>, pg8::StaticOrder, true, true>(L + RING_OFF, g, S, E);
    }
    SEAM(15);
    if (IN(16)) {
        pg8::Gemm g{ACT, W_DN1, M, D, FF / 2, PSUM2, WDQ + WQ_DN1}; pg8::StaticOrder S; S.init(M, D, G, bx);
        pg8::EpiResidBf<false, false, false, true> E{nullptr, HB, D, nullptr, nullptr};
        pg8::gemm_phase<pg8::EpiResidBf<false, false, false, true>, pg8::StaticOrder, true, true>(L + RING_OFF, g, S, E);
    }
    SEAM(16);
    if (IN(17)) { int ln = threadIdx.x; asm volatile("" : "+v"(ln)); ln &= 63;
        for (int m = gw; m < M; m += NGW) final_row(HB + (size_t)m * D, args.in[27], out + (size_t)m * D, ln); }
#undef IN
#undef SEAM
#undef XIN
}

extern "C" void kernel_launch(void* const* d_in, const int* in_sizes, int n_in, void* d_out, int out_size, void* d_ws, size_t ws_size, hipStream_t stream) {
    static int grid = 0;
    if (grid == 0) {
        if (n_in != 28 || in_sizes[0] != M * D || out_size != M * D || ws_size < WS_END) { fprintf(stderr, "kernel_launch: unexpected shapes / workspace (%d inputs, ws %zu < %zu); nothing launched\n", n_in, ws_size, (size_t)WS_END); grid = -1; return; }
        int dev = 0, cus = 0;
        if (hipGetDevice(&dev) != hipSuccess || hipDeviceGetAttribute(&cus, hipDeviceAttributeMultiprocessorCount, dev) != hipSuccess) { grid = -1; return; }
        if (hipFuncSetAttribute((const void*)fwd_kernel, hipFuncAttributeMaxDynamicSharedMemorySize, LDS_BYTES) != hipSuccess) { grid = -1; return; }
        int per_cu = 0;
        if (hipOccupancyMaxActiveBlocksPerMultiprocessor(&per_cu, (const void*)fwd_kernel, NWAVES * 64, LDS_BYTES) != hipSuccess || per_cu < 1) fprintf(stderr, "kernel_launch: occupancy query reports %d\n", per_cu);
        (void)hipGetLastError();
        grid = cus;
    }
    if (grid < 0) return;
    if (hipMemsetAsync((char*)d_ws + WS_CTL, 0, CTL_ZERO_BYTES, stream) != hipSuccess) return;
    Args a{};
    for (int i = 0; i < 28; ++i) a.in[i] = (const float*)d_in[i];
    a.out = (float*)d_out; a.ws = (unsigned char*)d_ws;
#if MK_ONE_LAUNCH
    if (PROBE_HI > PROBE_LO) {
        a.ph_lo = 0; a.ph_hi = PROBE_HI; a.li = 0; hipLaunchKernelGGL(fwd_kernel, dim3(grid), dim3(NWAVES * 64), LDS_BYTES, stream, a);
        a.ph_lo = PROBE_LO; a.ph_hi = NPH; a.li = 1; hipLaunchKernelGGL(fwd_kernel, dim3(grid), dim3(NWAVES * 64), LDS_BYTES, stream, a);
        return;
    }
    a.ph_lo = 0; a.ph_hi = NPH;
    hipLaunchKernelGGL(fwd_kernel, dim3(grid), dim3(NWAVES * 64), LDS_BYTES, stream, a);
#else
    for (int p = 0; p < NPH; ++p) { a.ph_lo = p; a.ph_hi = p + 1; hipLaunchKernelGGL(fwd_kernel, dim3(grid), dim3(NWAVES * 64), LDS_BYTES, stream, a); }
#endif
}
```
